# Optimizing an MI355X kernel written in HIP

```python
import math
import jax, jax.numpy as jnp
from jax import lax
import numpy as np

D_MODEL = 1024
BATCH = 16
SEQ = 2048
DEPTH = 2

RMS_EPS = 1e-6
N_BRANCHES = 3
MIX_WIDTH = D_MODEL
ATT_HEAD_DIM = 64
ATT_HEADS = MIX_WIDTH // ATT_HEAD_DIM
BLOCK_Q = 128
SSD_HEAD_DIM = 64
SSD_HEADS = MIX_WIDTH // SSD_HEAD_DIM
SSD_GROUPS = 4
SSD_HEADS_PER_GROUP = SSD_HEADS // SSD_GROUPS
SSD_STATE = 128
SSD_CONV = 4
SSD_CHUNK = 128
SSD_CONV_DIM = MIX_WIDTH + 2 * SSD_GROUPS * SSD_STATE
ML_HEADS = 4
ML_HEAD_DIM = MIX_WIDTH // ML_HEADS
ML_CONV = 4
ML_CHUNK = 128
N_EXPERT_GROUPS = 8
EXPERTS_PER_GROUP = 8
N_EXPERTS = N_EXPERT_GROUPS * EXPERTS_PER_GROUP
TOP_K = 2
D_EXPERT = D_MODEL // 2
MOE_BLOCK = 128

SPLIT_SIZES = (
    MIX_WIDTH, MIX_WIDTH, MIX_WIDTH, ATT_HEADS,
    MIX_WIDTH, SSD_CONV_DIM, SSD_HEADS,
    MIX_WIDTH, MIX_WIDTH, MIX_WIDTH, ML_HEADS, ML_HEADS, MIX_WIDTH,
    N_BRANCHES * D_MODEL,
)
SPLIT_POINTS = tuple(int(v) for v in np.cumsum(SPLIT_SIZES)[:-1])
IN_WIDTH = int(sum(SPLIT_SIZES))

kernel_name = 'hybrid_fox_ssd_mlstm_hmoe'


def _rmsnorm(x, w):
    xf = x.astype(jnp.float32)
    y = xf * lax.rsqrt(jnp.mean(xf * xf, axis=-1, keepdims=True) + RMS_EPS)
    return (y * w.astype(jnp.float32)).astype(x.dtype)


def _group_rmsnorm(x, w, n_groups):
    shp = x.shape
    xg = x.reshape(shp[:-1] + (n_groups, shp[-1] // n_groups)).astype(jnp.float32)
    y = xg * lax.rsqrt(jnp.mean(xg * xg, axis=-1, keepdims=True) + RMS_EPS)
    return (y.reshape(shp) * w.astype(jnp.float32)).astype(x.dtype)


def _causal_depthwise_conv(x, w, b):
    K = w.shape[0]
    L = x.shape[1]
    xp = jnp.pad(x, ((0, 0), (K - 1, 0), (0, 0)))
    y = xp[:, 0:L] * w[0]
    for k in range(1, K):
        y = y + xp[:, k:k + L] * w[k]
    return y + b


def _forgetting_attention(q, k, v, f_logit):
    Bsz, L, _ = q.shape
    to_heads = lambda t: t.reshape(Bsz, L, ATT_HEADS, ATT_HEAD_DIM).transpose(0, 2, 1, 3)
    q, k, v = to_heads(q), to_heads(k), to_heads(v)
    F = jnp.cumsum(jax.nn.log_sigmoid(f_logit.astype(jnp.float32)), axis=1).transpose(0, 2, 1)
    scale = ATT_HEAD_DIM ** -0.5
    outs = []
    for blk in range(L // BLOCK_Q):
        s0, s1 = blk * BLOCK_Q, (blk + 1) * BLOCK_Q
        logits = jnp.einsum('bhqd,bhkd->bhqk', q[:, :, s0:s1], k[:, :, :s1],
                            preferred_element_type=jnp.float32) * scale
        logits = logits + F[:, :, s0:s1, None] - F[:, :, None, :s1]
        q_pos = s0 + jnp.arange(BLOCK_Q)
        k_pos = jnp.arange(s1)
        logits = jnp.where(k_pos[None, :] <= q_pos[:, None], logits, -jnp.inf)
        p = jax.nn.softmax(logits, axis=-1).astype(v.dtype)
        outs.append(jnp.einsum('bhqk,bhkd->bhqd', p, v[:, :, :s1]))
    o = jnp.concatenate(outs, axis=2)
    return o.transpose(0, 2, 1, 3).reshape(Bsz, L, MIX_WIDTH)


def _ssd_mixer(z, xbc, dt_raw, conv_w, conv_b, dt_bias, a_log, d_skip, norm_w):
    dtype = z.dtype
    Bsz, L, _ = z.shape
    nc, Q, G, Hg, P, N = L // SSD_CHUNK, SSD_CHUNK, SSD_GROUPS, SSD_HEADS_PER_GROUP, SSD_HEAD_DIM, SSD_STATE
    xbc = jax.nn.silu(_causal_depthwise_conv(xbc, conv_w, conv_b)).astype(jnp.float32)
    xs, Bm, Cm = jnp.split(xbc, (MIX_WIDTH, MIX_WIDTH + G * N), axis=-1)
    xs = xs.reshape(Bsz, nc, Q, G, Hg, P)
    Bm = Bm.reshape(Bsz, nc, Q, G, N)
    Cm = Cm.reshape(Bsz, nc, Q, G, N)
    dt = jax.nn.softplus(dt_raw.astype(jnp.float32) + dt_bias.astype(jnp.float32)).reshape(Bsz, nc, Q, G, Hg)
    A = -jnp.exp(a_log.astype(jnp.float32)).reshape(G, Hg)
    a_cum = jnp.cumsum(dt * A, axis=2)
    seg = a_cum[:, :, :, None] - a_cum[:, :, None, :]
    causal = jnp.tril(jnp.ones((Q, Q), dtype=bool))[:, :, None, None]
    decay = jnp.exp(jnp.where(causal, seg, -jnp.inf))
    cb = jnp.einsum('bcign,bcjgn->bcijg', Cm, Bm)
    w_ij = cb[..., None] * decay * dt[:, :, None]
    y_diag = jnp.einsum('bcijgh,bcjghp->bcighp', w_ij, xs)
    decay_to_end = jnp.exp(a_cum[:, :, -1:] - a_cum)
    states = jnp.einsum('bcjgn,bcjgh,bcjghp->bcghpn', Bm, decay_to_end * dt, xs)
    chunk_decay = jnp.exp(a_cum[:, :, -1])

    def step(s, inp):
        st, dec = inp
        return s * dec[..., None, None] + st, s

    init = jnp.zeros((Bsz, G, Hg, P, N), jnp.float32)
    _, prev = lax.scan(step, init, (jnp.moveaxis(states, 1, 0), jnp.moveaxis(chunk_decay, 1, 0)))
    prev = jnp.moveaxis(prev, 0, 1)
    y_off = jnp.einsum('bcign,bcghpn,bcigh->bcighp', Cm, prev, jnp.exp(a_cum))
    y = y_diag + y_off + xs * d_skip.astype(jnp.float32).reshape(G, Hg)[:, :, None]
    y = y.reshape(Bsz, L, MIX_WIDTH)
    y = y * jax.nn.silu(z.astype(jnp.float32))
    return _group_rmsnorm(y, norm_w, SSD_GROUPS).astype(dtype)


def _mlstm_mixer(q, k, v, i_raw, f_raw, o_raw, conv_w, conv_b, i_bias, f_bias, norm_w):
    dtype = q.dtype
    Bsz, L, _ = q.shape
    nc, Q, H, d = L // ML_CHUNK, ML_CHUNK, ML_HEADS, ML_HEAD_DIM
    qk = jax.nn.silu(_causal_depthwise_conv(jnp.concatenate([q, k], axis=-1), conv_w, conv_b))
    q, k = jnp.split(qk.astype(jnp.float32), 2, axis=-1)
    k = k * (d ** -0.5)
    chunked = lambda t: t.reshape(Bsz, nc, Q, H, d).transpose(1, 0, 3, 2, 4)
    gate_chunked = lambda t: t.reshape(Bsz, nc, Q, H).transpose(1, 0, 3, 2)
    qc, kc, vc = chunked(q), chunked(k), chunked(v.astype(jnp.float32))
    log_i = gate_chunked(i_raw.astype(jnp.float32) + i_bias.astype(jnp.float32))
    log_f = gate_chunked(jax.nn.log_sigmoid(f_raw.astype(jnp.float32) + f_bias.astype(jnp.float32)))
    causal = jnp.tril(jnp.ones((Q, Q), dtype=bool))

    def step(carry, inp):
        C, n, m = carry
        qb, kb, vb, ib, fb = inp
        b = jnp.cumsum(fb, axis=-1)
        g = b[..., -1]
        D = jnp.where(causal, b[..., :, None] - b[..., None, :] + ib[..., None, :], -jnp.inf)
        m_inter = b + m[..., None]
        m_t = jnp.maximum(m_inter, jnp.max(D, axis=-1))
        ws = jnp.exp(D - m_t[..., None]) * jnp.einsum('bhtd,bhsd->bhts', qb, kb)
        inter = jnp.exp(m_inter - m_t)
        num = jnp.einsum('bhts,bhsv->bhtv', ws, vb) + inter[..., None] * jnp.einsum('bhtd,bhdv->bhtv', qb, C)
        den = jnp.sum(ws, axis=-1) + inter * jnp.einsum('bhtd,bhd->bht', qb, n)
        h = num / jnp.maximum(jnp.abs(den), jnp.exp(-m_t))[..., None]
        e = g[..., None] - b + ib
        m_new = jnp.maximum(g + m, jnp.max(e, axis=-1))
        wk = jnp.exp(e - m_new[..., None])
        carry_scale = jnp.exp(g + m - m_new)
        C = carry_scale[..., None, None] * C + jnp.einsum('bhs,bhsd,bhsv->bhdv', wk, kb, vb)
        n = carry_scale[..., None] * n + jnp.einsum('bhs,bhsd->bhd', wk, kb)
        return (C, n, m_new), h

    init = (jnp.zeros((Bsz, H, d, d), jnp.float32), jnp.zeros((Bsz, H, d), jnp.float32),
            jnp.zeros((Bsz, H), jnp.float32))
    _, hs = lax.scan(step, init, (qc, kc, vc, log_i, log_f))
    hs = hs.transpose(1, 0, 3, 2, 4).reshape(Bsz, L, MIX_WIDTH)
    hs = _group_rmsnorm(hs, norm_w, ML_HEADS).astype(jnp.float32)
    return (jax.nn.sigmoid(o_raw.astype(jnp.float32)) * hs).astype(dtype)


def _hybrid_mixer(h, w_in, att_f_bias, ssd_conv_w, ssd_conv_b, ssd_dt_bias, ssd_a_log, ssd_d, ssd_norm_w,
                  ml_conv_w, ml_conv_b, ml_i_bias, ml_f_bias, ml_norm_w, gate_bias, w_branch, w_out):
    (a_q, a_k, a_v, a_f, s_z, s_xbc, s_dt, m_q, m_k, m_v, m_i, m_f, m_o, g_raw) = [
        h @ w for w in jnp.split(w_in, SPLIT_POINTS, axis=-1)]
    y_att = _forgetting_attention(a_q, a_k, a_v, a_f + att_f_bias)
    y_ssd = _ssd_mixer(s_z, s_xbc, s_dt, ssd_conv_w, ssd_conv_b, ssd_dt_bias, ssd_a_log, ssd_d, ssd_norm_w)
    y_ml = _mlstm_mixer(m_q, m_k, m_v, m_i, m_f, m_o, ml_conv_w, ml_conv_b, ml_i_bias, ml_f_bias, ml_norm_w)
    gates = jax.nn.sigmoid((g_raw + gate_bias).astype(jnp.float32)).astype(h.dtype)
    gates = gates.reshape(h.shape[:-1] + (N_BRANCHES, D_MODEL))
    u = (gates[..., 0, :] * (y_att @ w_branch[0])
         + gates[..., 1, :] * (y_ssd @ w_branch[1])
         + gates[..., 2, :] * (y_ml @ w_branch[2]))
    return u @ w_out


def _hier_moe(h, w_group, b_group, w_expert_router, b_expert_router, w_gate, w_up, w_down):
    dtype = h.dtype
    Bsz, L, D = h.shape
    N = Bsz * L
    xf = h.reshape(N, D)
    g_logits = (xf @ w_group + b_group).astype(jnp.float32)
    g_prob = jax.nn.softmax(g_logits, axis=-1)
    _, g_sel = lax.top_k(g_logits, 1)
    e_logits = (xf @ w_expert_router + b_expert_router).astype(jnp.float32)
    e_logits = e_logits.reshape(N, N_EXPERT_GROUPS, EXPERTS_PER_GROUP)
    e_in_group = jnp.take_along_axis(e_logits, g_sel[:, :, None], axis=1)[:, 0]
    top_v, top_i = lax.top_k(e_in_group, TOP_K)
    weights = jnp.take_along_axis(g_prob, g_sel, axis=1) * jax.nn.softmax(top_v, axis=-1)
    expert_id = g_sel * EXPERTS_PER_GROUP + top_i
    A = N * TOP_K
    flat_e = expert_id.reshape(A)
    flat_tok = jnp.repeat(jnp.arange(N, dtype=jnp.int32), TOP_K)
    flat_w = weights.reshape(A)
    order = jnp.argsort(flat_e)
    sorted_e = flat_e[order]
    counts = jnp.bincount(flat_e, length=N_EXPERTS)
    starts = jnp.cumsum(counts) - counts
    padded = ((counts + MOE_BLOCK - 1) // MOE_BLOCK) * MOE_BLOCK
    pend = jnp.cumsum(padded)
    pstart = pend - padded
    dest = pstart[sorted_e] + (jnp.arange(A) - starts[sorted_e])
    P = A + N_EXPERTS * MOE_BLOCK
    row_tok = jnp.full((P,), N, jnp.int32).at[dest].set(flat_tok[order])
    row_w = jnp.zeros((P,), jnp.float32).at[dest].set(flat_w[order])
    n_blk = P // MOE_BLOCK
    blk_e = jnp.minimum(jnp.searchsorted(pend, jnp.arange(n_blk) * MOE_BLOCK, side='right'), N_EXPERTS - 1)
    x_rows = jnp.concatenate([xf, jnp.zeros((1, D), dtype)], axis=0)[row_tok].reshape(n_blk, MOE_BLOCK, D)

    def expert_block(args):
        xb, e = args
        return (jax.nn.silu(xb @ w_gate[e]) * (xb @ w_up[e])) @ w_down[e]

    y_rows = lax.map(expert_block, (x_rows, blk_e)).reshape(P, D)
    y = jax.ops.segment_sum(y_rows.astype(jnp.float32) * row_w[:, None], row_tok, num_segments=N + 1)[:N]
    return y.astype(dtype).reshape(Bsz, L, D)


def setup_inputs(seed: int = 0) -> dict:
    key = jax.random.key(seed)
    ks = jax.random.split(key, 27)
    f32 = jnp.float32
    nrm = lambda k, shape, scale: jax.random.normal(k, shape, f32) * scale
    dt = jnp.exp(jax.random.uniform(ks[6], (DEPTH, SSD_HEADS), f32) * (math.log(0.1) - math.log(0.001))
                 + math.log(0.001))
    return {
        'x': jax.random.normal(ks[0], (BATCH, SEQ, D_MODEL), f32),
        'norm1_w': 1.0 + nrm(ks[1], (DEPTH, D_MODEL), 0.02),
        'w_in': nrm(ks[2], (DEPTH, D_MODEL, IN_WIDTH), D_MODEL ** -0.5),
        'att_f_bias': jax.random.uniform(ks[3], (DEPTH, ATT_HEADS), f32, 1.0, 4.0),
        'ssd_conv_w': nrm(ks[4], (DEPTH, SSD_CONV, SSD_CONV_DIM), SSD_CONV ** -0.5),
        'ssd_conv_b': nrm(ks[5], (DEPTH, SSD_CONV_DIM), 0.01),
        'ssd_dt_bias': dt + jnp.log(-jnp.expm1(-dt)),
        'ssd_a_log': jnp.log(jax.random.uniform(ks[7], (DEPTH, SSD_HEADS), f32, 1.0, 16.0)),
        'ssd_d': 1.0 + nrm(ks[8], (DEPTH, SSD_HEADS), 0.1),
        'ssd_norm_w': 1.0 + nrm(ks[9], (DEPTH, MIX_WIDTH), 0.02),
        'ml_conv_w': nrm(ks[10], (DEPTH, ML_CONV, 2 * MIX_WIDTH), ML_CONV ** -0.5),
        'ml_conv_b': nrm(ks[11], (DEPTH, 2 * MIX_WIDTH), 0.01),
        'ml_i_bias': nrm(ks[12], (DEPTH, ML_HEADS), 0.1),
        'ml_f_bias': jax.random.uniform(ks[13], (DEPTH, ML_HEADS), f32, 3.0, 6.0),
        'ml_norm_w': 1.0 + nrm(ks[14], (DEPTH, MIX_WIDTH), 0.02),
        'gate_bias': nrm(ks[15], (DEPTH, N_BRANCHES * D_MODEL), 0.01),
        'w_branch': nrm(ks[16], (DEPTH, N_BRANCHES, MIX_WIDTH, D_MODEL), MIX_WIDTH ** -0.5),
        'w_out': nrm(ks[17], (DEPTH, D_MODEL, D_MODEL), D_MODEL ** -0.5),
        'norm2_w': 1.0 + nrm(ks[18], (DEPTH, D_MODEL), 0.02),
        'w_group': nrm(ks[19], (DEPTH, D_MODEL, N_EXPERT_GROUPS), D_MODEL ** -0.5),
        'b_group': nrm(ks[20], (DEPTH, N_EXPERT_GROUPS), 0.01),
        'w_expert_router': nrm(ks[21], (DEPTH, D_MODEL, N_EXPERTS), D_MODEL ** -0.5),
        'b_expert_router': nrm(ks[22], (DEPTH, N_EXPERTS), 0.01),
        'w_gate': nrm(ks[23], (DEPTH, N_EXPERTS, D_MODEL, D_EXPERT), D_MODEL ** -0.5),
        'w_up': nrm(ks[24], (DEPTH, N_EXPERTS, D_MODEL, D_EXPERT), D_MODEL ** -0.5),
        'w_down': nrm(ks[25], (DEPTH, N_EXPERTS, D_EXPERT, D_MODEL), D_EXPERT ** -0.5),
        'final_norm_w': 1.0 + nrm(ks[26], (D_MODEL,), 0.02),
    }


def reference(x, norm1_w, w_in, att_f_bias, ssd_conv_w, ssd_conv_b, ssd_dt_bias, ssd_a_log, ssd_d, ssd_norm_w,
              ml_conv_w, ml_conv_b, ml_i_bias, ml_f_bias, ml_norm_w, gate_bias, w_branch, w_out, norm2_w,
              w_group, b_group, w_expert_router, b_expert_router, w_gate, w_up, w_down, final_norm_w):
    for layer in range(DEPTH):
        h = _rmsnorm(x, norm1_w[layer])
        x = x + _hybrid_mixer(h, w_in[layer], att_f_bias[layer], ssd_conv_w[layer], ssd_conv_b[layer],
                              ssd_dt_bias[layer], ssd_a_log[layer], ssd_d[layer], ssd_norm_w[layer],
                              ml_conv_w[layer], ml_conv_b[layer], ml_i_bias[layer], ml_f_bias[layer],
                              ml_norm_w[layer], gate_bias[layer], w_branch[layer], w_out[layer])
        h = _rmsnorm(x, norm2_w[layer])
        x = x + _hier_moe(h, w_group[layer], b_group[layer], w_expert_router[layer], b_expert_router[layer],
                          w_gate[layer], w_up[layer], w_down[layer])
    return _rmsnorm(x, final_norm_w)
```

```cpp
#define MK_N_LAUNCHES 0
#include <hip/hip_runtime.h>
#include <cstdio>
#include <cstdint>
#ifndef MK_N_LAUNCHES
#define MK_N_LAUNCHES 1
#endif
#ifndef PHMASK
#define PHMASK 0xffffffffffffffffull
#endif
namespace pg8 {
#define PG8_LAS __attribute__((address_space(3)))
typedef unsigned short bf16_t;
typedef short bf16x8 __attribute__((ext_vector_type(8)));
typedef float f32x4 __attribute__((ext_vector_type(4)));
typedef unsigned u32x4 __attribute__((ext_vector_type(4)));
constexpr int BM = 256, BK = 64, HALF = 128, HTB = HALF * BK * 2  , STAGE_BYTES = 8 * HTB, NXCD = 8, WGM = 8;

__host__ __device__ __forceinline__ int lds_byte(int r, int c) { const int st = (r >> 4) * 2 + (c >> 5), rr = r & 15, cc = c & 31, ob = rr * 64 + cc * 2; return st * 1024 + (ob ^ (((ob >> 9) & 1) << 5)); }
__host__ __device__ __forceinline__ void stage_rc(int b, int& R, int& C) { const int st = b / 1024, sb = b % 1024, swz = sb ^ (((sb >> 9) & 1) << 5); R = (st >> 1) * 16 + swz / 64; C = (st & 1) * 32 + (swz % 64) / 2; }
__host__ __device__ __forceinline__ int perm32(int rho) { const int n = rho >> 4, i = rho & 15; return 8 * (i >> 2) + 4 * n + (i & 3); }

struct Unit { int pm, pn; };
struct Gemm { const bf16_t* A; const bf16_t* Bt; int M, N, K; };

struct StaticOrder {
    int nM, nN, nwg, G, c;
    __host__ __device__ void init(int M, int N, int G_, int c_) { nM = M / BM; nN = N / BM; nwg = nM * nN; G = G_; c = c_; }
    __host__ __device__ bool next(int i, Unit& u) const {
        const long L = (long)i * G + c; if (L >= nwg) return false;
        int wgid = (int)L; { const int q = nwg / NXCD, r = nwg % NXCD, xcd = wgid % NXCD, off = wgid / NXCD; wgid = (xcd < r ? xcd * (q + 1) : r * (q + 1) + (xcd - r) * q) + off; }
        const int nig = WGM * nN, gid = wgid / nig, fm = gid * WGM, gsz = (nM - fm) < WGM ? (nM - fm) : WGM;
        u.pm = fm + ((wgid % nig) % gsz); u.pn = (wgid % nig) / gsz; return true;
    }
    __device__ __forceinline__ void a_ready(const Unit&) const {}
    __device__ __forceinline__ void done(const Unit&) const {}
};

typedef float cvt_f32x2 __attribute__((ext_vector_type(2))); typedef __bf16 cvt_bf16x2 __attribute__((ext_vector_type(2)));
__device__ __forceinline__ unsigned cvt_pk_bf16(float lo, float hi) { const cvt_f32x2 v = {lo, hi}; const cvt_bf16x2 b = __builtin_convertvector(v, cvt_bf16x2); return __builtin_bit_cast(unsigned, b); }
typedef float f32x2 __attribute__((ext_vector_type(2)));
__device__ __forceinline__ f32x2 gelu_pk(f32x2 v) {
    const f32x2 av = __builtin_elementwise_abs(v), d = av * 0.2316418882f + 1.0f;
    f32x2 t; t.x = __builtin_amdgcn_rcpf(d.x); t.y = __builtin_amdgcn_rcpf(d.y);
    f32x2 q = t * 0.5307027145f + (-0.7265760135f); q = q * t + 0.7107068705f; q = q * t + (-0.142248368f); q = q * t + 0.127414796f; q = q * t;
    const f32x2 s = (v * v) * (-0.72134752044f);
    f32x2 e; e.x = __builtin_amdgcn_exp2f(s.x); e.y = __builtin_amdgcn_exp2f(s.y);
    const f32x2 m = v * (q * e), r = v - m;
    f32x2 o; o.x = v.x < 0.f ? m.x : r.x; o.y = v.y < 0.f ? m.y : r.y; return o;
}

__device__ __forceinline__ float fast_sigmoid(float x) { return __builtin_amdgcn_rcpf(1.0f + __expf(-x)); }
__device__ __forceinline__ float bf_lo(unsigned w) { return __builtin_bit_cast(float, w << 16); }
__device__ __forceinline__ float bf_hi(unsigned w) { return __builtin_bit_cast(float, w & 0xffff0000u); }
constexpr size_t SLAB = (size_t)64 << 20;

struct EpiProj {
    static constexpr bool PERM = true, AFTER_DRAIN = false;
    unsigned char* proj;
    __device__ __forceinline__ void operator()(const f32x4 (&acc)[2][2][4][2], const Unit& u, int wr, int wc, int fr, int fq) const {
        const int pn = u.pn; const int row0 = u.pm * BM + wr * 64 + fr;
        int ldc = 1024, colt; size_t boff;
        if (pn < 16) { boff = (size_t)(pn >> 2) * SLAB; colt = (pn & 3) * 256; }
        else if (pn < 28) { const int q = pn - 16; boff = (size_t)(q >> 2) * SLAB; colt = (q & 3) * 256; }
        else if (pn < 32) { boff = 0; colt = (pn - 28) * 256; }
        else { boff = SLAB; ldc = 2048; colt = (pn - 32) * 256; }
        bf16_t* base = (bf16_t*)(proj + boff) + colt + wc * 32 + 8 * fq;
#pragma unroll
        for (int ai = 0; ai < 2; ++ai)
#pragma unroll
            for (int m = 0; m < 4; ++m) { bf16_t* rowp = base + (size_t)(row0 + ai * HALF + m * 16) * ldc;
#pragma unroll
                for (int bj = 0; bj < 2; ++bj) { const f32x4 v0 = acc[ai][bj][m][0], v1 = acc[ai][bj][m][1];
                    u32x4 w; w.x = cvt_pk_bf16(v0[0], v0[1]); w.y = cvt_pk_bf16(v0[2], v0[3]); w.z = cvt_pk_bf16(v1[0], v1[1]); w.w = cvt_pk_bf16(v1[2], v1[3]);
                    *(u32x4*)(rowp + bj * HALF) = w; } }
    }
};
struct EpiGate {
    static constexpr bool PERM = true, AFTER_DRAIN = false;
    unsigned char* proj; const float* gate_bias;
    __device__ __forceinline__ void operator()(const f32x4 (&acc)[2][2][4][2], const Unit& u, int wr, int wc, int fr, int fq) const {
        const int q = u.pn - 40; const int row0 = u.pm * BM + wr * 64 + fr;
        bf16_t* base = (bf16_t*)(proj + (size_t)(q >> 2) * SLAB) + (q & 3) * 256 + wc * 32 + 8 * fq;
        const float* bp = gate_bias + q * 256 + wc * 32 + 8 * fq;
#pragma unroll
        for (int bj = 0; bj < 2; ++bj) { const f32x4 b0 = *(const f32x4*)(bp + bj * HALF), b1 = *(const f32x4*)(bp + bj * HALF + 4);
#pragma unroll
            for (int ai = 0; ai < 2; ++ai)
#pragma unroll
                for (int m = 0; m < 4; ++m) { f32x4 v0 = acc[ai][bj][m][0] + b0, v1 = acc[ai][bj][m][1] + b1;
#pragma unroll
                    for (int e = 0; e < 4; ++e) { v0[e] = fast_sigmoid(v0[e]); v1[e] = fast_sigmoid(v1[e]); }
                    u32x4 w; w.x = cvt_pk_bf16(v0[0], v0[1]); w.y = cvt_pk_bf16(v0[2], v0[3]); w.z = cvt_pk_bf16(v1[0], v1[1]); w.w = cvt_pk_bf16(v1[2], v1[3]);
                    *(u32x4*)(base + (size_t)(row0 + ai * HALF + m * 16) * 1024 + bj * HALF) = w; } }
    }
};

struct EpiBranch {
    static constexpr bool PERM = true, AFTER_DRAIN = false;
    bf16_t* U; const bf16_t* G; int first;
    __device__ __forceinline__ void operator()(const f32x4 (&acc)[2][2][4][2], const Unit& u, int wr, int wc, int fr, int fq) const {
        const int row0 = u.pm * BM + wr * 64 + fr, col0 = u.pn * BM + wc * 32 + 8 * fq;
#pragma unroll
        for (int ai = 0; ai < 2; ++ai)
#pragma unroll
            for (int m = 0; m < 4; ++m) { const size_t ro = (size_t)(row0 + ai * HALF + m * 16) * 1024 + col0;
#pragma unroll
                for (int bj = 0; bj < 2; ++bj) { const u32x4 g = *(const u32x4*)(G + ro + bj * HALF); u32x4 o = (u32x4){0u, 0u, 0u, 0u}; if (!first) o = *(const u32x4*)(U + ro + bj * HALF);
                    const f32x4 a0 = acc[ai][bj][m][0], a1 = acc[ai][bj][m][1]; u32x4 w;
                    w.x = cvt_pk_bf16(bf_lo(o.x) + bf_lo(g.x) * a0[0], bf_hi(o.x) + bf_hi(g.x) * a0[1]);
                    w.y = cvt_pk_bf16(bf_lo(o.y) + bf_lo(g.y) * a0[2], bf_hi(o.y) + bf_hi(g.y) * a0[3]);
                    w.z = cvt_pk_bf16(bf_lo(o.z) + bf_lo(g.z) * a1[0], bf_hi(o.z) + bf_hi(g.z) * a1[1]);
                    w.w = cvt_pk_bf16(bf_lo(o.w) + bf_lo(g.w) * a1[2], bf_hi(o.w) + bf_hi(g.w) * a1[3]);
                    *(u32x4*)(U + ro + bj * HALF) = w; } }
    }
};

struct EpiResid {
    static constexpr bool PERM = true, AFTER_DRAIN = false;
    const float* src; float* dst;
    __device__ __forceinline__ void operator()(const f32x4 (&acc)[2][2][4][2], const Unit& u, int wr, int wc, int fr, int fq) const {
        const int row0 = u.pm * BM + wr * 64 + fr, col0 = u.pn * BM + wc * 32 + 8 * fq;
#pragma unroll
        for (int ai = 0; ai < 2; ++ai)
#pragma unroll
            for (int m = 0; m < 4; ++m) { const size_t ro = (size_t)(row0 + ai * HALF + m * 16) * 1024 + col0;
#pragma unroll
                for (int bj = 0; bj < 2; ++bj) { const f32x4 s0 = *(const f32x4*)(src + ro + bj * HALF), s1 = *(const f32x4*)(src + ro + bj * HALF + 4);
                    *(f32x4*)(dst + ro + bj * HALF) = s0 + acc[ai][bj][m][0]; *(f32x4*)(dst + ro + bj * HALF + 4) = s1 + acc[ai][bj][m][1]; } }
    }
};

struct EpiGU {
    static constexpr bool PERM = true, AFTER_DRAIN = false;
    bf16_t* ACT;
    __device__ __forceinline__ void operator()(const f32x4 (&acc)[2][2][4][2], const Unit& u, int wr, int wc, int fr, int fq) const {
        const int row0 = u.pm * BM + wr * 64 + fr, col0 = (u.pn & 3) * 128 + wc * 16 + 4 * fq;
#pragma unroll
        for (int ai = 0; ai < 2; ++ai)
#pragma unroll
            for (int m = 0; m < 4; ++m) { bf16_t* rowp = ACT + (size_t)(row0 + ai * HALF + m * 16) * 512 + col0;
#pragma unroll
                for (int bj = 0; bj < 2; ++bj) { const f32x4 g = acc[ai][bj][m][0], v = acc[ai][bj][m][1]; float r[4];
#pragma unroll
                    for (int e = 0; e < 4; ++e) r[e] = g[e] * fast_sigmoid(g[e]) * v[e];
                    uint2 w; w.x = cvt_pk_bf16(r[0], r[1]); w.y = cvt_pk_bf16(r[2], r[3]);
                    *(uint2*)(rowp + bj * 64) = w; } }
    }
};

struct EpiRows {
    static constexpr bool PERM = true, AFTER_DRAIN = false;
    bf16_t* Y;
    __device__ __forceinline__ void operator()(const f32x4 (&acc)[2][2][4][2], const Unit& u, int wr, int wc, int fr, int fq) const {
        const int row0 = u.pm * BM + wr * 64 + fr, col0 = (u.pn & 3) * BM + wc * 32 + 8 * fq;
#pragma unroll
        for (int ai = 0; ai < 2; ++ai)
#pragma unroll
            for (int m = 0; m < 4; ++m) { bf16_t* rowp = Y + (size_t)(row0 + ai * HALF + m * 16) * 1024 + col0;
#pragma unroll
                for (int bj = 0; bj < 2; ++bj) { const f32x4 v0 = acc[ai][bj][m][0], v1 = acc[ai][bj][m][1];
                    u32x4 w; w.x = cvt_pk_bf16(v0[0], v0[1]); w.y = cvt_pk_bf16(v0[2], v0[3]); w.z = cvt_pk_bf16(v1[0], v1[1]); w.w = cvt_pk_bf16(v1[2], v1[3]);
                    *(u32x4*)(rowp + bj * HALF) = w; } }
    }
};

struct RangeOrder {
    StaticOrder S; int pn0;
    __device__ void init(int M, int npn, int pn0_, int G, int c) { S.init(M, npn * BM, G, c); pn0 = pn0_; }
    __device__ __forceinline__ bool next(int i, Unit& u) const { if (!S.next(i, u)) return false; u.pn += pn0; return true; }
    __device__ __forceinline__ void a_ready(const Unit&) const {}
    __device__ __forceinline__ void done(const Unit&) const {}
};
struct MoeOrder {
    const PG8_LAS int* tile_start;
    int G, c;
    __device__ __forceinline__ bool next(int i, Unit& u) const {
        const int L = i * G + c, ti = L >> 2; if (ti >= tile_start[64]) return false;
        int e = 0;
        for (int j = 1; j < 64; ++j) e += (tile_start[j] <= ti) ? 1 : 0;
        u.pm = ti; u.pn = e * 4 + (L & 3); return true;
    }
    __device__ __forceinline__ void a_ready(const Unit&) const {}
    __device__ __forceinline__ void done(const Unit&) const {}
};
template <class Epi, class Sched, bool ALIGN_EPI = false, bool SP2 = false>
__device__ __forceinline__ void gemm_phase(PG8_LAS unsigned char* lds, const Gemm g, const Sched& S, const Epi& E) {
    const int tid = threadIdx.x, wid = __builtin_amdgcn_readfirstlane(tid >> 6), lane = tid & 63, wr = wid >> 2, wc = wid & 3, fr = lane & 15, fq = lane >> 4;
    const int K = g.K, nt = K / BK;
    unsigned voffA[2], voffB[2];
#pragma unroll
    for (int i = 0; i < 2; ++i) { int R, C; stage_rc(tid * 16 + i * 8192, R, C); const int Rb = Epi::PERM ? ((R & ~31) + perm32(R & 31)) : R;
        voffA[i] = (unsigned)(R * K + C) * 2u; voffB[i] = (unsigned)(Rb * K + C) * 2u; }
    const size_t kstep = (size_t)(BK * 2);
    const size_t hstep = (size_t)HALF * K * 2;
    const size_t tstep = 2 * hstep;
    const unsigned ldsw = (unsigned)wid * 1024u;
    const int aoff = lds_byte(wr * 64 + fr, fq * 8), boff = lds_byte(wc * 32 + fr, fq * 8);
#define PG8_SA(b, h) (((b) * 2 + (h)) * HTB)
#define PG8_SB(b, h) ((4 + (b) * 2 + (h)) * HTB)
#define PG8_STAGE(bufoff, gbase, voff) do { _Pragma("unroll") for (int _i = 0; _i < 2; ++_i) \
        __builtin_amdgcn_global_load_lds((const unsigned*)((const char*)(gbase) + (voff)[_i]), (PG8_LAS unsigned*)(lds + (bufoff) + ldsw + _i * 8192), 16, 0, 0); } while (0)
#define PG8_LDA(dst, b, h) do { _Pragma("unroll") for (int m = 0; m < 4; ++m) _Pragma("unroll") for (int k = 0; k < 2; ++k) dst[m][k] = *(const PG8_LAS bf16x8*)(lds + PG8_SA(b, h) + aoff + m * 2048 + k * 1024); } while (0)
#define PG8_LDB(dst, b, h) do { _Pragma("unroll") for (int n = 0; n < 2; ++n) _Pragma("unroll") for (int k = 0; k < 2; ++k) dst[n][k] = *(const PG8_LAS bf16x8*)(lds + PG8_SB(b, h) + boff + n * 2048 + k * 1024); } while (0)
#define PG8_MMA(ai, bj, At, Bt) do { __builtin_amdgcn_s_setprio(1); _Pragma("unroll") for (int m = 0; m < 4; ++m) _Pragma("unroll") for (int n = 0; n < 2; ++n) _Pragma("unroll") for (int k = 0; k < 2; ++k) \
        acc[ai][bj][m][n] = __builtin_amdgcn_mfma_f32_16x16x32_bf16(Bt[n][k], At[m][k], acc[ai][bj][m][n], 0, 0, 0); __builtin_amdgcn_s_setprio(0); } while (0)
#define PG8_WAIT_V(n) asm volatile("s_waitcnt vmcnt(" #n ")" ::: "memory")
#define PG8_WAIT_L(n) asm volatile("s_waitcnt lgkmcnt(" #n ")" ::: "memory")
#define PG8_BAR __builtin_amdgcn_s_barrier()
#define PG8_SCHED __builtin_amdgcn_sched_barrier(0)
    Unit cur, nxt; int ui = 0;
    if (!S.next(0, cur)) return;
    f32x4 acc[2][2][4][2];
#pragma unroll
    for (int a = 0; a < 2; ++a)
#pragma unroll
        for (int b = 0; b < 2; ++b)
#pragma unroll
            for (int m = 0; m < 4; ++m)
#pragma unroll
                for (int n = 0; n < 2; ++n) acc[a][b][m][n] = (f32x4){0.f, 0.f, 0.f, 0.f};
    bf16x8 At[4][2], B0[2][2], B1[2][2];
    const char* cA = (const char*)g.A + (size_t)cur.pm * tstep; const char* cB = (const char*)g.Bt + (size_t)cur.pn * tstep;
    S.a_ready(cur);
    if constexpr (SP2) {
        PG8_STAGE(PG8_SB(0, 0), cB, voffB); PG8_STAGE(PG8_SB(0, 1), cB + hstep, voffB); PG8_STAGE(PG8_SA(0, 0), cA, voffA); PG8_STAGE(PG8_SA(0, 1), cA + hstep, voffA);
        if (wr == 1) PG8_BAR;
        PG8_WAIT_V(2); PG8_BAR;
        PG8_STAGE(PG8_SB(1, 0), cB + kstep, voffB); PG8_STAGE(PG8_SA(1, 0), cA + kstep, voffA); PG8_STAGE(PG8_SB(1, 1), cB + hstep + kstep, voffB);
        PG8_WAIT_V(6); PG8_BAR;
    } else {
        PG8_STAGE(PG8_SB(0, 0), cB, voffB); PG8_STAGE(PG8_SA(0, 0), cA, voffA); PG8_STAGE(PG8_SB(0, 1), cB + hstep, voffB); PG8_STAGE(PG8_SA(0, 1), cA + hstep, voffA);
        if (wr == 1) PG8_BAR;
        PG8_WAIT_V(4); PG8_BAR;
        PG8_STAGE(PG8_SB(1, 0), cB + kstep, voffB); PG8_STAGE(PG8_SA(1, 0), cA + kstep, voffA); PG8_STAGE(PG8_SB(1, 1), cB + hstep + kstep, voffB);
        PG8_WAIT_V(6); PG8_BAR;
    }
    for (;;) {
        const bool has_next = S.next(ui + 1, nxt);
        const char* nA = has_next ? (const char*)g.A + (size_t)nxt.pm * tstep : cA; const char* nB = has_next ? (const char*)g.Bt + (size_t)nxt.pn * tstep : cB;
        for (int t = 0; t < nt; t += 2) {
            const bool last = (t == nt - 2);
            const char* a1 = cA + (size_t)(t + 1) * kstep;
            const char* a2 = last ? nA : cA + (size_t)(t + 2) * kstep; const char* b2 = last ? nB : cB + (size_t)(t + 2) * kstep;
            const char* a3 = a2 + kstep; const char* b3 = b2 + kstep;
            if (last && has_next) S.a_ready(nxt);
            if constexpr (SP2) {
            PG8_LDB(B0, 0, 0); PG8_LDB(B1, 0, 1); PG8_SCHED; PG8_LDA(At, 0, 0); PG8_STAGE(PG8_SA(1, 1), a1 + hstep, voffA);
            PG8_WAIT_V(8); PG8_WAIT_L(0); PG8_BAR; PG8_MMA(0, 0, At, B0); PG8_MMA(0, 1, At, B1); PG8_BAR; PG8_SCHED;
            PG8_LDA(At, 0, 1); PG8_STAGE(PG8_SB(0, 0), b2, voffB); PG8_STAGE(PG8_SB(0, 1), b2 + hstep, voffB); PG8_STAGE(PG8_SA(0, 0), a2, voffA);
            PG8_WAIT_V(8); PG8_WAIT_L(0); PG8_BAR; PG8_MMA(1, 0, At, B0); PG8_MMA(1, 1, At, B1); PG8_BAR; PG8_SCHED;
            PG8_LDB(B0, 1, 0); PG8_LDB(B1, 1, 1); PG8_SCHED; PG8_LDA(At, 1, 0); PG8_STAGE(PG8_SA(0, 1), a2 + hstep, voffA);
            PG8_WAIT_V(8); PG8_WAIT_L(0); PG8_BAR; PG8_MMA(0, 0, At, B0); PG8_MMA(0, 1, At, B1); PG8_BAR; PG8_SCHED;
            PG8_LDA(At, 1, 1); PG8_STAGE(PG8_SB(1, 0), b3, voffB); PG8_STAGE(PG8_SB(1, 1), b3 + hstep, voffB); PG8_STAGE(PG8_SA(1, 0), a3, voffA);
            PG8_WAIT_V(8); PG8_WAIT_L(0); PG8_BAR; PG8_MMA(1, 0, At, B0); PG8_MMA(1, 1, At, B1); PG8_BAR; PG8_SCHED;
            } else {
            PG8_LDB(B0, 0, 0); PG8_SCHED; PG8_LDA(At, 0, 0); PG8_STAGE(PG8_SA(1, 1), a1 + hstep, voffA);
            PG8_WAIT_L(8); PG8_BAR; PG8_WAIT_L(0); PG8_MMA(0, 0, At, B0); PG8_BAR; PG8_SCHED;
            PG8_LDB(B1, 0, 1); PG8_STAGE(PG8_SB(0, 0), b2, voffB);
            PG8_BAR; PG8_WAIT_L(0); PG8_MMA(0, 1, At, B1); PG8_BAR;
            PG8_LDA(At, 0, 1); PG8_STAGE(PG8_SA(0, 0), a2, voffA);
            PG8_BAR; PG8_WAIT_L(0); PG8_MMA(1, 0, At, B0); PG8_BAR; PG8_SCHED;
            PG8_STAGE(PG8_SB(0, 1), b2 + hstep, voffB);
            PG8_WAIT_V(6); PG8_BAR; PG8_MMA(1, 1, At, B1); PG8_BAR;
            PG8_LDB(B0, 1, 0); PG8_SCHED; PG8_LDA(At, 1, 0); PG8_STAGE(PG8_SA(0, 1), a2 + hstep, voffA);
            PG8_WAIT_L(8); PG8_BAR; PG8_WAIT_L(0); PG8_MMA(0, 0, At, B0); PG8_BAR; PG8_SCHED;
            PG8_LDB(B1, 1, 1); PG8_STAGE(PG8_SB(1, 0), b3, voffB);
            PG8_BAR; PG8_WAIT_L(0); PG8_MMA(0, 1, At, B1); PG8_BAR;
            PG8_LDA(At, 1, 1); PG8_STAGE(PG8_SA(1, 0), a3, voffA);
            PG8_BAR; PG8_WAIT_L(0); PG8_MMA(1, 0, At, B0); PG8_BAR; PG8_SCHED;
            PG8_STAGE(PG8_SB(1, 1), b3 + hstep, voffB);
            PG8_WAIT_V(6); PG8_BAR; PG8_MMA(1, 1, At, B1); PG8_BAR;
            }
        }
        if constexpr (ALIGN_EPI) { if (wr == 0) PG8_BAR; }
        if constexpr (!Epi::AFTER_DRAIN) { E(acc, cur, wr, wc, fr, fq); S.done(cur); }
        if (!has_next) break;
#pragma unroll
        for (int a = 0; a < 2; ++a)
#pragma unroll
            for (int b = 0; b < 2; ++b)
#pragma unroll
                for (int m = 0; m < 4; ++m)
#pragma unroll
                    for (int n = 0; n < 2; ++n) acc[a][b][m][n] = (f32x4){0.f, 0.f, 0.f, 0.f};
        cur = nxt; cA = nA; cB = nB; ++ui;
        if constexpr (ALIGN_EPI) { if (wr == 1) PG8_BAR; }
    }
    PG8_WAIT_V(0);
    if constexpr (!ALIGN_EPI) { if (wr == 0) PG8_BAR; }
    PG8_BAR;
    if constexpr (Epi::AFTER_DRAIN) { E.fused(acc, cur, wr, wc, fr, fq, lds, wid, lane); S.done(cur); }
#undef PG8_SA
#undef PG8_SB
#undef PG8_STAGE
#undef PG8_LDA
#undef PG8_LDB
#undef PG8_MMA
#undef PG8_WAIT_V
#undef PG8_WAIT_L
#undef PG8_BAR
#undef PG8_SCHED
}
}

constexpr int NWAVES = 8;
constexpr int NB = 16, SEQ = 2048, NT = NB * SEQ, D = 1024, DEPTH = 2, INW = 13352;
constexpr int NPN_IN = 52, NIN_ROWS = 52 * 256 + 64;
constexpr float RMS_EPS = 1e-6f;
constexpr int MAXTILES = 320;
constexpr int PROWS = MAXTILES * 256;

constexpr size_t MiB = (size_t)1 << 20;
constexpr size_t WS_CTL = 0, CTL_ZERO_BYTES = 1 * MiB;
constexpr size_t WS_WIN = 1 * MiB;
constexpr size_t WS_WBR = 28 * MiB;
constexpr size_t WS_WOUT = 34 * MiB;
constexpr size_t WS_WRT = 36 * MiB;
constexpr size_t WS_ROUTE = 37 * MiB;
constexpr size_t WS_FB = 38 * MiB;
constexpr size_t WS_SSQS = 40 * MiB;
constexpr size_t WS_SSQM = 42 * MiB;
constexpr size_t WS_SMALL = 44 * MiB;
constexpr size_t WS_WGU = 52 * MiB;
constexpr size_t WS_WDN = 180 * MiB;
constexpr size_t WS_H = 244 * MiB;
constexpr size_t WS_YATT = 308 * MiB, WS_YSSD = 372 * MiB, WS_YML = 436 * MiB;
constexpr size_t WS_PROJ = 500 * MiB;
constexpr size_t WS_END = 756 * MiB;
constexpr size_t WS_HG = WS_PROJ, WS_ACT = WS_PROJ + 160 * MiB;
static_assert((size_t)PROWS * 1024 * 2 == 160 * MiB && WS_ACT + (size_t)PROWS * 512 * 2 <= WS_END, "moe overlay");
constexpr int CW_TMO = 0, CW_CODE = 1, CW_BAR = 4096, CW_CNT = 16384;

constexpr int RING_OFF = 0, RING_BYTES = 131072;
constexpr int LDSCTL_OFF = RING_BYTES, MISC_OFF = LDSCTL_OFF + 320, TAB_OFF = LDSCTL_OFF + 1024;
constexpr int LDS_BYTES = 147456;

#define GAS __attribute__((address_space(1)))
#define LAS __attribute__((address_space(3)))
typedef unsigned short bf16;
typedef unsigned v4u __attribute__((ext_vector_type(4)));
typedef unsigned v2u __attribute__((ext_vector_type(2)));
typedef float f32x4 __attribute__((ext_vector_type(4)));
typedef GAS unsigned gu32;
#define RLX_AGENT __ATOMIC_RELAXED, __HIP_MEMORY_SCOPE_AGENT
#define LDS_WAIT() asm volatile("s_waitcnt lgkmcnt(0)" ::: "memory")
__device__ __forceinline__ unsigned f2bf(float f) { unsigned u = __builtin_bit_cast(unsigned, f); return (u + 0x7fffu + ((u >> 16) & 1u)) >> 16; }
__device__ __forceinline__ unsigned pk2(float lo, float hi) { return f2bf(lo) | (f2bf(hi) << 16); }
__device__ __forceinline__ float bf2f(unsigned short u) { return __builtin_bit_cast(float, (unsigned)u << 16); }
__device__ __forceinline__ float blo(unsigned w) { return __builtin_bit_cast(float, w << 16); }
__device__ __forceinline__ float bhi(unsigned w) { return __builtin_bit_cast(float, w & 0xffff0000u); }
__device__ __forceinline__ float sigmoid_f(float x) { return 1.0f / (1.0f + expf(-x)); }
__device__ __forceinline__ float silu_f(float x) { return x / (1.0f + expf(-x)); }
__device__ __forceinline__ float logsigmoid_f(float x) { return fminf(x, 0.f) - log1pf(expf(-fabsf(x))); }
__device__ __forceinline__ float softplus_f(float x) { return fmaxf(x, 0.f) + log1pf(expf(-fabsf(x))); }
__device__ __forceinline__ float wave_sum(float v) {
#pragma unroll
    for (int o = 1; o < 64; o <<= 1) v += __shfl_xor(v, o);
    return v;
}
#define XB_TMO      128
#define XB_XCNT(j)  (256  + 64 * (j))
#define XB_XSUB(j)  (1280 + 64 * (j))
#define XB_XGEN(j)  (2304 + 64 * (j))
#define XB_TOP      3328
#define XB_TOPGEN   3392
#define XCD_BAR_WORDS 3456
#define XB_SPIN_CAP (1u << 20)

__device__ __forceinline__ unsigned xb_ld(unsigned* p)              { return __hip_atomic_load(p, __ATOMIC_RELAXED, __HIP_MEMORY_SCOPE_AGENT); }
__device__ __forceinline__ unsigned xb_add(unsigned* p, unsigned v) { return __hip_atomic_fetch_add(p, v, __ATOMIC_RELAXED, __HIP_MEMORY_SCOPE_AGENT); }
__device__ __forceinline__ unsigned xb_xcc_id() { return (unsigned)__builtin_amdgcn_s_getreg((3 << 11) | 20) & 0xFu; }
#define XB_SPIN(cond, bar) do { unsigned _sp = 0; while (cond) { __builtin_amdgcn_s_sleep(1); \
    if ((++_sp & 255u) == 0u) { if (xb_ld(&(bar)[XB_TMO])) break; if (_sp > XB_SPIN_CAP) { atomicAdd(&(bar)[XB_TMO], 1u); break; } } } } while (0)

struct XcdBarrier {
    unsigned* bar; unsigned x;
    volatile LAS unsigned* st;
};

__device__ __forceinline__ XcdBarrier xcd_barrier_post(unsigned* bar, volatile LAS unsigned* st) {
    XcdBarrier b; b.bar = bar; b.x = xb_xcc_id(); b.st = st;
    if (threadIdx.x == 0) (void)xb_add(&bar[XB_XCNT(b.x)], 1u);
    return b;
}
__device__ __forceinline__ void xcd_barrier_complete(unsigned* bar, unsigned x, unsigned& nloc, unsigned& nx) {
    const unsigned G = gridDim.x * gridDim.y * gridDim.z;
    unsigned sum, cnt, mine, sp = 0u;
    for (;;) {
        sum = 0u; cnt = 0u; mine = 0u;
#pragma nounroll
        for (unsigned j = 0; j < 16; ++j) { const unsigned c = xb_ld(&bar[XB_XCNT(j)]); sum += c; cnt += (c > 0u) ? 1u : 0u; mine = (j == x) ? c : mine; }
        if (sum == G) break;
        __builtin_amdgcn_s_sleep(1);
        if ((++sp & 255u) == 0u) { if (xb_ld(&bar[XB_TMO])) break; if (sp > XB_SPIN_CAP) { atomicAdd(&bar[XB_TMO], 1u); break; } }
    }
    nloc = mine > 0u ? mine : 1u; nx = cnt > 0u ? cnt : 1u;
}

__device__ __forceinline__ void xcd_barrier(const XcdBarrier& b) {
    asm volatile("s_waitcnt vmcnt(0)" ::: "memory");
    __syncthreads();
    if (threadIdx.x == 0) {
        unsigned* bar = b.bar;
        __builtin_amdgcn_s_waitcnt(0);
        unsigned nloc = b.st[0], nx = b.st[1];
        if (nloc == 0u) { xcd_barrier_complete(bar, b.x, nloc, nx); b.st[0] = nloc; b.st[1] = nx; }
        const unsigned old = xb_add(&bar[XB_XSUB(b.x)], 1u);
        const unsigned gen = old / nloc;
        if (old + 1u == (gen + 1u) * nloc) {
            __builtin_amdgcn_fence(__ATOMIC_RELEASE, "agent");
            asm volatile("s_waitcnt vmcnt(0)" ::: "memory");
            const unsigned og = xb_add(&bar[XB_TOP], 1u);
            const unsigned tg = og / nx;
            if (og + 1u == (tg + 1u) * nx) xb_add(&bar[XB_TOPGEN], 1u);
            else XB_SPIN(xb_ld(&bar[XB_TOPGEN]) == tg, bar);
            __builtin_amdgcn_fence(__ATOMIC_ACQUIRE, "agent");
            xb_add(&bar[XB_XGEN(b.x)], 1u);
            asm volatile("s_waitcnt vmcnt(0)" ::: "memory");
        } else {
            XB_SPIN(xb_ld(&bar[XB_XGEN(b.x)]) == gen, bar);
            __builtin_amdgcn_fence(__ATOMIC_ACQUIRE, "agent");
            asm volatile("s_waitcnt vmcnt(0)" ::: "memory");
        }
    }
    __syncthreads();
}


struct Args { const float* in[27]; float* out; unsigned char* ws; int ph_lo, ph_hi; };
typedef const __attribute__((address_space(4))) Args* KArgs;
__device__ __forceinline__ KArgs kargs() { KArgs p = (KArgs)__builtin_amdgcn_kernarg_segment_ptr(); asm volatile("" : "+s"(p)); return p; }
struct Frame {
    LAS unsigned char* lds;
    volatile LAS unsigned* MISC;
    gu32* ctl;
    int tid, lane, wave, G, bid;
    unsigned char* ws; float* out;
};
enum { I_X = 0, I_N1W, I_WIN, I_AFB, I_SCW, I_SCB, I_SDTB, I_SALOG, I_SD, I_SNW, I_MCW, I_MCB, I_MIB, I_MFB, I_MNW, I_GB, I_WBR, I_WOUT, I_N2W, I_WG, I_BG, I_WER, I_BER, I_WGATE, I_WUP, I_WDOWN, I_FNW };

__device__ __forceinline__ int incol(int n) {
    if (n < 1024) return 6176 + n;
    if (n < 2048) return 7200 + (n - 1024);
    if (n < 3072) return 8224 + (n - 2048);
    if (n < 4096) return 9256 + (n - 3072);
    if (n < 7168) return n - 4096;
    if (n < 10240) return 3088 + (n - 7168);
    if (n < 13312) return 10280 + (n - 10240);
    const int j = n - 13312;
    if (j < 16) return 3072 + j; if (j < 32) return 6160 + (j - 16); if (j < 36) return 9248 + (j - 32); if (j < 40) return 9252 + (j - 36); return -1;
}
__device__ __forceinline__ void tr_item(const float* cp, int ld, int K, bf16* WT, int n0, int k0, LAS float* scr, int lane) {
#pragma unroll 8
    for (int i = 0; i < 32; ++i) { const int kk = 2 * i + (lane >> 5); scr[kk * 33 + (lane & 31)] = cp ? cp[(size_t)(k0 + kk) * ld] : 0.f; }
    LDS_WAIT(); asm volatile("" ::: "memory");
    const int c = lane & 7;
#pragma unroll
    for (int j = 0; j < 4; ++j) { const int n = (lane >> 3) + 8 * j; const LAS float* s = scr + (8 * c) * 33 + n;
        v4u o; o.x = pk2(s[0 * 33], s[1 * 33]); o.y = pk2(s[2 * 33], s[3 * 33]); o.z = pk2(s[4 * 33], s[5 * 33]); o.w = pk2(s[6 * 33], s[7 * 33]);
        *(GAS v4u*)(WT + (size_t)(n0 + n) * K + k0 + 8 * c) = o; }
    LDS_WAIT(); asm volatile("" ::: "memory");
}
__device__ __forceinline__ void p_convert(Frame& F, KArgs A, int L) {
    LAS float* scr = (LAS float*)(F.lds + RING_OFF + F.wave * 16384);
    const int gw = F.bid * NWAVES + F.wave, NGW = F.G * NWAVES, lane = F.lane;
    constexpr int NBI = NIN_ROWS / 32, I_IN = 16 * NBI, I_BR = 3 * 512, I_OUT = 512, I_GU = 64 * 512, I_DN = 64 * 256;
    constexpr int NITEMS = I_IN + I_BR + I_OUT + I_GU + I_DN;
    const float* w_in = A->in[I_WIN] + (size_t)L * 1024 * INW;
    for (int it = gw; it < NITEMS; it += NGW) {
        int r = it;
        if (r < I_IN) { const int kb = r / NBI, nb = r % NBI; const int c = incol(nb * 32 + (lane & 31));
            tr_item(c < 0 ? nullptr : w_in + c, INW, 1024, (bf16*)(F.ws + WS_WIN), nb * 32, kb * 64, scr, lane); continue; }
        r -= I_IN;
        if (r < I_BR) { const int b = r / 512, rr = r % 512, kb = rr / 32, nb = rr % 32;
            tr_item(A->in[I_WBR] + (size_t)(L * 3 + b) * 1048576 + nb * 32 + (lane & 31), 1024, 1024, (bf16*)(F.ws + WS_WBR) + (size_t)b * 1048576, nb * 32, kb * 64, scr, lane); continue; }
        r -= I_BR;
        if (r < I_OUT) { const int kb = r / 32, nb = r % 32;
            tr_item(A->in[I_WOUT] + (size_t)L * 1048576 + nb * 32 + (lane & 31), 1024, 1024, (bf16*)(F.ws + WS_WOUT), nb * 32, kb * 64, scr, lane); continue; }
        r -= I_OUT;
        if (r < I_GU) { const int e = r / 512, rr = r % 512, kb = rr / 32, nb = rr % 32; const int n = nb * 32 + (lane & 31), q = n >> 3, i = n & 7;
            const float* src = ((i < 4) ? A->in[I_WGATE] : A->in[I_WUP]) + (size_t)(L * 64 + e) * 524288 + 4 * q + (i & 3);
            tr_item(src, 512, 1024, (bf16*)(F.ws + WS_WGU) + (size_t)e * 1048576, nb * 32, kb * 64, scr, lane); continue; }
        r -= I_GU;
        { const int e = r / 256, rr = r % 256, kb = rr / 32, nb = rr % 32;
            tr_item(A->in[I_WDOWN] + (size_t)(L * 64 + e) * 524288 + nb * 32 + (lane & 31), 1024, 512, (bf16*)(F.ws + WS_WDN) + (size_t)e * 524288, nb * 32, kb * 64, scr, lane); }
    }
    float* wrt = (float*)(F.ws + WS_WRT);
    const float* wg = A->in[I_WG] + (size_t)L * 1024 * 8; const float* we = A->in[I_WER] + (size_t)L * 1024 * 64;
    for (int idx = F.bid * 512 + F.tid; idx < 72 * 1024; idx += F.G * 512) { const int c = idx >> 10, k = idx & 1023; wrt[idx] = (c < 8) ? wg[k * 8 + c] : we[k * 64 + (c - 8)]; }
}

template <int COMBINE, int FINAL>
__device__ __forceinline__ void p_norm(Frame& F, const float* xin, float* X, const float* w, bf16* H) {
    const int gw = F.bid * NWAVES + F.wave, NGW = F.G * NWAVES, lane = F.lane;
    const int* tok_pos = (const int*)(F.ws + WS_ROUTE + 3 * 262144); const float* tok_w = (const float*)(F.ws + WS_ROUTE + 262144);
    const bf16* Y = (const bf16*)(F.ws + WS_HG);
    f32x4 wv[4];
#pragma unroll
    for (int j = 0; j < 4; ++j) wv[j] = ((const f32x4*)w)[lane + 64 * j];
    for (int m = gw; m < NT; m += NGW) {
        f32x4 v[4];
        const f32x4* xr = (const f32x4*)((COMBINE ? X : xin) + (size_t)m * D) + lane;
#pragma unroll
        for (int j = 0; j < 4; ++j) v[j] = xr[64 * j];
        if (COMBINE) {
            const int p0 = tok_pos[2 * m], p1 = tok_pos[2 * m + 1]; const float w0 = tok_w[2 * m], w1 = tok_w[2 * m + 1];
            const v2u* y0 = (const v2u*)(Y + (size_t)p0 * D) + lane; const v2u* y1 = (const v2u*)(Y + (size_t)p1 * D) + lane;
#pragma unroll
            for (int j = 0; j < 4; ++j) { const v2u a = y0[64 * j], b = y1[64 * j];
                v[j].x += w0 * blo(a.x) + w1 * blo(b.x); v[j].y += w0 * bhi(a.x) + w1 * bhi(b.x); v[j].z += w0 * blo(a.y) + w1 * blo(b.y); v[j].w += w0 * bhi(a.y) + w1 * bhi(b.y); }
            if (!FINAL) {
                f32x4* xo = (f32x4*)(X + (size_t)m * D) + lane;
#pragma unroll
                for (int j = 0; j < 4; ++j) xo[64 * j] = v[j];
            }
        }
        float s = 0.f;
#pragma unroll
        for (int j = 0; j < 4; ++j) s += (v[j].x * v[j].x + v[j].y * v[j].y) + (v[j].z * v[j].z + v[j].w * v[j].w);
        const float rstd = 1.0f / sqrtf(wave_sum(s) * (1.f / D) + RMS_EPS);
        if (FINAL) {
            f32x4* xo = (f32x4*)(X + (size_t)m * D) + lane;
#pragma unroll
            for (int j = 0; j < 4; ++j) xo[64 * j] = v[j] * rstd * wv[j];
        } else {
            GAS unsigned long long* o8 = (GAS unsigned long long*)(H + (size_t)m * D) + lane;
#pragma unroll
            for (int j = 0; j < 4; ++j) { const f32x4 y = v[j] * rstd * wv[j]; o8[64 * j] = (unsigned long long)pk2(y.x, y.y) | ((unsigned long long)pk2(y.z, y.w) << 32); }
        }
    }
}

__device__ __forceinline__ void p_small(Frame& F) {
    typedef short bf16x8 __attribute__((ext_vector_type(8)));
    const int gw = F.bid * NWAVES + F.wave, NGW = F.G * NWAVES, lane = F.lane, r = lane & 15, g = lane >> 4;
    const bf16* H = (const bf16*)(F.ws + WS_H); const bf16* W = (const bf16*)(F.ws + WS_WIN) + (size_t)(NPN_IN * 256) * 1024; float* SM = (float*)(F.ws + WS_SMALL);
    for (int task = gw; task < NT / 16; task += NGW) {
        const int m0 = task * 16;
        const bf16x8* ap = (const bf16x8*)(H + (size_t)(m0 + r) * D + 8 * g);
        const bf16x8* bp0 = (const bf16x8*)(W + (size_t)(r) * D + 8 * g); const bf16x8* bp1 = (const bf16x8*)(W + (size_t)(16 + r) * D + 8 * g); const bf16x8* bp2 = (const bf16x8*)(W + (size_t)(32 + r) * D + 8 * g);
        f32x4 c0 = (f32x4){0.f, 0.f, 0.f, 0.f}, c1 = c0, c2 = c0;
#pragma unroll 4
        for (int ks = 0; ks < 32; ++ks) { const bf16x8 a = ap[ks * 4], b0 = bp0[ks * 4], b1 = bp1[ks * 4], b2 = bp2[ks * 4];
            c0 = __builtin_amdgcn_mfma_f32_16x16x32_bf16(a, b0, c0, 0, 0, 0); c1 = __builtin_amdgcn_mfma_f32_16x16x32_bf16(a, b1, c1, 0, 0, 0); c2 = __builtin_amdgcn_mfma_f32_16x16x32_bf16(a, b2, c2, 0, 0, 0); }
#pragma unroll
        for (int i = 0; i < 4; ++i) { float* o = SM + (size_t)(m0 + 4 * g + i) * 64 + r; o[0] = c0[i]; o[16] = c1[i]; o[32] = c2[i]; }
    }
}

__device__ __forceinline__ void p_fcum(Frame& F, KArgs A, int L) {
    const int gw = F.bid * NWAVES + F.wave, lane = F.lane;
    if (gw >= NB * 16) return;
    const int b = gw >> 4, h = gw & 15; const float fb = A->in[I_AFB][L * 16 + h];
    const float* sm = (const float*)(F.ws + WS_SMALL) + (size_t)b * SEQ * 64 + h;
    float* out = (float*)(F.ws + WS_FB) + (size_t)gw * SEQ;
    float tot = 0.f;
    for (int i = 0; i < 32; ++i) tot += logsigmoid_f(sm[(size_t)(lane * 32 + i) * 64] + fb);
    float inc = tot;
#pragma unroll
    for (int o = 1; o < 64; o <<= 1) { const float t = __shfl_up(inc, o); if (lane >= o) inc += t; }
    float run = inc - tot;
    for (int i = 0; i < 32; ++i) { run += logsigmoid_f(sm[(size_t)(lane * 32 + i) * 64] + fb); out[lane * 32 + i] = run; }
}

__device__ __forceinline__ void att_simple_unit(Frame& F, int b, int h, int qb) {
    LAS float* sK = (LAS float*)(F.lds + RING_OFF); LAS float* sV = sK + 4096; LAS float* sF = sV + 4096;
    const bf16* Q = (const bf16*)(F.ws + WS_PROJ); const bf16* K = (const bf16*)(F.ws + WS_PROJ + pg8::SLAB); const bf16* V = (const bf16*)(F.ws + WS_PROJ + 2 * pg8::SLAB);
    const float* FB = (const float*)(F.ws + WS_FB) + (size_t)(b * 16 + h) * SEQ;
    bf16* O = (bf16*)(F.ws + WS_YATT);
    const int tid = F.tid, t = qb * 512 + tid; const size_t row = (size_t)b * SEQ + t;
    float q[64], o[64];
    { const v4u* qp = (const v4u*)(Q + row * D + h * 64);
#pragma unroll
      for (int i = 0; i < 8; ++i) { const v4u w = qp[i]; q[8 * i + 0] = blo(w.x) * 0.125f; q[8 * i + 1] = bhi(w.x) * 0.125f; q[8 * i + 2] = blo(w.y) * 0.125f; q[8 * i + 3] = bhi(w.y) * 0.125f;
          q[8 * i + 4] = blo(w.z) * 0.125f; q[8 * i + 5] = bhi(w.z) * 0.125f; q[8 * i + 6] = blo(w.w) * 0.125f; q[8 * i + 7] = bhi(w.w) * 0.125f; } }
#pragma unroll
    for (int d = 0; d < 64; ++d) o[d] = 0.f;
    const float Fq = FB[t]; float mrun = -INFINITY, l = 0.f;
    const int ntile = (qb * 512 + 512) / 64;
    const int key = tid >> 3, dc = (tid & 7) * 8;
    for (int kt = 0; kt < ntile; ++kt) {
        __syncthreads();
        { const size_t kr = ((size_t)b * SEQ + kt * 64 + key) * D + h * 64 + dc; const v4u kw = *(const v4u*)(K + kr), vw = *(const v4u*)(V + kr);
          LAS float* kd = sK + key * 64 + dc; LAS float* vd = sV + key * 64 + dc;
          kd[0] = blo(kw.x); kd[1] = bhi(kw.x); kd[2] = blo(kw.y); kd[3] = bhi(kw.y); kd[4] = blo(kw.z); kd[5] = bhi(kw.z); kd[6] = blo(kw.w); kd[7] = bhi(kw.w);
          vd[0] = blo(vw.x); vd[1] = bhi(vw.x); vd[2] = blo(vw.y); vd[3] = bhi(vw.y); vd[4] = blo(vw.z); vd[5] = bhi(vw.z); vd[6] = blo(vw.w); vd[7] = bhi(vw.w);
          if (tid < 64) sF[tid] = FB[kt * 64 + tid]; }
        __syncthreads();
        for (int j = 0; j < 64; ++j) {
            const int pos = kt * 64 + j;
            if (pos <= t) {
                float s = Fq - sF[j];
                const LAS f32x4* kp = (const LAS f32x4*)(sK + j * 64);
#pragma unroll
                for (int d4 = 0; d4 < 16; ++d4) { const f32x4 kv = kp[d4]; s += q[4 * d4] * kv.x + q[4 * d4 + 1] * kv.y + q[4 * d4 + 2] * kv.z + q[4 * d4 + 3] * kv.w; }
                const float mn = fmaxf(mrun, s), corr = __expf(mrun - mn), p = __expf(s - mn);
                l = l * corr + p; mrun = mn;
                const LAS f32x4* vp = (const LAS f32x4*)(sV + j * 64);
#pragma unroll
                for (int d4 = 0; d4 < 16; ++d4) { const f32x4 vv = vp[d4]; o[4 * d4] = o[4 * d4] * corr + p * vv.x; o[4 * d4 + 1] = o[4 * d4 + 1] * corr + p * vv.y; o[4 * d4 + 2] = o[4 * d4 + 2] * corr + p * vv.z; o[4 * d4 + 3] = o[4 * d4 + 3] * corr + p * vv.w; }
            }
        }
    }
    const float rl = 1.0f / l;
    v4u* op = (v4u*)(O + row * D + h * 64);
#pragma unroll
    for (int i = 0; i < 8; ++i) { v4u w; w.x = pk2(o[8 * i] * rl, o[8 * i + 1] * rl); w.y = pk2(o[8 * i + 2] * rl, o[8 * i + 3] * rl); w.z = pk2(o[8 * i + 4] * rl, o[8 * i + 5] * rl); w.w = pk2(o[8 * i + 6] * rl, o[8 * i + 7] * rl); op[i] = w; }
}
__device__ __forceinline__ void p_att_simple(Frame& F) {
    for (int u = F.bid; u < 1024; u += F.G) { const int qb = 3 - (u >> 8), bh = u & 255; att_simple_unit(F, bh >> 4, bh & 15, qb); }
    __syncthreads();
}

__device__ __forceinline__ void ssd_simple_unit(Frame& F, KArgs A, int L, int b, int h) {
    constexpr int TB = 32;
    LAS float* cv = (LAS float*)(F.lds + RING_OFF);
    LAS float* sdt = cv + TB * 320; LAS float* sda = sdt + TB; LAS float* yb = sda + TB;
    const int tid = F.tid, g = h >> 2;
    const bf16* SZ = (const bf16*)(F.ws + WS_PROJ); const bf16* XBC = (const bf16*)(F.ws + WS_PROJ + pg8::SLAB) + (size_t)b * SEQ * 2048;
    const float* SM = (const float*)(F.ws + WS_SMALL) + (size_t)b * SEQ * 64;
    bf16* YO = (bf16*)(F.ws + WS_YSSD); float* SSQ = (float*)(F.ws + WS_SSQS);
    int ch = -1;
    if (tid < 64) ch = h * 64 + tid; else if (tid < 192) ch = 1024 + g * 128 + (tid - 64); else if (tid < 320) ch = 1536 + g * 128 + (tid - 192);
    float cw0 = 0.f, cw1 = 0.f, cw2 = 0.f, cw3 = 0.f, cb = 0.f;
    if (ch >= 0) { const float* cw = A->in[I_SCW] + (size_t)L * 4 * 2048 + ch; cw0 = cw[0]; cw1 = cw[2048]; cw2 = cw[4096]; cw3 = cw[6144]; cb = A->in[I_SCB][L * 2048 + ch]; }
    const float Aneg = -expf(A->in[I_SALOG][L * 16 + h]), dtb = A->in[I_SDTB][L * 16 + h], Dh = A->in[I_SD][L * 16 + h];
    float st[16];
#pragma unroll
    for (int j = 0; j < 16; ++j) st[j] = 0.f;
    const int p = tid >> 3, nq = tid & 7;
    float r0 = 0.f, r1 = 0.f, r2 = 0.f;
    for (int t0 = 0; t0 < SEQ; t0 += TB) {
        if (ch >= 0) {
#pragma unroll
            for (int s = 0; s < TB; ++s) { const float r3 = bf2f(XBC[(size_t)(t0 + s) * 2048 + ch]); const float y = cb + cw0 * r0 + cw1 * r1 + cw2 * r2 + cw3 * r3; cv[s * 320 + tid] = silu_f(y); r0 = r1; r1 = r2; r2 = r3; }
        } else if (tid < 320 + TB) { const int s = tid - 320; const float dt = softplus_f(SM[(size_t)(t0 + s) * 64 + 16 + h] + dtb); sdt[s] = dt; sda[s] = expf(dt * Aneg); }
        __syncthreads();
        for (int s = 0; s < TB; ++s) {
            const float xv = cv[s * 320 + p], dt = sdt[s], dA = sda[s], dx = dt * xv; float acc = 0.f;
#pragma unroll
            for (int j = 0; j < 16; ++j) { st[j] = st[j] * dA + dx * cv[s * 320 + 64 + nq * 16 + j]; acc += cv[s * 320 + 192 + nq * 16 + j] * st[j]; }
            acc += __shfl_xor(acc, 1); acc += __shfl_xor(acc, 2); acc += __shfl_xor(acc, 4);
            if (nq == 0) { const float z = bf2f(SZ[((size_t)b * SEQ + t0 + s) * D + h * 64 + p]); yb[s * 64 + p] = (acc + Dh * xv) * silu_f(z); }
        }
        __syncthreads();
        if (tid < TB) { float q = 0.f; for (int i = 0; i < 64; ++i) { const float y = yb[tid * 64 + i]; q += y * y; } SSQ[((size_t)b * SEQ + t0 + tid) * 16 + h] = q; }
        for (int i = tid; i < TB * 64; i += 512) { const int s = i >> 6, pp = i & 63; YO[((size_t)b * SEQ + t0 + s) * D + h * 64 + pp] = (bf16)f2bf(yb[i]); }
        __syncthreads();
    }
}
__device__ __forceinline__ void p_ssd_simple(Frame& F, KArgs A, int L) {
    for (int u = F.bid; u < NB * 16; u += F.G) ssd_simple_unit(F, A, L, u >> 4, u & 15);
}

__device__ __forceinline__ void ml_simple_unit(Frame& F, KArgs A, int L, int b, int h, int vs) {
    constexpr int TB = 16;
    LAS float* sq = (LAS float*)(F.lds + RING_OFF); LAS float* sk = sq + TB * 256; LAS float* sv = sk + TB * 256; LAS float* sg = sv + TB * 64;
    LAS float* red = sg + 2 * TB; LAS float* redd = red + 2 * 8 * 64; LAS float* hb = redd + 16;
    const int tid = F.tid, w = tid >> 6, v = tid & 63;
    const bf16* MQ = (const bf16*)(F.ws + WS_PROJ); const bf16* MK = (const bf16*)(F.ws + WS_PROJ + pg8::SLAB); const bf16* MV = (const bf16*)(F.ws + WS_PROJ + 2 * pg8::SLAB);
    const float* SM = (const float*)(F.ws + WS_SMALL) + (size_t)b * SEQ * 64;
    bf16* YO = (bf16*)(F.ws + WS_YML); float* SSQ = (float*)(F.ws + WS_SSQM);
    const bool isk = tid >= 256; const int cc = h * 256 + (tid & 255), cidx = (isk ? 1024 : 0) + cc;
    const bf16* src = (isk ? MK : MQ) + (size_t)b * SEQ * D + cc;
    const float* cw = A->in[I_MCW] + (size_t)L * 4 * 2048 + cidx; const float cw0 = cw[0], cw1 = cw[2048], cw2 = cw[4096], cw3 = cw[6144], cb = A->in[I_MCB][L * 2048 + cidx];
    const float ib = A->in[I_MIB][L * 4 + h], fbias = A->in[I_MFB][L * 4 + h];
    const float ksc = isk ? 0.0625f : 1.0f;
    float C[32], n[32];
#pragma unroll
    for (int j = 0; j < 32; ++j) { C[j] = 0.f; n[j] = 0.f; }
    float m = 0.f, r0 = 0.f, r1 = 0.f, r2 = 0.f;
    for (int t0 = 0; t0 < SEQ; t0 += TB) {
#pragma unroll
        for (int s = 0; s < TB; ++s) { const float r3 = bf2f(src[(size_t)(t0 + s) * D]); const float y = cb + cw0 * r0 + cw1 * r1 + cw2 * r2 + cw3 * r3; (isk ? sk : sq)[s * 256 + (tid & 255)] = silu_f(y) * ksc; r0 = r1; r1 = r2; r2 = r3; }
        for (int i = tid; i < TB * 64; i += 512) { const int s = i >> 6, j = i & 63; sv[i] = bf2f(MV[((size_t)b * SEQ + t0 + s) * D + h * 256 + vs * 64 + j]); }
        if (tid < TB) { const float* r = SM + (size_t)(t0 + tid) * 64; sg[2 * tid] = r[32 + h] + ib; sg[2 * tid + 1] = logsigmoid_f(r[36 + h] + fbias); }
        __syncthreads();
        for (int s = 0; s < TB; ++s) {
            const float ig = sg[2 * s], lf = sg[2 * s + 1]; const float mn = fmaxf(lf + m, ig); const float fs = expf(lf + m - mn), is = expf(ig - mn); m = mn;
            const float vv = sv[s * 64 + v]; float nump = 0.f, denp = 0.f;
#pragma unroll
            for (int j = 0; j < 32; ++j) { const float kd = sk[s * 256 + w * 32 + j] * is, qd = sq[s * 256 + w * 32 + j]; C[j] = fs * C[j] + kd * vv; nump += qd * C[j]; n[j] = fs * n[j] + kd; denp += qd * n[j]; }
            const int par = s & 1;
            red[(par * 8 + w) * 64 + v] = nump; if (v == 0) redd[par * 8 + w] = denp;
            __syncthreads();
            if (w == 0) { float num = 0.f, den = 0.f;
#pragma unroll
                for (int ww = 0; ww < 8; ++ww) { num += red[(par * 8 + ww) * 64 + v]; den += redd[par * 8 + ww]; }
                hb[s * 64 + v] = num / fmaxf(fabsf(den), expf(-m)); }
        }
        __syncthreads();
        if (tid < TB) { float q = 0.f; for (int i = 0; i < 64; ++i) { const float y = hb[tid * 64 + i]; q += y * y; } SSQ[((size_t)b * SEQ + t0 + tid) * 16 + h * 4 + vs] = q; }
        for (int i = tid; i < TB * 64; i += 512) { const int s = i >> 6, j = i & 63; YO[((size_t)b * SEQ + t0 + s) * D + h * 256 + vs * 64 + j] = (bf16)f2bf(hb[i]); }
        __syncthreads();
    }
}
__device__ __forceinline__ void p_ml_simple(Frame& F, KArgs A, int L) {
    for (int u = F.bid; u < NB * 16; u += F.G) ml_simple_unit(F, A, L, u >> 4, (u >> 2) & 3, u & 3);
}

template <int ML>
__device__ __forceinline__ void p_fix(Frame& F, KArgs A, int L) {
    const int gw = F.bid * NWAVES + F.wave, NGW = F.G * NWAVES, lane = F.lane;
    bf16* Y = (bf16*)(F.ws + (ML ? WS_YML : WS_YSSD)); const float* SSQ = (const float*)(F.ws + (ML ? WS_SSQM : WS_SSQS));
    const bf16* MO = (const bf16*)(F.ws + WS_PROJ + 3 * pg8::SLAB);
    const float* nw = A->in[ML ? I_MNW : I_SNW] + (size_t)L * D;
    f32x4 wv[4];
#pragma unroll
    for (int j = 0; j < 4; ++j) wv[j] = ((const f32x4*)nw)[lane + 64 * j];
    for (int m = gw; m < NT; m += NGW) {
        const f32x4* sp = (const f32x4*)(SSQ + (size_t)m * 16);
        v2u* yp = (v2u*)(Y + (size_t)m * D) + lane; const v2u* op = (const v2u*)(MO + (size_t)m * D) + lane;
#pragma unroll
        for (int j = 0; j < 4; ++j) {
            const f32x4 q = sp[j]; const float rstd = 1.0f / sqrtf(((q.x + q.y) + (q.z + q.w)) * (1.f / 256.f) + RMS_EPS);
            const v2u y = yp[64 * j]; f32x4 r; r.x = blo(y.x) * rstd * wv[j].x; r.y = bhi(y.x) * rstd * wv[j].y; r.z = blo(y.y) * rstd * wv[j].z; r.w = bhi(y.y) * rstd * wv[j].w;
            if (ML) { const v2u o = op[64 * j]; r.x *= sigmoid_f(blo(o.x)); r.y *= sigmoid_f(bhi(o.x)); r.z *= sigmoid_f(blo(o.y)); r.w *= sigmoid_f(bhi(o.y)); }
            v2u w; w.x = pk2(r.x, r.y); w.y = pk2(r.z, r.w); yp[64 * j] = w;
        }
    }
}

__device__ __forceinline__ void p_router(Frame& F, KArgs A, int L) {
    const int gw = F.bid * NWAVES + F.wave, NGW = F.G * NWAVES, lane = F.lane;
    const float* X = F.out; bf16* H = (bf16*)(F.ws + WS_H);
    const float* w = A->in[I_N2W] + (size_t)L * D; const f32x4* wrt = (const f32x4*)(F.ws + WS_WRT);
    const float* bg = A->in[I_BG] + L * 8; const float* ber = A->in[I_BER] + L * 64;
    int* tok_e = (int*)(F.ws + WS_ROUTE); float* tok_w = (float*)(F.ws + WS_ROUTE + 262144); int* tok_rank = (int*)(F.ws + WS_ROUTE + 2 * 262144);
    unsigned* cnt = (unsigned*)F.ctl + CW_CNT + 64 * L;
    f32x4 wv[4];
#pragma unroll
    for (int j = 0; j < 4; ++j) wv[j] = ((const f32x4*)w)[lane + 64 * j];
    for (int m = gw; m < NT; m += NGW) {
        f32x4 v[4]; const f32x4* xr = (const f32x4*)(X + (size_t)m * D) + lane; float s = 0.f;
#pragma unroll
        for (int j = 0; j < 4; ++j) { v[j] = xr[64 * j]; s += (v[j].x * v[j].x + v[j].y * v[j].y) + (v[j].z * v[j].z + v[j].w * v[j].w); }
        const float rstd = 1.0f / sqrtf(wave_sum(s) * (1.f / D) + RMS_EPS);
        GAS unsigned long long* o8 = (GAS unsigned long long*)(H + (size_t)m * D) + lane;
#pragma unroll
        for (int j = 0; j < 4; ++j) { v[j] = v[j] * rstd * wv[j]; o8[64 * j] = (unsigned long long)pk2(v[j].x, v[j].y) | ((unsigned long long)pk2(v[j].z, v[j].w) << 32); }
        float r0 = 0.f, r1 = 0.f;
        for (int c = 0; c < 72; ++c) {
            float a = 0.f;
#pragma unroll
            for (int j = 0; j < 4; ++j) { const f32x4 ww = wrt[c * 256 + lane + 64 * j]; a += (v[j].x * ww.x + v[j].y * ww.y) + (v[j].z * ww.z + v[j].w * ww.w); }
            a = wave_sum(a);
            if (c < 64) { if (lane == c) r0 = a; } else { if (lane == c - 64) r1 = a; }
        }
        float gl[8], gmax; int gsel = 0;
#pragma unroll
        for (int j = 0; j < 8; ++j) gl[j] = __shfl(r0, j) + bg[j];
        gmax = gl[0];
#pragma unroll
        for (int j = 1; j < 8; ++j) if (gl[j] > gmax) { gmax = gl[j]; gsel = j; }
        float den = 0.f;
#pragma unroll
        for (int j = 0; j < 8; ++j) den += expf(gl[j] - gmax);
        const float pg = 1.0f / den;
        float el[8];
#pragma unroll
        for (int j = 0; j < 8; ++j) { const int idx = 8 + gsel * 8 + j; const float a0 = __shfl(r0, idx & 63), a1 = __shfl(r1, idx & 63); el[j] = (idx < 64 ? a0 : a1) + ber[gsel * 8 + j]; }
        int i1 = 0; float v1 = el[0];
#pragma unroll
        for (int j = 1; j < 8; ++j) if (el[j] > v1) { v1 = el[j]; i1 = j; }
        int i2 = -1; float v2 = -INFINITY;
#pragma unroll
        for (int j = 0; j < 8; ++j) if (j != i1 && el[j] > v2) { v2 = el[j]; i2 = j; }
        const float ex = expf(v2 - v1); const float w1 = pg / (1.0f + ex), w2 = pg * ex / (1.0f + ex);
        if (lane == 0) {
            const int e1 = gsel * 8 + i1, e2 = gsel * 8 + i2;
            const unsigned k1 = __hip_atomic_fetch_add(cnt + e1, 1u, RLX_AGENT), k2 = __hip_atomic_fetch_add(cnt + e2, 1u, RLX_AGENT);
            tok_e[2 * m] = e1; tok_e[2 * m + 1] = e2; tok_w[2 * m] = w1; tok_w[2 * m + 1] = w2; tok_rank[2 * m] = (int)k1; tok_rank[2 * m + 1] = (int)k2;
        }
    }
}

__device__ __forceinline__ void moe_table(Frame& F, int L) {
    LAS int* tab = (LAS int*)(F.lds + TAB_OFF);
    if (F.tid == 0) { const unsigned* cnt = (const unsigned*)F.ctl + CW_CNT + 64 * L; int acc = 0;
        for (int e = 0; e < 64; ++e) { tab[e] = acc; acc += (int)((__hip_atomic_load(cnt + e, RLX_AGENT) + 255u) >> 8); } tab[64] = acc; }
    __syncthreads();
}
__device__ __forceinline__ void p_gather(Frame& F, int L) {
    moe_table(F, L);
    const LAS int* tab = (const LAS int*)(F.lds + TAB_OFF);
    const int gw = F.bid * NWAVES + F.wave, NGW = F.G * NWAVES, lane = F.lane;
    const int* tok_e = (const int*)(F.ws + WS_ROUTE); const int* tok_rank = (const int*)(F.ws + WS_ROUTE + 2 * 262144); int* tok_pos = (int*)(F.ws + WS_ROUTE + 3 * 262144);
    const bf16* H = (const bf16*)(F.ws + WS_H); bf16* HG = (bf16*)(F.ws + WS_HG);
    for (int a = gw; a < 2 * NT; a += NGW) {
        const int e = tok_e[a], pos = tab[e] * 256 + tok_rank[a];
        if (lane == 0) tok_pos[a] = pos;
        const v4u* s = (const v4u*)(H + (size_t)(a >> 1) * D) + lane; v4u* d = (v4u*)(HG + (size_t)pos * D) + lane;
        d[0] = s[0]; d[64] = s[64];
    }
}

template <unsigned MASK>
__global__ void __launch_bounds__(NWAVES * 64, 2) mk_fwd(Args) {
    extern __shared__ __attribute__((aligned(16))) unsigned char lds[];
    { const int t0 = threadIdx.x; for (int u = t0; u < (LDS_BYTES - LDSCTL_OFF) / 4; u += NWAVES * 64) ((LAS unsigned*)((LAS unsigned char*)lds + LDSCTL_OFF))[u] = 0u; }
    __syncthreads();
    XcdBarrier bar = xcd_barrier_post((unsigned*)(kargs()->ws + WS_CTL) + CW_BAR, (volatile LAS unsigned*)((LAS unsigned char*)lds + MISC_OFF) + 8);
    int pid = 0;
#define PH_BEGIN(k) if constexpr ((MASK >> (k)) & 1u) if (kargs()->ph_lo <= pid && pid < kargs()->ph_hi) { KArgs A = kargs(); Frame F; \
        { int t_ = threadIdx.x, b_ = blockIdx.x, g_ = gridDim.x; asm volatile("" : "+v"(t_)); asm volatile("" : "+s"(b_), "+s"(g_)); \
          F.lds = (LAS unsigned char*)lds; F.MISC = (volatile LAS unsigned*)(F.lds + MISC_OFF); F.tid = t_; F.lane = t_ & 63; F.wave = __builtin_amdgcn_readfirstlane(t_ >> 6); \
          F.G = g_; F.bid = b_; F.ws = A->ws; F.out = A->out; F.ctl = (gu32*)(F.ws + WS_CTL); } unsigned char* const ws = F.ws;
#define PH_END   if (pid + 1 < kargs()->ph_hi) { bar.bar = (unsigned*)(kargs()->ws + WS_CTL) + CW_BAR; xcd_barrier(bar); } } ++pid;
#define GEMM_IN(EPI, E, pn0, npn) do { pg8::Gemm g{(const pg8::bf16_t*)(ws + WS_H), (const pg8::bf16_t*)(ws + WS_WIN), NT, NPN_IN * 256, 1024}; \
        pg8::RangeOrder S; S.init(NT, (npn), (pn0), F.G, F.bid); \
        pg8::gemm_phase<EPI, pg8::RangeOrder, true, true>(F.lds + RING_OFF, g, S, E); } while (0)

    for (int L = 0; L < DEPTH; ++L) {
        PH_BEGIN(0) p_convert(F, A, L); PH_END
        PH_BEGIN(1)
            if (L == 0) p_norm<0, 0>(F, A->in[I_X], F.out, A->in[I_N1W], (bf16*)(ws + WS_H));
            else p_norm<1, 0>(F, nullptr, F.out, A->in[I_N1W] + (size_t)L * D, (bf16*)(ws + WS_H));
        PH_END
        PH_BEGIN(2) p_small(F); PH_END
        PH_BEGIN(3) { pg8::EpiProj E{ws + WS_PROJ}; GEMM_IN(pg8::EpiProj, E, 0, 16); } PH_END
        PH_BEGIN(4) p_ml_simple(F, A, L); PH_END
        PH_BEGIN(5) p_fix<1>(F, A, L); PH_END
        PH_BEGIN(6) p_fcum(F, A, L); PH_END
        PH_BEGIN(7) { pg8::EpiProj E{ws + WS_PROJ}; GEMM_IN(pg8::EpiProj, E, 16, 12); } PH_END
        PH_BEGIN(8) p_att_simple(F); PH_END
        PH_BEGIN(9) { pg8::EpiProj E{ws + WS_PROJ}; GEMM_IN(pg8::EpiProj, E, 28, 12); } PH_END
        PH_BEGIN(10) p_ssd_simple(F, A, L); PH_END
        PH_BEGIN(11) p_fix<0>(F, A, L); PH_END
        PH_BEGIN(12) { pg8::EpiGate E{ws + WS_PROJ, A->in[I_GB] + (size_t)L * 3072}; GEMM_IN(pg8::EpiGate, E, 40, 12); } PH_END
        for (int b = 0; b < 3; ++b) {
            PH_BEGIN(13)
                const size_t yoff = (b == 0) ? WS_YATT : (b == 1) ? WS_YSSD : WS_YML;
                pg8::Gemm g{(const pg8::bf16_t*)(ws + yoff), (const pg8::bf16_t*)(ws + WS_WBR) + (size_t)b * 1048576, NT, 1024, 1024};
                pg8::RangeOrder S; S.init(NT, 4, 0, F.G, F.bid);
                pg8::EpiBranch E{(pg8::bf16_t*)(ws + WS_H), (const pg8::bf16_t*)(ws + WS_PROJ + (size_t)b * pg8::SLAB), b == 0 ? 1 : 0};
                pg8::gemm_phase<pg8::EpiBranch, pg8::RangeOrder, true, true>(F.lds + RING_OFF, g, S, E);
            PH_END
        }
        PH_BEGIN(14)
            pg8::Gemm g{(const pg8::bf16_t*)(ws + WS_H), (const pg8::bf16_t*)(ws + WS_WOUT), NT, 1024, 1024};
            pg8::RangeOrder S; S.init(NT, 4, 0, F.G, F.bid);
            pg8::EpiResid E{L == 0 ? A->in[I_X] : (const float*)F.out, F.out};
            pg8::gemm_phase<pg8::EpiResid, pg8::RangeOrder, true, true>(F.lds + RING_OFF, g, S, E);
        PH_END
        PH_BEGIN(15) p_router(F, A, L); PH_END
        PH_BEGIN(16) p_gather(F, L); PH_END
        PH_BEGIN(17)
            moe_table(F, L);
            pg8::Gemm g{(const pg8::bf16_t*)(ws + WS_HG), (const pg8::bf16_t*)(ws + WS_WGU), PROWS, 65536, 1024};
            pg8::MoeOrder S{(const PG8_LAS int*)(F.lds + TAB_OFF), F.G, F.bid};
            pg8::EpiGU E{(pg8::bf16_t*)(ws + WS_ACT)};
            pg8::gemm_phase<pg8::EpiGU, pg8::MoeOrder, true, true>(F.lds + RING_OFF, g, S, E);
        PH_END
        PH_BEGIN(18)
            moe_table(F, L);
            pg8::Gemm g{(const pg8::bf16_t*)(ws + WS_ACT), (const pg8::bf16_t*)(ws + WS_WDN), PROWS, 65536, 512};
            pg8::MoeOrder S{(const PG8_LAS int*)(F.lds + TAB_OFF), F.G, F.bid};
            pg8::EpiRows E{(pg8::bf16_t*)(ws + WS_HG)};
            pg8::gemm_phase<pg8::EpiRows, pg8::MoeOrder, true, true>(F.lds + RING_OFF, g, S, E);
        PH_END
    }
    PH_BEGIN(19) p_norm<1, 1>(F, nullptr, F.out, A->in[I_FNW], nullptr); PH_END
#ifdef DBG_STOP
    if constexpr ((MASK >> 20) & 1u) {
        KArgs A = kargs(); unsigned char* ws = A->ws; float* out = A->out; const size_t offs[4] = {DBG_D0, DBG_D1, DBG_D2, DBG_D3};
        for (size_t i = (size_t)blockIdx.x * 512 + threadIdx.x; i < (size_t)NT * D; i += (size_t)gridDim.x * 512) { float v = 0.f;
            for (int k = 0; k < 4; ++k) if (offs[k]) v += bf2f(((const bf16*)(ws + offs[k]))[i]);
            out[i] = v; }
    }
#endif
#undef PH_BEGIN
#undef PH_END
#undef GEMM_IN
}
constexpr int PIDS_PER_LAYER = 21;

typedef void (*kern_t)(Args);
extern "C" void kernel_launch(void* const* d_in, const int* in_sizes, int n_in, void* d_out, int out_size, void* d_ws, size_t ws_size, hipStream_t stream) {
    static int grid = 0;
#if MK_N_LAUNCHES == 1
    static const kern_t kerns[1] = { mk_fwd<0xffffffffu> };
    constexpr int NK = 1;
#else
    static const kern_t kerns[21] = { mk_fwd<1u << 0>, mk_fwd<1u << 1>, mk_fwd<1u << 2>, mk_fwd<1u << 3>, mk_fwd<1u << 4>, mk_fwd<1u << 5>, mk_fwd<1u << 6>, mk_fwd<1u << 7>, mk_fwd<1u << 8>, mk_fwd<1u << 9>,
                                      mk_fwd<1u << 10>, mk_fwd<1u << 11>, mk_fwd<1u << 12>, mk_fwd<1u << 13>, mk_fwd<1u << 14>, mk_fwd<1u << 15>, mk_fwd<1u << 16>, mk_fwd<1u << 17>, mk_fwd<1u << 18>, mk_fwd<1u << 19>, mk_fwd<1u << 20> };
    constexpr int NK = 21;
#endif
    if (grid == 0) {
        if (n_in != 27 || in_sizes[0] != NT * D || out_size != NT * D || ws_size < WS_END) { fprintf(stderr, "kernel_launch: unexpected shapes (n_in %d, in0 %d, out %d, ws %zu < %zu); nothing launched\n", n_in, n_in > 0 ? in_sizes[0] : -1, out_size, ws_size, (size_t)WS_END); grid = -1; return; }
        int dev = 0, cus = 0, per_cu = 0;
        if (hipGetDevice(&dev) != hipSuccess || hipDeviceGetAttribute(&cus, hipDeviceAttributeMultiprocessorCount, dev) != hipSuccess) { grid = -1; return; }
        for (int k = 0; k < NK; ++k)
            if (hipFuncSetAttribute((const void*)kerns[k], hipFuncAttributeMaxDynamicSharedMemorySize, LDS_BYTES) != hipSuccess) { fprintf(stderr, "kernel_launch: hipFuncSetAttribute failed\n"); grid = -1; return; }
        if (hipOccupancyMaxActiveBlocksPerMultiprocessor(&per_cu, (const void*)kerns[0], NWAVES * 64, LDS_BYTES) != hipSuccess || per_cu < 1) { fprintf(stderr, "kernel_launch: occupancy query says %d\n", per_cu); }
        (void)hipGetLastError();
        grid = cus;
    }
    if (grid < 0) return;
    if (hipMemsetAsync((char*)d_ws + WS_CTL, 0, CTL_ZERO_BYTES, stream) != hipSuccess) return;
    Args a{};
    for (int i = 0; i < 27; ++i) a.in[i] = (const float*)d_in[i];
    a.out = (float*)d_out; a.ws = (unsigned char*)d_ws;
    constexpr int NPH = DEPTH * PIDS_PER_LAYER + 1;
#if MK_N_LAUNCHES == 1
    a.ph_lo = 0; a.ph_hi = NPH;
    hipLaunchKernelGGL(kerns[0], dim3(grid), dim3(NWAVES * 64), LDS_BYTES, stream, a);
#else
    static const int kind_of[PIDS_PER_LAYER] = {0, 1, 2, 3, 4, 5, 6, 7, 8, 9, 10, 11, 12, 13, 13, 13, 14, 15, 16, 17, 18};
#ifdef DBG_STOP
    constexpr int NPH_RUN = DBG_STOP;
#else
    constexpr int NPH_RUN = NPH;
#endif
    for (int p = 0; p < NPH_RUN; ++p) { a.ph_lo = p; a.ph_hi = p + 1; const int k = (p == NPH - 1) ? 19 : kind_of[p % PIDS_PER_LAYER];
        hipLaunchKernelGGL(kerns[k], dim3(grid), dim3(NWAVES * 64), LDS_BYTES, stream, a); }
#ifdef DBG_STOP
    if (DBG_D0) { a.ph_lo = 1000; a.ph_hi = 1000; hipLaunchKernelGGL(kerns[20], dim3(grid), dim3(NWAVES * 64), LDS_BYTES, stream, a); }
#endif
#endif
    const hipError_t le = hipPeekAtLastError();
    if (le != hipSuccess) fprintf(stderr, "kernel_launch: launch failed: %s\n", hipGetErrorName(le));
}
```

```cpp
#define MK_N_LAUNCHES 1
#define MOE_TABLE_ONCE 1
#include <hip/hip_runtime.h>
#include <cstdio>
#include <cstdint>
#ifndef MK_N_LAUNCHES
#define MK_N_LAUNCHES 1
#endif
#ifndef PHMASK
#define PHMASK 0xffffffffffffffffull
#endif
#ifndef USE_SIMPLE_ML
#define USE_SIMPLE_ML 0
#endif
#ifndef USE_SIMPLE_SSD
#define USE_SIMPLE_SSD 0
#endif
#ifndef USE_SIMPLE_ATT
#define USE_SIMPLE_ATT 0
#endif
#ifndef REPEAT_MASK
#define REPEAT_MASK 0
#endif
#ifndef ATT_THRL
#define ATT_THRL 24
#endif
#ifndef GEMM_ALIGN
#define GEMM_ALIGN true
#endif
#ifndef GEMM_SP2
#define GEMM_SP2 true
#endif
#ifndef PROBE_BAR2
#define PROBE_BAR2 0
#endif
#ifndef PROBE_CHUNK_BAR
#define PROBE_CHUNK_BAR 0
#endif
#ifndef PROBE_DUP_X
#define PROBE_DUP_X 0
#endif
#ifndef PROBE_SEC
#define PROBE_SEC 0
#endif
#ifndef PG8_WGM
#define PG8_WGM 8
#endif
#ifndef USE_EPI_CONV
#define USE_EPI_CONV 1
#endif
#ifndef USE_GUEST_CVT
#define USE_GUEST_CVT 1
#endif
#ifndef ATT_GUEST
#define ATT_GUEST 0
#endif
#ifndef FIX_PURE
#define FIX_PURE 1
#endif
#ifndef MOE_ROWSKIP
#define MOE_ROWSKIP 2
#endif
#ifndef PROBE_ML2
#define PROBE_ML2 0
#endif
#ifndef PROBE_COPY
#define PROBE_COPY 0
#endif
#ifndef USE_NT
#define USE_NT 1
#endif
#if USE_NT
#define NT_LOAD(p) __builtin_nontemporal_load(p)
#define NT_STORE(v, p) __builtin_nontemporal_store((v), (p))
#else
#define NT_LOAD(p) (*(p))
#define NT_STORE(v, p) (*(p) = (v))
#endif
#ifndef NT_EPI
#define NT_EPI 0
#endif
#if NT_EPI
#define EPI_STORE(v, p) __builtin_nontemporal_store((v), (p))
#else
#define EPI_STORE(v, p) (*(p) = (v))
#endif
#ifndef MOE_B_NT
#define MOE_B_NT 0
#endif
#ifndef ROUTER_NT
#define ROUTER_NT 0
#endif
#ifndef SSD_ZPRE
#define SSD_ZPRE 1
#endif
#ifndef SSD_VEARLY
#define SSD_VEARLY 0
#endif
#ifndef RESID_SSQ
#define RESID_SSQ 1
#endif
#ifndef GATE_FUSE
#define GATE_FUSE 1
#endif
#ifndef MOE_XCD
#define MOE_XCD 1
#endif
#ifndef ATT_PK
#define ATT_PK 1
#endif
#ifndef ATT_KBPRE
#define ATT_KBPRE 0
#endif
#ifndef PROBE_EPINULL
#define PROBE_EPINULL 0
#endif
#ifndef ATT_PRE
#define ATT_PRE 1
#endif
#ifndef GEMM_CHAIN
#define GEMM_CHAIN 0
#endif
#ifndef PHASE_SPLIT
#define PHASE_SPLIT 0
#endif
#ifndef ROUTER_2LVL
#define ROUTER_2LVL 1
#endif
#ifndef ROUTER_NOATOM
#define ROUTER_NOATOM 0
#endif
#ifndef MOE_TABLE_ONCE
#define MOE_TABLE_ONCE 0
#endif
namespace pg8 {
#define PG8_LAS __attribute__((address_space(3)))
typedef unsigned short bf16_t;
typedef short bf16x8 __attribute__((ext_vector_type(8)));
typedef float f32x4 __attribute__((ext_vector_type(4)));
typedef unsigned u32x4 __attribute__((ext_vector_type(4)));
typedef unsigned u32x2 __attribute__((ext_vector_type(2)));
constexpr int BM = 256, BK = 64, HALF = 128, HTB = HALF * BK * 2  , STAGE_BYTES = 8 * HTB, NXCD = 8, WGM = PG8_WGM;

__host__ __device__ __forceinline__ int lds_byte(int r, int c) { const int st = (r >> 4) * 2 + (c >> 5), rr = r & 15, cc = c & 31, ob = rr * 64 + cc * 2; return st * 1024 + (ob ^ (((ob >> 9) & 1) << 5)); }
__host__ __device__ __forceinline__ void stage_rc(int b, int& R, int& C) { const int st = b / 1024, sb = b % 1024, swz = sb ^ (((sb >> 9) & 1) << 5); R = (st >> 1) * 16 + swz / 64; C = (st & 1) * 32 + (swz % 64) / 2; }
__host__ __device__ __forceinline__ int perm32(int rho) { const int n = rho >> 4, i = rho & 15; return 8 * (i >> 2) + 4 * n + (i & 3); }

constexpr int MOE_ORDER_OFF = 768;
struct Unit { int pm, pn; int rows; };
struct Gemm { const bf16_t* A; const bf16_t* Bt; int M, N, K; };

struct StaticOrder {
    static constexpr bool ROWSKIP = false, B_NT = false;
    int nM, nN, nwg, G, c;
    __host__ __device__ void init(int M, int N, int G_, int c_) { nM = M / BM; nN = N / BM; nwg = nM * nN; G = G_; c = c_; }
    __host__ __device__ bool next(int i, Unit& u) const {
        const long L = (long)i * G + c; if (L >= nwg) return false;
        int wgid = (int)L; { const int q = nwg / NXCD, r = nwg % NXCD, xcd = wgid % NXCD, off = wgid / NXCD; wgid = (xcd < r ? xcd * (q + 1) : r * (q + 1) + (xcd - r) * q) + off; }
        const int nig = WGM * nN, gid = wgid / nig, fm = gid * WGM, gsz = (nM - fm) < WGM ? (nM - fm) : WGM;
        u.pm = fm + ((wgid % nig) % gsz); u.pn = (wgid % nig) / gsz; return true;
    }
    __device__ __forceinline__ void a_ready(const Unit&) const {}
    __device__ __forceinline__ void done(const Unit&) const {}
};

typedef float cvt_f32x2 __attribute__((ext_vector_type(2))); typedef __bf16 cvt_bf16x2 __attribute__((ext_vector_type(2)));
__device__ __forceinline__ unsigned cvt_pk_bf16(float lo, float hi) { const cvt_f32x2 v = {lo, hi}; const cvt_bf16x2 b = __builtin_convertvector(v, cvt_bf16x2); return __builtin_bit_cast(unsigned, b); }
typedef float f32x2 __attribute__((ext_vector_type(2)));
__device__ __forceinline__ f32x2 gelu_pk(f32x2 v) {
    const f32x2 av = __builtin_elementwise_abs(v), d = av * 0.2316418882f + 1.0f;
    f32x2 t; t.x = __builtin_amdgcn_rcpf(d.x); t.y = __builtin_amdgcn_rcpf(d.y);
    f32x2 q = t * 0.5307027145f + (-0.7265760135f); q = q * t + 0.7107068705f; q = q * t + (-0.142248368f); q = q * t + 0.127414796f; q = q * t;
    const f32x2 s = (v * v) * (-0.72134752044f);
    f32x2 e; e.x = __builtin_amdgcn_exp2f(s.x); e.y = __builtin_amdgcn_exp2f(s.y);
    const f32x2 m = v * (q * e), r = v - m;
    f32x2 o; o.x = v.x < 0.f ? m.x : r.x; o.y = v.y < 0.f ? m.y : r.y; return o;
}

__device__ __forceinline__ float fast_sigmoid(float x) { return __builtin_amdgcn_rcpf(1.0f + __expf(-x)); }
__device__ __forceinline__ float bf_lo(unsigned w) { return __builtin_bit_cast(float, w << 16); }
__device__ __forceinline__ float bf_hi(unsigned w) { return __builtin_bit_cast(float, w & 0xffff0000u); }
constexpr size_t SLAB = (size_t)64 << 20;

struct EpiProj {
    static constexpr bool PERM = true, AFTER_DRAIN = false;
    unsigned char* proj;
    __device__ __forceinline__ void operator()(const f32x4 (&acc)[2][2][4][2], const Unit& u, int wr, int wc, int fr, int fq) const {
        const int pn = u.pn; const int row0 = u.pm * BM + wr * 64 + fr;
        int ldc = 1024, colt; size_t boff;
        if (pn < 16) { boff = (size_t)(pn >> 2) * SLAB; colt = (pn & 3) * 256; }
        else if (pn < 28) { const int q = pn - 16; boff = (size_t)(q >> 2) * SLAB; colt = (q & 3) * 256; }
        else if (pn < 32) { boff = 0; colt = (pn - 28) * 256; }
        else { boff = SLAB; ldc = 2048; colt = (pn - 32) * 256; }
        bf16_t* base = (bf16_t*)(proj + boff) + colt + wc * 32 + 8 * fq;
        const float sc = (!USE_SIMPLE_ATT && pn >= 16 && pn < 20) ? 0.125f * 1.4426950408889634f : 1.0f;
#pragma unroll
        for (int ai = 0; ai < 2; ++ai)
#pragma unroll
            for (int m = 0; m < 4; ++m) { bf16_t* rowp = base + (size_t)(row0 + ai * HALF + m * 16) * ldc;
#pragma unroll
                for (int bj = 0; bj < 2; ++bj) { const f32x4 v0 = acc[ai][bj][m][0] * sc, v1 = acc[ai][bj][m][1] * sc;
                    u32x4 w; w.x = cvt_pk_bf16(v0[0], v0[1]); w.y = cvt_pk_bf16(v0[2], v0[3]); w.z = cvt_pk_bf16(v1[0], v1[1]); w.w = cvt_pk_bf16(v1[2], v1[3]);
                    EPI_STORE(w, (u32x4*)(rowp + bj * HALF)); } }
    }
};
template <int CTRL> __device__ __forceinline__ float dppf(float v) { return __builtin_bit_cast(float, __builtin_amdgcn_update_dpp(0, __builtin_bit_cast(int, v), CTRL, 0xF, 0xF, true)); }
struct EpiProjConv {
    static constexpr bool PERM = true, AFTER_DRAIN = false;
    unsigned char* proj; bf16_t* d0a; bf16_t* d1a; const float* cwa; const float* cba; bf16_t* rawha; float sc1a;
    bf16_t* d0b; bf16_t* d1b; const float* cwb; const float* cbb; bf16_t* rawhb;
    __device__ __forceinline__ void operator()(const f32x4 (&acc)[2][2][4][2], const Unit& u, int wr, int wc, int fr, int fq) const {
        const int pn = u.pn; const int row0 = u.pm * BM + wr * 64 + fr;
        const int mode = pn >= 28 ? 1 : 0;
        bf16_t* const d0 = mode ? d0b : d0a; bf16_t* const d1 = mode ? d1b : d1a; const float* const cw = mode ? cwb : cwa; const float* const cb = mode ? cbb : cba; bf16_t* const rawh = mode ? rawhb : rawha; const float sc1 = mode ? 1.0f : sc1a;
        int q, which; bool conv;
        if (mode == 0) { q = pn; conv = q < 8; which = q >> 2; } else { q = pn - 28; conv = q >= 4; which = (q - 4) >> 2; }
        if (!conv) {
            bf16_t* base = (bf16_t*)(proj + (mode == 0 ? (size_t)(q >> 2) * SLAB : (size_t)0)) + (q & 3) * 256 + wc * 32 + 8 * fq;
#pragma unroll
            for (int ai = 0; ai < 2; ++ai)
#pragma unroll
                for (int m = 0; m < 4; ++m) { bf16_t* rowp = base + (size_t)(row0 + ai * HALF + m * 16) * 1024;
#pragma unroll
                    for (int bj = 0; bj < 2; ++bj) { const f32x4 v0 = acc[ai][bj][m][0], v1 = acc[ai][bj][m][1];
                        u32x4 w; w.x = cvt_pk_bf16(v0[0], v0[1]); w.y = cvt_pk_bf16(v0[2], v0[3]); w.z = cvt_pk_bf16(v1[0], v1[1]); w.w = cvt_pk_bf16(v1[2], v1[3]);
                        EPI_STORE(w, (u32x4*)(rowp + bj * HALF)); } }
            return;
        }
        bf16_t* dst = (which ? d1 : d0) + (q & 3) * 256 + wc * 32 + 8 * fq; const float sc = which ? sc1 : 1.0f;
        const int cc0 = which * 1024 + (q & 3) * 256 + wc * 32 + 8 * fq;
        const int blk0 = u.pm * 4 + wr;
#pragma unroll
        for (int bj = 0; bj < 2; ++bj)
#pragma unroll
        for (int h = 0; h < 2; ++h) {
            const int cc = cc0 + bj * HALF + 4 * h;
            const f32x4 w0 = *(const f32x4*)(cw + cc), w1 = *(const f32x4*)(cw + 2048 + cc), w2 = *(const f32x4*)(cw + 4096 + cc), w3 = *(const f32x4*)(cw + 6144 + cc), bb = *(const f32x4*)(cb + cc);
#pragma unroll
            for (int ai = 0; ai < 2; ++ai) {
                f32x4 xp = {0.f, 0.f, 0.f, 0.f};
#pragma unroll
                for (int m = 0; m < 4; ++m) {
                    const f32x4 x = acc[ai][bj][m][h]; float y[4];
#pragma unroll
                    for (int e = 0; e < 4; ++e) {
                        const float h1 = dppf<0x111>(x[e]) + dppf<0x10F>(xp[e]);
                        const float h2 = dppf<0x112>(x[e]) + dppf<0x10E>(xp[e]);
                        const float h3 = dppf<0x113>(x[e]) + dppf<0x10D>(xp[e]);
                        const float t = bb[e] + w3[e] * x[e] + w2[e] * h1 + w1[e] * h2 + w0[e] * h3;
                        y[e] = t * fast_sigmoid(t) * sc; }
                    const size_t r = (size_t)(row0 + ai * HALF + m * 16);
                    u32x2 o; o.x = cvt_pk_bf16(y[0], y[1]); o.y = cvt_pk_bf16(y[2], y[3]);
                    EPI_STORE(o, (u32x2*)(dst + r * 1024 + bj * HALF + 4 * h));
                    if (m == 0 || m == 3) {
                        const bool lo3 = (m == 0) && fr < 3, hi3 = (m == 3) && fr >= 13;
                        if (lo3 || hi3) { const int blk = blk0 + 2 * ai + (hi3 ? 1 : 0), slot = hi3 ? fr - 13 : 3 + fr;
                            u32x2 rw; rw.x = cvt_pk_bf16(x[0], x[1]); rw.y = cvt_pk_bf16(x[2], x[3]);
                            *(u32x2*)(rawh + ((size_t)blk * 6 + slot) * 2048 + cc) = rw; } }
                    xp = x;
                }
            }
        }
    }
};

struct EpiNull {
    static constexpr bool PERM = true, AFTER_DRAIN = false;
    __device__ __forceinline__ void operator()(const f32x4 (&acc)[2][2][4][2], const Unit&, int, int, int, int) const {
#pragma unroll
        for (int ai = 0; ai < 2; ++ai)
#pragma unroll
            for (int bj = 0; bj < 2; ++bj)
#pragma unroll
                for (int m = 0; m < 4; ++m) asm volatile("" :: "v"(acc[ai][bj][m][0]), "v"(acc[ai][bj][m][1]));
    }
};
struct EpiGate {
    static constexpr bool PERM = true, AFTER_DRAIN = false;
    unsigned char* proj; const float* gate_bias;
    __device__ __forceinline__ void operator()(const f32x4 (&acc)[2][2][4][2], const Unit& u, int wr, int wc, int fr, int fq) const {
        const int q = u.pn - 40; const int row0 = u.pm * BM + wr * 64 + fr;
        bf16_t* base = (bf16_t*)(proj + (size_t)(q >> 2) * SLAB) + (q & 3) * 256 + wc * 32 + 8 * fq;
        const float* bp = gate_bias + q * 256 + wc * 32 + 8 * fq;
#pragma unroll
        for (int bj = 0; bj < 2; ++bj) { const f32x4 b0 = *(const f32x4*)(bp + bj * HALF), b1 = *(const f32x4*)(bp + bj * HALF + 4);
#pragma unroll
            for (int ai = 0; ai < 2; ++ai)
#pragma unroll
                for (int m = 0; m < 4; ++m) { f32x4 v0 = acc[ai][bj][m][0] + b0, v1 = acc[ai][bj][m][1] + b1;
#pragma unroll
                    for (int e = 0; e < 4; ++e) { v0[e] = fast_sigmoid(v0[e]); v1[e] = fast_sigmoid(v1[e]); }
                    u32x4 w; w.x = cvt_pk_bf16(v0[0], v0[1]); w.y = cvt_pk_bf16(v0[2], v0[3]); w.z = cvt_pk_bf16(v1[0], v1[1]); w.w = cvt_pk_bf16(v1[2], v1[3]);
                    EPI_STORE(w, (u32x4*)(base + (size_t)(row0 + ai * HALF + m * 16) * 1024 + bj * HALF)); } }
    }
};

struct EpiBranch {
    static constexpr bool PERM = true, AFTER_DRAIN = false;
    bf16_t* U; const bf16_t* G; int first;
    __device__ __forceinline__ void operator()(const f32x4 (&acc)[2][2][4][2], const Unit& u, int wr, int wc, int fr, int fq) const {
        const int row0 = u.pm * BM + wr * 64 + fr, col0 = u.pn * BM + wc * 32 + 8 * fq;
#pragma unroll
        for (int ai = 0; ai < 2; ++ai)
#pragma unroll
            for (int mh = 0; mh < 2; ++mh) {
                u32x4 g[2][2], o[2][2];
#pragma unroll
                for (int mm = 0; mm < 2; ++mm)
#pragma unroll
                    for (int bj = 0; bj < 2; ++bj) { const size_t ro = (size_t)(row0 + ai * HALF + (2 * mh + mm) * 16) * 1024 + col0 + bj * HALF;
                        g[mm][bj] = NT_LOAD((const u32x4*)(G + ro)); o[mm][bj] = (u32x4){0u, 0u, 0u, 0u}; if (!first) o[mm][bj] = *(const u32x4*)(U + ro); }
#pragma unroll
                for (int mm = 0; mm < 2; ++mm)
#pragma unroll
                    for (int bj = 0; bj < 2; ++bj) { const int m = 2 * mh + mm; const size_t ro = (size_t)(row0 + ai * HALF + m * 16) * 1024 + col0 + bj * HALF;
                        const f32x4 a0 = acc[ai][bj][m][0], a1 = acc[ai][bj][m][1]; const u32x4 gg = g[mm][bj], oo = o[mm][bj]; u32x4 w;
                        w.x = cvt_pk_bf16(bf_lo(oo.x) + bf_lo(gg.x) * a0[0], bf_hi(oo.x) + bf_hi(gg.x) * a0[1]);
                        w.y = cvt_pk_bf16(bf_lo(oo.y) + bf_lo(gg.y) * a0[2], bf_hi(oo.y) + bf_hi(gg.y) * a0[3]);
                        w.z = cvt_pk_bf16(bf_lo(oo.z) + bf_lo(gg.z) * a1[0], bf_hi(oo.z) + bf_hi(gg.z) * a1[1]);
                        w.w = cvt_pk_bf16(bf_lo(oo.w) + bf_lo(gg.w) * a1[2], bf_hi(oo.w) + bf_hi(gg.w) * a1[3]);
                        *(u32x4*)(U + ro) = w; }
            }
    }
};

struct EpiResid {
    static constexpr bool PERM = true, AFTER_DRAIN = false;
    const float* src; float* dst; float* ssq;
    __device__ __forceinline__ void operator()(const f32x4 (&acc)[2][2][4][2], const Unit& u, int wr, int wc, int fr, int fq) const {
        const int row0 = u.pm * BM + wr * 64 + fr, col0 = u.pn * BM + wc * 32 + 8 * fq;
#pragma unroll
        for (int ai = 0; ai < 2; ++ai)
#pragma unroll
            for (int mh = 0; mh < 2; ++mh) {
                f32x4 s0[2][2], s1[2][2];
#pragma unroll
                for (int mm = 0; mm < 2; ++mm)
#pragma unroll
                    for (int bj = 0; bj < 2; ++bj) { const size_t ro = (size_t)(row0 + ai * HALF + (2 * mh + mm) * 16) * 1024 + col0 + bj * HALF; s0[mm][bj] = NT_LOAD((const f32x4*)(src + ro)); s1[mm][bj] = NT_LOAD((const f32x4*)(src + ro + 4)); }
#pragma unroll
                for (int mm = 0; mm < 2; ++mm) { const int m = 2 * mh + mm; float q = 0.f;
#pragma unroll
                    for (int bj = 0; bj < 2; ++bj) { const size_t ro = (size_t)(row0 + ai * HALF + m * 16) * 1024 + col0 + bj * HALF;
                        const f32x4 o0 = s0[mm][bj] + acc[ai][bj][m][0], o1 = s1[mm][bj] + acc[ai][bj][m][1];
                        *(f32x4*)(dst + ro) = o0; *(f32x4*)(dst + ro + 4) = o1;
                        if (RESID_SSQ) q += ((o0[0] * o0[0] + o0[1] * o0[1]) + (o0[2] * o0[2] + o0[3] * o0[3])) + ((o1[0] * o1[0] + o1[1] * o1[1]) + (o1[2] * o1[2] + o1[3] * o1[3])); }
                    if (RESID_SSQ) { q += __shfl_xor(q, 16); q += __shfl_xor(q, 32); if (fq == 0) ssq[(size_t)(row0 + ai * HALF + m * 16) * 16 + u.pn * 4 + wc] = q; } }
            }
    }
};

struct EpiGU {
    static constexpr bool PERM = true, AFTER_DRAIN = false;
    bf16_t* ACT;
    __device__ __forceinline__ void operator()(const f32x4 (&acc)[2][2][4][2], const Unit& u, int wr, int wc, int fr, int fq) const {
        const int row0 = u.pm * BM + wr * 64 + fr, col0 = (u.pn & 3) * 128 + wc * 16 + 4 * fq;
#pragma unroll
        for (int ai = 0; ai < 2; ++ai)
#pragma unroll
            for (int m = 0; m < 4; ++m) { bf16_t* rowp = ACT + (size_t)(row0 + ai * HALF + m * 16) * 512 + col0;
#pragma unroll
                for (int bj = 0; bj < 2; ++bj) { const f32x4 g = acc[ai][bj][m][0], v = acc[ai][bj][m][1]; float r[4];
#pragma unroll
                    for (int e = 0; e < 4; ++e) r[e] = g[e] * fast_sigmoid(g[e]) * v[e];
                    uint2 w; w.x = cvt_pk_bf16(r[0], r[1]); w.y = cvt_pk_bf16(r[2], r[3]);
                    *(uint2*)(rowp + bj * 64) = w; } }
    }
};

struct EpiRows {
    static constexpr bool PERM = true, AFTER_DRAIN = false;
    bf16_t* Y;
    __device__ __forceinline__ void operator()(const f32x4 (&acc)[2][2][4][2], const Unit& u, int wr, int wc, int fr, int fq) const {
        const int row0 = u.pm * BM + wr * 64 + fr, col0 = (u.pn & 3) * BM + wc * 32 + 8 * fq;
#pragma unroll
        for (int ai = 0; ai < 2; ++ai)
#pragma unroll
            for (int m = 0; m < 4; ++m) { bf16_t* rowp = Y + (size_t)(row0 + ai * HALF + m * 16) * 1024 + col0;
#pragma unroll
                for (int bj = 0; bj < 2; ++bj) { const f32x4 v0 = acc[ai][bj][m][0], v1 = acc[ai][bj][m][1];
                    u32x4 w; w.x = cvt_pk_bf16(v0[0], v0[1]); w.y = cvt_pk_bf16(v0[2], v0[3]); w.z = cvt_pk_bf16(v1[0], v1[1]); w.w = cvt_pk_bf16(v1[2], v1[3]);
                    *(u32x4*)(rowp + bj * HALF) = w; } }
    }
};

struct RangeOrder {
    static constexpr bool GATHER = false, ROWSKIP = false, B_NT = false; const int* row_tok; const PG8_LAS int* tok_lds;
    StaticOrder S; int pn0, gap_at, gap_len;
    __device__ void init(int M, int npn, int pn0_, int G, int c, int gap_at_ = 1 << 30, int gap_len_ = 0) { S.init(M, npn * BM, G, c); pn0 = pn0_; gap_at = gap_at_; gap_len = gap_len_; }
    __device__ __forceinline__ bool next(int i, Unit& u) const { if (!S.next(i, u)) return false; u.pn += pn0; if (u.pn >= gap_at) u.pn += gap_len; return true; }
    __device__ __forceinline__ void a_ready(const Unit&) const {}
    __device__ __forceinline__ void done(const Unit&) const {}
};
struct ConstOrder {
    static constexpr bool GATHER = false, ROWSKIP = false, B_NT = false; const int* row_tok; const PG8_LAS int* tok_lds;
    int n;
    __device__ __forceinline__ bool next(int i, Unit& u) const { if (i >= n) return false; u.pm = 0; u.pn = 0; u.rows = 256; return true; }
    __device__ __forceinline__ void a_ready(const Unit&) const {}
    __device__ __forceinline__ void done(const Unit&) const {}
};
template <bool G_>
struct MoeOrderT {
    static constexpr bool GATHER = G_, ROWSKIP = (MOE_ROWSKIP != 0), B_NT = MOE_B_NT;
    const PG8_LAS int* tile_start;
    int G, c; const int* row_tok; const PG8_LAS int* tok_lds;
    __device__ __forceinline__ bool next(int i, Unit& u) const {
        const int q = (MOE_XCD && (G & 7) == 0) ? (c & 7) * (G >> 3) + (c >> 3) : c;
        const int L = i * G + q, j = L >> 2; if (j >= tile_start[64]) return false;
        const int ent = tile_start[MOE_ORDER_OFF + j];
        u.pm = ent & 511; u.pn = ((ent >> 9) & 63) * 4 + (L & 3); u.rows = ent >> 15; return true;
    }
    __device__ __forceinline__ void a_ready(const Unit&) const {}
    __device__ __forceinline__ void done(const Unit&) const {}
};
typedef MoeOrderT<false> MoeOrder; typedef MoeOrderT<true> MoeOrderG;
template <class Epi, class Sched, bool ALIGN_EPI = false, bool SP2 = false, bool CH_IN = false, bool CH_OUT = false>
__device__ __forceinline__ void gemm_phase(PG8_LAS unsigned char* lds, const Gemm g, const Sched& S, const Epi& E, const char* chA = nullptr, const char* chB = nullptr) {
    static_assert(!(CH_IN || CH_OUT) || (ALIGN_EPI && SP2 && !Epi::AFTER_DRAIN && !Sched::GATHER), "chained calls: aligned epilogues, SP2 loop, plain A");
    static_assert(SP2 || !Sched::GATHER, "the gathered-A form exists only in the SP2 loop");
    int tid_ = threadIdx.x; asm volatile("" : "+v"(tid_));
    const int tid = tid_, wid = __builtin_amdgcn_readfirstlane(tid >> 6), lane = tid & 63, wr = wid >> 2, wc = wid & 3, fr = lane & 15, fq = lane >> 4;
    const int K = g.K, nt = K / BK;
    constexpr bool GATH = Sched::GATHER;
    unsigned voffA[2], voffB[2], voffG[2][2];
#pragma unroll
    for (int i = 0; i < 2; ++i) { int R, C; stage_rc(tid * 16 + i * 8192, R, C); const int Rb = Epi::PERM ? ((R & ~31) + perm32(R & 31)) : R;
        voffA[i] = (unsigned)(R * K + C) * 2u; voffB[i] = (unsigned)(Rb * K + C) * 2u; }
    const size_t kstep = (size_t)(BK * 2);
    const size_t hstep = (size_t)HALF * K * 2;
    const size_t tstep = 2 * hstep;
    const unsigned ldsw = (unsigned)wid * 1024u;
    const int aoff = lds_byte(wr * 64 + fr, fq * 8), boff = lds_byte(wc * 32 + fr, fq * 8);
#define PG8_SA(b, h) (((b) * 2 + (h)) * HTB)
#define PG8_SB(b, h) ((4 + (b) * 2 + (h)) * HTB)
#define PG8_STAGE(bufoff, gbase, voff) do { _Pragma("unroll") for (int _i = 0; _i < 2; ++_i) \
        __builtin_amdgcn_global_load_lds((const unsigned*)((const char*)(gbase) + (voff)[_i]), (PG8_LAS unsigned*)(lds + (bufoff) + ldsw + _i * 8192), 16, 0, 0); } while (0)
#define PG8_STAGE_B(bufoff, gbase, voff) do { _Pragma("unroll") for (int _i = 0; _i < 2; ++_i) \
        __builtin_amdgcn_global_load_lds((const unsigned*)((const char*)(gbase) + (voff)[_i]), (PG8_LAS unsigned*)(lds + (bufoff) + ldsw + _i * 8192), 16, 0, Sched::B_NT ? 2 : 0); } while (0)
#define PG8_STAGE_A(bufoff, gptr, hf) do { if constexpr (GATH) { PG8_STAGE(bufoff, gptr, voffG[hf]); } else { PG8_STAGE(bufoff, (gptr) + (hf) * hstep, voffA); } } while (0)
#define PG8_TOKDMA(u_, slot) do { if (wid < 4) __builtin_amdgcn_global_load_lds((const unsigned*)(S.row_tok + (u_).pm * BM + wid * 64 + lane), (PG8_LAS unsigned*)(S.tok_lds + (slot) * 256 + wid * 64), 4, 0, 0); } while (0)
#define PG8_GOFF(slot) do { _Pragma("unroll") for (int h_ = 0; h_ < 2; ++h_) _Pragma("unroll") for (int i_ = 0; i_ < 2; ++i_) { int R_, C_; stage_rc(tid * 16 + i_ * 8192, R_, C_); voffG[h_][i_] = ((unsigned)S.tok_lds[(slot) * 256 + h_ * HALF + R_] * (unsigned)K + (unsigned)C_) * 2u; } } while (0)
#define PG8_LDA(dst, b, h) do { _Pragma("unroll") for (int m = 0; m < 4; ++m) _Pragma("unroll") for (int k = 0; k < 2; ++k) dst[m][k] = *(const PG8_LAS bf16x8*)(lds + PG8_SA(b, h) + aoff + m * 2048 + k * 1024); } while (0)
#define PG8_LDB(dst, b, h) do { _Pragma("unroll") for (int n = 0; n < 2; ++n) _Pragma("unroll") for (int k = 0; k < 2; ++k) dst[n][k] = *(const PG8_LAS bf16x8*)(lds + PG8_SB(b, h) + boff + n * 2048 + k * 1024); } while (0)
#define PG8_MMA(ai, bj, At, Bt) do { __builtin_amdgcn_s_setprio(1); _Pragma("unroll") for (int m = 0; m < 4; ++m) _Pragma("unroll") for (int n = 0; n < 2; ++n) _Pragma("unroll") for (int k = 0; k < 2; ++k) \
        acc[ai][bj][m][n] = __builtin_amdgcn_mfma_f32_16x16x32_bf16(Bt[n][k], At[m][k], acc[ai][bj][m][n], 0, 0, 0); __builtin_amdgcn_s_setprio(0); } while (0)
#define PG8_WAIT_V(n) asm volatile("s_waitcnt vmcnt(" #n ")" ::: "memory")
#define PG8_WAIT_L(n) asm volatile("s_waitcnt lgkmcnt(" #n ")" ::: "memory")
#define PG8_BAR __builtin_amdgcn_s_barrier()
#define PG8_SCHED __builtin_amdgcn_sched_barrier(0)
    Unit cur, nxt; int ui = 0;
    if (!S.next(0, cur)) return;
    constexpr bool RS = Sched::ROWSKIP;
    bool do0 = true, do1 = true; if constexpr (RS) { do0 = cur.rows > wr * 64; do1 = cur.rows > 128 + wr * 64; }
#define PG8_IF0 if (!RS || do0)
#define PG8_IF1 if (!RS || do1)
#define PG8_IFB if (!RS || do0 || do1)
    f32x4 acc[2][2][4][2];
#pragma unroll
    for (int a = 0; a < 2; ++a)
#pragma unroll
        for (int b = 0; b < 2; ++b)
#pragma unroll
            for (int m = 0; m < 4; ++m)
#pragma unroll
                for (int n = 0; n < 2; ++n) acc[a][b][m][n] = (f32x4){0.f, 0.f, 0.f, 0.f};
    bf16x8 At[4][2], B0[2][2], B1[2][2];
    const char* cA = GATH ? (const char*)g.A : (const char*)g.A + (size_t)cur.pm * tstep; const char* cB = (const char*)g.Bt + (size_t)cur.pn * tstep;
    if constexpr (GATH) { PG8_TOKDMA(cur, 0); PG8_WAIT_V(0); PG8_BAR; PG8_GOFF(0); }
    if constexpr (!CH_IN) {
    S.a_ready(cur);
    if constexpr (SP2) {
        PG8_STAGE_B(PG8_SB(0, 0), cB, voffB); PG8_STAGE_B(PG8_SB(0, 1), cB + hstep, voffB); PG8_STAGE_A(PG8_SA(0, 0), cA, 0); PG8_STAGE_A(PG8_SA(0, 1), cA, 1);
        if (wr == 1) PG8_BAR;
        PG8_WAIT_V(2); PG8_BAR;
        PG8_STAGE_B(PG8_SB(1, 0), cB + kstep, voffB); PG8_STAGE_A(PG8_SA(1, 0), cA + kstep, 0); PG8_STAGE_B(PG8_SB(1, 1), cB + hstep + kstep, voffB);
        PG8_WAIT_V(6); PG8_BAR;
    } else {
        PG8_STAGE_B(PG8_SB(0, 0), cB, voffB); PG8_STAGE(PG8_SA(0, 0), cA, voffA); PG8_STAGE_B(PG8_SB(0, 1), cB + hstep, voffB); PG8_STAGE(PG8_SA(0, 1), cA + hstep, voffA);
        if (wr == 1) PG8_BAR;
        PG8_WAIT_V(4); PG8_BAR;
        PG8_STAGE_B(PG8_SB(1, 0), cB + kstep, voffB); PG8_STAGE(PG8_SA(1, 0), cA + kstep, voffA); PG8_STAGE_B(PG8_SB(1, 1), cB + hstep + kstep, voffB);
        PG8_WAIT_V(6); PG8_BAR;
    }
    }
    for (;;) {
        const bool has_next = S.next(ui + 1, nxt);
        const char* nA = has_next ? (GATH ? (const char*)g.A : (const char*)g.A + (size_t)nxt.pm * tstep) : (CH_OUT ? chA : cA);
        if constexpr (GATH) { if (has_next) PG8_TOKDMA(nxt, (ui + 1) & 1); }
        const char* nB = has_next ? (const char*)g.Bt + (size_t)nxt.pn * tstep : (CH_OUT ? chB : cB);
        for (int t = 0; t < nt; t += 2) {
            const bool last = (t == nt - 2);
            const char* a1 = cA + (size_t)(t + 1) * kstep;
            const char* a2 = last ? nA : cA + (size_t)(t + 2) * kstep; const char* b2 = last ? nB : cB + (size_t)(t + 2) * kstep;
            const char* a3 = a2 + kstep; const char* b3 = b2 + kstep;
            if (last && has_next) S.a_ready(nxt);
            if constexpr (SP2) {
            PG8_IFB { PG8_LDB(B0, 0, 0); PG8_LDB(B1, 0, 1); } PG8_SCHED; PG8_IF0 { PG8_LDA(At, 0, 0); } PG8_STAGE_A(PG8_SA(1, 1), a1, 1);
            if constexpr (GATH) { if (last && has_next) PG8_GOFF((ui + 1) & 1); }
            PG8_WAIT_V(8); PG8_WAIT_L(0); PG8_BAR; PG8_IF0 { PG8_MMA(0, 0, At, B0); PG8_MMA(0, 1, At, B1); } PG8_BAR; PG8_SCHED;
            PG8_IF1 { PG8_LDA(At, 0, 1); } PG8_STAGE_B(PG8_SB(0, 0), b2, voffB); PG8_STAGE_B(PG8_SB(0, 1), b2 + hstep, voffB); PG8_STAGE_A(PG8_SA(0, 0), a2, 0);
            PG8_WAIT_V(8); PG8_WAIT_L(0); PG8_BAR; PG8_IF1 { PG8_MMA(1, 0, At, B0); PG8_MMA(1, 1, At, B1); } PG8_BAR; PG8_SCHED;
            PG8_IFB { PG8_LDB(B0, 1, 0); PG8_LDB(B1, 1, 1); } PG8_SCHED; PG8_IF0 { PG8_LDA(At, 1, 0); } PG8_STAGE_A(PG8_SA(0, 1), a2, 1);
            PG8_WAIT_V(8); PG8_WAIT_L(0); PG8_BAR; PG8_IF0 { PG8_MMA(0, 0, At, B0); PG8_MMA(0, 1, At, B1); } PG8_BAR; PG8_SCHED;
            PG8_IF1 { PG8_LDA(At, 1, 1); } PG8_STAGE_B(PG8_SB(1, 0), b3, voffB); PG8_STAGE_B(PG8_SB(1, 1), b3 + hstep, voffB); PG8_STAGE_A(PG8_SA(1, 0), a3, 0);
            PG8_WAIT_V(8); PG8_WAIT_L(0); PG8_BAR; PG8_IF1 { PG8_MMA(1, 0, At, B0); PG8_MMA(1, 1, At, B1); } PG8_BAR; PG8_SCHED;
            } else {
            PG8_LDB(B0, 0, 0); PG8_SCHED; PG8_LDA(At, 0, 0); PG8_STAGE(PG8_SA(1, 1), a1 + hstep, voffA);
            PG8_WAIT_L(8); PG8_BAR; PG8_WAIT_L(0); PG8_MMA(0, 0, At, B0); PG8_BAR; PG8_SCHED;
            PG8_LDB(B1, 0, 1); PG8_STAGE_B(PG8_SB(0, 0), b2, voffB);
            PG8_BAR; PG8_WAIT_L(0); PG8_MMA(0, 1, At, B1); PG8_BAR;
            PG8_LDA(At, 0, 1); PG8_STAGE(PG8_SA(0, 0), a2, voffA);
            PG8_BAR; PG8_WAIT_L(0); PG8_MMA(1, 0, At, B0); PG8_BAR; PG8_SCHED;
            PG8_STAGE_B(PG8_SB(0, 1), b2 + hstep, voffB);
            PG8_WAIT_V(6); PG8_BAR; PG8_MMA(1, 1, At, B1); PG8_BAR;
            PG8_LDB(B0, 1, 0); PG8_SCHED; PG8_LDA(At, 1, 0); PG8_STAGE(PG8_SA(0, 1), a2 + hstep, voffA);
            PG8_WAIT_L(8); PG8_BAR; PG8_WAIT_L(0); PG8_MMA(0, 0, At, B0); PG8_BAR; PG8_SCHED;
            PG8_LDB(B1, 1, 1); PG8_STAGE_B(PG8_SB(1, 0), b3, voffB);
            PG8_BAR; PG8_WAIT_L(0); PG8_MMA(0, 1, At, B1); PG8_BAR;
            PG8_LDA(At, 1, 1); PG8_STAGE(PG8_SA(1, 0), a3, voffA);
            PG8_BAR; PG8_WAIT_L(0); PG8_MMA(1, 0, At, B0); PG8_BAR; PG8_SCHED;
            PG8_STAGE_B(PG8_SB(1, 1), b3 + hstep, voffB);
            PG8_WAIT_V(6); PG8_BAR; PG8_MMA(1, 1, At, B1); PG8_BAR;
            }
        }
        if constexpr (ALIGN_EPI) { if (wr == 0) PG8_BAR; }
        if constexpr (!Epi::AFTER_DRAIN) { E(acc, cur, wr, wc, fr, fq); S.done(cur); }
        if (!has_next) { if constexpr (CH_OUT) { if (wr == 1) PG8_BAR; } break; }
#pragma unroll
        for (int a = 0; a < 2; ++a)
#pragma unroll
            for (int b = 0; b < 2; ++b)
#pragma unroll
                for (int m = 0; m < 4; ++m)
#pragma unroll
                    for (int n = 0; n < 2; ++n) acc[a][b][m][n] = (f32x4){0.f, 0.f, 0.f, 0.f};
        cur = nxt; cA = nA; cB = nB; ++ui; if constexpr (RS) { do0 = cur.rows > wr * 64; do1 = cur.rows > 128 + wr * 64; }
        if constexpr (ALIGN_EPI) { if (wr == 1) PG8_BAR; }
    }
    if constexpr (!CH_OUT) {
    PG8_WAIT_V(0);
    if constexpr (!ALIGN_EPI) { if (wr == 0) PG8_BAR; }
    PG8_BAR;
    if constexpr (Epi::AFTER_DRAIN) { E.fused(acc, cur, wr, wc, fr, fq, lds, wid, lane); S.done(cur); }
    }
#undef PG8_SA
#undef PG8_IF0
#undef PG8_IF1
#undef PG8_IFB
#undef PG8_SB
#undef PG8_STAGE
#undef PG8_STAGE_B
#undef PG8_LDA
#undef PG8_STAGE_A
#undef PG8_GOFF
#undef PG8_TOKDMA
#undef PG8_LDB
#undef PG8_MMA
#undef PG8_WAIT_V
#undef PG8_WAIT_L
#undef PG8_BAR
#undef PG8_SCHED
}
}
#include <hip/hip_bf16.h>
#include <cmath>
namespace attn_body {
using bf16=__hip_bfloat16;
using bf16x8=__attribute__((ext_vector_type(8)))short;
using s16x4=__attribute__((ext_vector_type(4)))short;
using f32x16=__attribute__((ext_vector_type(16)))float;
using u32x4=__attribute__((ext_vector_type(4)))unsigned;
constexpr int BATCH=16,NHEAD=16,SEQ=2048,D=64,DM=NHEAD*D;
constexpr int NW=8,QBLK=32,QB=QBLK*NW,KVBLK=64,NQB=SEQ/QB;
constexpr int ATTN_PITCH=DM, ATTN_UNIT_ROWS=QB;
__device__ __forceinline__ int crow(int r,int hi){return (r&3)+8*(r>>2)+4*hi;}
#define SBAR() __builtin_amdgcn_sched_barrier(0)
__device__ __forceinline__ void cmask(f32x16&p0,f32x16&p1,int jb,int qrel,int hi){
  const float NEG=-INFINITY; int kb=64*jb+4*hi;
  #pragma unroll
  for(int r=0;r<16;++r){int kv=kb+(r&3)+8*(r>>2); if(kv>qrel)p0[r]=NEG; if(kv+32>qrel)p1[r]=NEG;}
}

constexpr int NSLOT=3, SLOTB=8192;
constexpr int LDS_K=0, LDS_V=NSLOT*SLOTB, LDS_WS=2*NSLOT*SLOTB, LDS_OST=LDS_WS+NW*64*4, LDS_KB=LDS_OST+NW*4096, LDS_BYTES=LDS_KB+SEQ*4;
constexpr int GW_STRIDE=4608, LDS_GW=LDS_BYTES, LDS_BYTES_G=LDS_GW+NW*GW_STRIDE;
struct Guest { bf16* Y0; bf16* Y1; const float* S0; const float* S1; int row0; int k; int n; };
constexpr float C2=0.125f*1.4426950408889634f;
__device__ __forceinline__ void glds16(const void*gsrc,unsigned lds_dst){unsigned keep;
  asm volatile("s_mov_b32 %0, m0\n\ts_mov_b32 m0, %2\n\ts_nop 0\n\tglobal_load_lds_dwordx4 %1, off\n\ts_mov_b32 m0, %0":"=&s"(keep):"v"(gsrc),"s"(lds_dst):"memory");}
__device__ __forceinline__ void glds4(const void*gsrc,unsigned lds_dst){unsigned keep;
  asm volatile("s_mov_b32 %0, m0\n\ts_mov_b32 m0, %2\n\ts_nop 0\n\tglobal_load_lds_dword %1, off\n\ts_mov_b32 m0, %0":"=&s"(keep):"v"(gsrc),"s"(lds_dst):"memory");}
__device__ __forceinline__ float max3f(float a,float b,float c){float r;asm("v_max3_f32 %0, %1, %2, %3":"=v"(r):"v"(a),"v"(b),"v"(c));return r;}
__device__ __forceinline__ float max2f(float a,float b){float r;asm("v_max_f32_e32 %0, %1, %2":"=v"(r):"v"(a),"v"(b));return r;}
__device__ __forceinline__ float fadd_s(float a,float b){float r;asm("v_add_f32_e32 %0, %1, %2":"=v"(r):"v"(a),"v"(b));return r;}
__device__ __forceinline__ float fsub_s(float a,float b){float r;asm("v_sub_f32_e32 %0, %1, %2":"=v"(r):"v"(a),"v"(b));return r;}
typedef float f32x2_t __attribute__((ext_vector_type(2))); typedef __bf16 bf16x2_t __attribute__((ext_vector_type(2)));
__device__ __forceinline__ unsigned cvtpk_s(float lo,float hi){f32x2_t v={lo,hi};bf16x2_t b=__builtin_convertvector(v,bf16x2_t);return __builtin_bit_cast(unsigned,b);}
__device__ __forceinline__ void guest_issue(const Guest&G,int row,unsigned gdst,int lane){
  const bf16*y0=G.Y0+(long)row*1024+8*lane; const bf16*y1=G.Y1+(long)row*1024+8*lane;
  glds16(y0,gdst); glds16(y0+512,gdst+1024); glds16(y1,gdst+2048); glds16(y1+512,gdst+3072); glds4(G.S0+(long)row*16+(lane&15),gdst+4096); glds4(G.S1+(long)row*16+(lane&15),gdst+4352);
}
__device__ __forceinline__ void guest_finish(const Guest&G,int row,const char*shm,int wid,int lane){
  const char*gb=shm+LDS_GW+wid*GW_STRIDE;
  #pragma unroll
  for(int t=0;t<2;++t){ bf16*Y=t?G.Y1:G.Y0;
    #pragma unroll
    for(int j=0;j<2;++j){
      const u32x4 y=*(const u32x4*)(gb+t*2048+j*1024+lane*16);
      const float4 q=*(const float4*)(gb+4096+t*256+16*((lane>>5)+2*j)); const float rstd=__builtin_amdgcn_rsqf(((q.x+q.y)+(q.z+q.w))*(1.f/256.f)+1e-6f);
      u32x4 r;
      #pragma unroll
      for(int e=0;e<4;++e) r[e]=cvtpk_s(__uint_as_float(y[e]<<16)*rstd,__uint_as_float(y[e]&0xffff0000u)*rstd);
      *(u32x4*)(Y+(long)row*1024+8*(lane+64*j))=r;
    } }
}
#define WAIT_BAR(N) asm volatile("s_waitcnt vmcnt(" #N ") lgkmcnt(0)\n\ts_barrier":::"memory")

__device__ __forceinline__ void qkt(f32x16&p0,f32x16&p1,const char*Kslot,const bf16x8*qr,int r32,int hi){
  const char*kb=Kslot+hi*1024+r32*16;
  #pragma unroll
  for(int d0=0;d0<4;++d0){
    const bf16x8 b0=*reinterpret_cast<const bf16x8*>(kb+d0*2048);
    const bf16x8 b1=*reinterpret_cast<const bf16x8*>(kb+d0*2048+512);
    p0=__builtin_amdgcn_mfma_f32_32x32x16_bf16(b0,qr[d0],p0,0,0,0);p1=__builtin_amdgcn_mfma_f32_32x32x16_bf16(b1,qr[d0],p1,0,0,0);}
}
typedef __attribute__((address_space(3))) const char* lds_cptr;
typedef short v4i16_t __attribute__((ext_vector_type(4)));
__device__ __forceinline__ void kload8(bf16x8*kf,lds_cptr kp){
  kf[0]=*(const __attribute__((address_space(3))) bf16x8*)(kp);      kf[1]=*(const __attribute__((address_space(3))) bf16x8*)(kp+512);
  kf[2]=*(const __attribute__((address_space(3))) bf16x8*)(kp+2048); kf[3]=*(const __attribute__((address_space(3))) bf16x8*)(kp+2560);
  kf[4]=*(const __attribute__((address_space(3))) bf16x8*)(kp+4096); kf[5]=*(const __attribute__((address_space(3))) bf16x8*)(kp+4608);
  kf[6]=*(const __attribute__((address_space(3))) bf16x8*)(kp+6144); kf[7]=*(const __attribute__((address_space(3))) bf16x8*)(kp+6656);
}
__device__ __forceinline__ void kload2(bf16x8*kf,lds_cptr kp,int j){ kf[2*j]=*(const __attribute__((address_space(3))) bf16x8*)(kp+j*2048); kf[2*j+1]=*(const __attribute__((address_space(3))) bf16x8*)(kp+j*2048+512); }
__device__ __forceinline__ s16x4 vtr(lds_cptr p){ return __builtin_bit_cast(s16x4,__builtin_amdgcn_ds_read_tr16_b64_v4i16((__attribute__((address_space(3))) v4i16_t*)p)); }
__device__ __forceinline__ float rowmax(const f32x16&p0,const f32x16&p1){
  float a=max3f(p0[0],p0[1],p1[0]),b=max3f(p0[2],p0[3],p1[1]);a=max3f(a,p1[2],p1[3]);
  #pragma unroll
  for(int r=4;r<16;r+=4){a=max3f(a,p0[r],p0[r+1]);b=max3f(b,p0[r+2],p0[r+3]);a=max3f(a,p1[r],p1[r+1]);b=max3f(b,p1[r+2],p1[r+3]);}
  const float m=max2f(a,b);
  auto rr=__builtin_amdgcn_permlane32_swap(__float_as_uint(m),__float_as_uint(m),false,false);
  return max2f(__uint_as_float(rr[0]),__uint_as_float(rr[1]));
}
__device__ __forceinline__ void pv(f32x16*o,int vb,bf16x8 pa0,bf16x8 pa1,bf16x8 pa2,bf16x8 pa3){
  #pragma unroll
  for(int d0=0;d0<2;++d0){s16x4 lo[4],hi[4];
    #pragma unroll
    for(int ks=0;ks<4;++ks){
      asm volatile("ds_read_b64_tr_b16 %0,%1 offset:%c2":"=&v"(lo[ks]):"v"(vb),"i"(d0*4096+ks*1024):"memory");
      asm volatile("ds_read_b64_tr_b16 %0,%1 offset:%c2":"=&v"(hi[ks]):"v"(vb),"i"(d0*4096+ks*1024+512):"memory");}
    asm volatile("s_waitcnt lgkmcnt(0)":::"memory");SBAR();
    #define PK(k) (bf16x8){lo[k][0],lo[k][1],lo[k][2],lo[k][3],hi[k][0],hi[k][1],hi[k][2],hi[k][3]}
    o[d0]=__builtin_amdgcn_mfma_f32_32x32x16_bf16(pa0,PK(0),o[d0],0,0,0);
    o[d0]=__builtin_amdgcn_mfma_f32_32x32x16_bf16(pa1,PK(1),o[d0],0,0,0);
    o[d0]=__builtin_amdgcn_mfma_f32_32x32x16_bf16(pa2,PK(2),o[d0],0,0,0);
    o[d0]=__builtin_amdgcn_mfma_f32_32x32x16_bf16(pa3,PK(3),o[d0],0,0,0);
    #undef PK
  }
}

#ifndef ATTN_STORE16
#define ATTN_STORE16(p,v) NT_STORE((v),(u32x4*)(p))
#endif
template<int THRL> __device__ __forceinline__ void attn_unit(int b,int h,int qb,const bf16*Q,const bf16*__restrict__ K,const bf16*__restrict__ V,bf16*O,const float*__restrict__ Fg,bool stage_kb,char*shm,Guest&G,bool pre_cur,bool pre_next,int qb_next,bf16x8(&qr)[4]){
  int tid_=threadIdx.x; asm volatile("":"+v"(tid_)); const int tid=tid_,lane=tid&63,r32=lane&31,hi=lane>>5; const int wid=__builtin_amdgcn_readfirstlane(tid>>6);
  const long rowbase=(long)b*SEQ; const int q0=qb*QB;
  if(stage_kb){ float*kbw=(float*)(shm+LDS_KB); for(int j=4*tid;j<SEQ;j+=4*NW*64){ const float4 f=*reinterpret_cast<const float4*>(Fg+j); *reinterpret_cast<float4*>(kbw+j)=make_float4(f.x*-1.4426950408889634f,f.y*-1.4426950408889634f,f.z*-1.4426950408889634f,f.w*-1.4426950408889634f);} }
  const float*kb=(const float*)(shm+LDS_KB)+4*hi;
  const bf16*Qw=Q+(rowbase+q0+wid*QBLK)*DM+h*D;
  const bf16*Kh=K+rowbase*DM+h*D,*Vh=V+rowbase*DM+h*D;
  const unsigned lds0=(unsigned)(uintptr_t)shm;
  float*wsf=(float*)(shm+LDS_WS)+wid*64;
  const bf16*ksrc=Kh+(long)lane*DM+wid*8;
  const bf16*vsrc=Vh+(long)(16*(wid&3)+(lane>>2))*DM+(wid>>2)*32+(lane&3)*8;
  const unsigned kdst=lds0+LDS_K+wid*1024, vdst=lds0+LDS_V+wid*1024;
  #define DMA_K(t,slot) glds16(ksrc+(long)(t)*KVBLK*DM,(unsigned)__builtin_amdgcn_readfirstlane(kdst+(slot)))
  #define DMA_V(t,slot) glds16(vsrc+(long)(t)*KVBLK*DM,(unsigned)__builtin_amdgcn_readfirstlane(vdst+(slot)))
  const int vb0=(int)(lds0+LDS_V)+((lane>>4)&1)*32+(lane&3)*8+(4*hi+((lane&15)>>2))*64;
  const char*Kbase=shm+LDS_K; bf16x8 kf[8];
  const lds_cptr shm3=(lds_cptr)shm; const lds_cptr kp0=shm3+LDS_K+hi*1024+r32*16; const lds_cptr vp0=shm3+LDS_V+((lane>>4)&1)*32+(lane&3)*8+(4*hi+((lane&15)>>2))*64;
  const int NT=(q0+QB)/KVBLK;
  if(!(ATT_PRE&&pre_cur)){DMA_K(0,0);DMA_V(0,0);DMA_K(1,SLOTB);}
  if(!(ATT_PRE&&pre_cur)){
  #pragma unroll
  for(int d0=0;d0<4;++d0)qr[d0]=*reinterpret_cast<const bf16x8*>(&Qw[(long)r32*DM+d0*16+hi*8]); }
  float mhat=0.f,l_reg=0.f;f32x16 o[2];o[0]=f32x16{};o[1]=f32x16{};
  const int qrel=wid*QBLK+r32;
  #define CMASK(P0,P1,t) do{int jb_=(t)-(NT-4); if(jb_>=0)cmask(P0,P1,jb_,qrel,hi);}while(0)
  bool resc=false;
#if ATT_PK
  typedef float f32x4v __attribute__((ext_vector_type(4))); typedef float f32x8v __attribute__((ext_vector_type(8)));
  #define KB4(p_) (*reinterpret_cast<const f32x4v*>(p_))
  #define CAT8(x_,y_) __builtin_shufflevector(x_,y_,0,1,2,3,4,5,6,7)
  #define CAT16(x_,y_) __builtin_shufflevector(x_,y_,0,1,2,3,4,5,6,7,8,9,10,11,12,13,14,15)
  #define KBINIT(C0,C1,t) do{ const float*kp_=kb+64*(t); f32x16 mh_; { const float nm_=-mhat; _Pragma("unroll") for(int i_=0;i_<16;++i_)mh_[i_]=nm_; } \
      C0=CAT16(CAT8(KB4(kp_),KB4(kp_+8)),CAT8(KB4(kp_+16),KB4(kp_+24)))+mh_; C1=CAT16(CAT8(KB4(kp_+32),KB4(kp_+40)),CAT8(KB4(kp_+48),KB4(kp_+56)))+mh_; }while(0)
#else
  #define KBINIT(C0,C1,t) do{ const float*kp_=kb+64*(t); _Pragma("unroll") for(int g_=0;g_<4;++g_){ const float4 a_=*reinterpret_cast<const float4*>(kp_+8*g_), b_=*reinterpret_cast<const float4*>(kp_+32+8*g_); \
      C0[4*g_]=a_.x-mhat;C0[4*g_+1]=a_.y-mhat;C0[4*g_+2]=a_.z-mhat;C0[4*g_+3]=a_.w-mhat; C1[4*g_]=b_.x-mhat;C1[4*g_+1]=b_.y-mhat;C1[4*g_+2]=b_.z-mhat;C1[4*g_+3]=b_.w-mhat; } }while(0)
#endif
#if ATT_KBPRE
  #define KBINIT_AT_START(C0,C1,t) do{}while(0)
  #define KBNEXT_LOAD(G,t) f32x4v ka0_,ka1_,ka2_,ka3_,kb0_,kb1_,kb2_,kb3_; if(G){ const float*kn_=kb+64*((t)+1); ka0_=KB4(kn_);ka1_=KB4(kn_+8);ka2_=KB4(kn_+16);ka3_=KB4(kn_+24);kb0_=KB4(kn_+32);kb1_=KB4(kn_+40);kb2_=KB4(kn_+48);kb3_=KB4(kn_+56); }
  #define KBNEXT_ADD(G,N0,N1) if(G){ f32x16 mh_; { const float nm_=-mhat; _Pragma("unroll") for(int i_=0;i_<16;++i_)mh_[i_]=nm_; } N0=CAT16(CAT8(ka0_,ka1_),CAT8(ka2_,ka3_))+mh_; N1=CAT16(CAT8(kb0_,kb1_),CAT8(kb2_,kb3_))+mh_; }
#else
  #define KBINIT_AT_START(C0,C1,t) KBINIT(C0,C1,t)
  #define KBNEXT_LOAD(G,t) do{}while(0)
  #define KBNEXT_ADD(G,N0,N1) do{}while(0)
#endif
  #define START(P0,P1) do{ const float rm=rowmax(P0,P1); resc=false; \
    { const float dl=rm; mhat=fadd_s(mhat,dl); \
      _Pragma("unroll") for(int r=0;r<16;++r){P0[r]=fsub_s(P0[r],dl);P1[r]=fsub_s(P1[r],dl);} \
      } \
    _Pragma("unroll") for(int r=0;r<16;++r)P0[r]=__builtin_amdgcn_exp2f(P0[r]); }while(0)
  #define RESC() do{ if(resc){ asm volatile("s_waitcnt lgkmcnt(0)":::"memory"); \
      _Pragma("unroll") for(int d_=0;d_<2;++d_) _Pragma("unroll") for(int r=0;r<16;++r)o[d_][r]*=wsf[crow(r,hi)]; } }while(0)
  f32x16 pA0,pA1,pB0,pB1;
  int sl_prev=0,sl_cur=0,sl_next=SLOTB;
  #define ROT() do{sl_prev=sl_cur;sl_cur=sl_next;sl_next=(sl_next==(NSLOT-1)*SLOTB)?0:sl_next+SLOTB;}while(0)
  DMA_K(2,2*SLOTB);
  WAIT_BAR(3);
  KBINIT(pA0,pA1,0); qkt(pA0,pA1,Kbase,qr,r32,hi);asm volatile("s_nop 15\n\ts_nop 7":"+v"(pA0),"+v"(pA1));CMASK(pA0,pA1,0);
  START(pA0,pA1);
  _Pragma("unroll") for(int r=0;r<16;++r)pA1[r]=__builtin_amdgcn_exp2f(pA1[r]);
  WAIT_BAR(0);
  DMA_K(3,0);DMA_V(1,SLOTB);
  ROT();
  kload8(kf,kp0+sl_cur);
#if ATT_KBPRE
  KBINIT(pB0,pB1,1);
#endif
  WAIT_BAR(2);
  s16x4 vlo[8],vhi[8]; u32x4 pw0,pw1,pw2,pw3;
  #define PKW(P,B) cvtpk_s(P[B],P[B+1])
  #define PAF(k) __builtin_bit_cast(bf16x8,pw##k)
  #define VFR(i) (bf16x8){vlo[i][0],vlo[i][1],vlo[i][2],vlo[i][3],vhi[i][0],vhi[i][1],vhi[i][2],vhi[i][3]}
  #define PIN(x) asm volatile("":"+v"(x))
  #define MX3(a,b,c) __builtin_fmaxf(__builtin_fmaxf((a),(b)),(c))
#if ATT_PK
  #define GAPA(MF,A0,A1,A2,A3,W0,W1,PW) do{ MF; { const f32x2_t u_={A0,A1}, w_={A2,A3}; asm volatile("v_pk_add_f32 %0, %0, %1\n\tv_pk_add_f32 %0, %0, %2":"+v"(sacc):"v"(u_),"v"(w_)); } W0; W1; PIN(PW); SBAR(); }while(0)
  #define SACC_T f32x2_t
  #define SACC_INIT(P) (f32x2_t){P[0],P[1]}
  #define SACC_SUM(s) ((s).x+(s).y)
#else
  #define GAPA(MF,A0,A1,A2,A3,W0,W1,PW) do{ MF; sacc+=A0; sacc+=A1; sacc+=A2; sacc+=A3; PIN(sacc); W0; W1; PIN(PW); SBAR(); }while(0)
  #define SACC_T float
  #define SACC_INIT(P) (P[0]+P[1])
  #define SACC_SUM(s) (s)
#endif
  #define EX(v) __builtin_amdgcn_exp2f(v)
  #define GAPB(MF,X,B) do{ MF; X[B]=EX(X[B]); X[B+1]=EX(X[B+1]); X[B+2]=EX(X[B+2]); X[B+3]=EX(X[B+3]); PIN(X); SBAR(); }while(0)
  #define VRD(i) do{ vlo[i]=vtr(vp_+(((i)>>2)*4096+((i)&3)*1024)); vhi[i]=vtr(vp_+(((i)>>2)*4096+((i)&3)*1024+512)); }while(0)
  #define KRD(G,j) do{ if(G){ kload2(kf,kp0+sl_next,j); SBAR(); } }while(0)
  #define STEP(C0,C1,P0,P1,t,GK,GV,GL) do{ SBAR(); \
    const lds_cptr vp_=vp0+sl_prev; \
    KBINIT_AT_START(C0,C1,t); SBAR(); VRD(0); SBAR(); SACC_T sacc=SACC_INIT(P0); \
    GAPA(C0=__builtin_amdgcn_mfma_f32_32x32x16_bf16(kf[0],qr[0],C0,0,0,0), P0[2],P0[3],P0[4],P0[5],     pw0[0]=PKW(P0,0), pw0[1]=PKW(P0,2), pw0); \
    VRD(4); SBAR(); GAPA(C1=__builtin_amdgcn_mfma_f32_32x32x16_bf16(kf[1],qr[0],C1,0,0,0), P0[6],P0[7],P0[8],P0[9],     pw0[2]=PKW(P0,4), pw0[3]=PKW(P0,6), pw0); \
    VRD(1); SBAR(); GAPA(C0=__builtin_amdgcn_mfma_f32_32x32x16_bf16(kf[2],qr[1],C0,0,0,0),   P0[10],P0[11],P0[12],P0[13], pw1[0]=PKW(P0,8), pw1[1]=PKW(P0,10), pw1); \
    VRD(5); SBAR(); GAPA(C1=__builtin_amdgcn_mfma_f32_32x32x16_bf16(kf[3],qr[1],C1,0,0,0),   P0[14],P0[15],P1[0],P1[1],   pw1[2]=PKW(P0,12),pw1[3]=PKW(P0,14), pw1); \
    VRD(2); SBAR(); GAPA(C0=__builtin_amdgcn_mfma_f32_32x32x16_bf16(kf[4],qr[2],C0,0,0,0),   P1[2],P1[3],P1[4],P1[5],     pw2[0]=PKW(P1,0), pw2[1]=PKW(P1,2), pw2); \
    VRD(6); SBAR(); GAPA(C1=__builtin_amdgcn_mfma_f32_32x32x16_bf16(kf[5],qr[2],C1,0,0,0),   P1[6],P1[7],P1[8],P1[9],     pw2[2]=PKW(P1,4), pw2[3]=PKW(P1,6), pw2); \
    VRD(3); SBAR(); GAPA(C0=__builtin_amdgcn_mfma_f32_32x32x16_bf16(kf[6],qr[3],C0,0,0,0),   P1[10],P1[11],P1[12],P1[13], pw3[0]=PKW(P1,8), pw3[1]=PKW(P1,10), pw3); \
    VRD(7); SBAR(); GAPA(C1=__builtin_amdgcn_mfma_f32_32x32x16_bf16(kf[7],qr[3],C1,0,0,0),   P1[14],P1[15],0.f,0.f,       pw3[2]=PKW(P1,12),pw3[3]=PKW(P1,14), pw3); \
    l_reg+=SACC_SUM(sacc); \
    if(GK){DMA_K((t)+3,sl_cur);} if(GV){DMA_V((t)+1,sl_next);} \
    CMASK(C0,C1,t); \
    { float a=MX3(C0[0],C0[1],C1[0]),b=MX3(C0[2],C0[3],C1[1]); a=MX3(a,C1[2],C1[3]); \
      _Pragma("unroll") for(int r=4;r<16;r+=4){a=MX3(a,C0[r],C0[r+1]);b=MX3(b,C0[r+2],C0[r+3]);a=MX3(a,C1[r],C1[r+1]);b=MX3(b,C1[r+2],C1[r+3]);} \
      float rm=__builtin_fmaxf(a,b); { auto rr=__builtin_amdgcn_permlane32_swap(__float_as_uint(rm),__float_as_uint(rm),false,false); rm=__builtin_fmaxf(__uint_as_float(rr[0]),__uint_as_float(rr[1])); } \
      resc=false; \
      if(__builtin_expect(__any(rm>(float)THRL),0)){ const float dl=__builtin_fmaxf(rm,0.f); mhat+=dl; \
        _Pragma("unroll") for(int r=0;r<16;++r){C0[r]-=dl;C1[r]-=dl;} \
        const float f=__builtin_amdgcn_exp2f(-dl); l_reg*=f; if(hi==0)wsf[r32]=f; resc=true; } } \
    SBAR(); \
    KBNEXT_LOAD(GL,t); \
    GAPB(o[0]=__builtin_amdgcn_mfma_f32_32x32x16_bf16(PAF(0),VFR(0),o[0],0,0,0), C0,0); \
    GAPB(o[1]=__builtin_amdgcn_mfma_f32_32x32x16_bf16(PAF(0),VFR(4),o[1],0,0,0), C0,4); \
    KRD(GL,0); GAPB(o[0]=__builtin_amdgcn_mfma_f32_32x32x16_bf16(PAF(1),VFR(1),o[0],0,0,0), C0,8); \
    KRD(GL,1); GAPB(o[1]=__builtin_amdgcn_mfma_f32_32x32x16_bf16(PAF(1),VFR(5),o[1],0,0,0), C0,12); \
    KRD(GL,2); GAPB(o[0]=__builtin_amdgcn_mfma_f32_32x32x16_bf16(PAF(2),VFR(2),o[0],0,0,0), C1,0); \
    KRD(GL,3); GAPB(o[1]=__builtin_amdgcn_mfma_f32_32x32x16_bf16(PAF(2),VFR(6),o[1],0,0,0), C1,4); \
    GAPB(o[0]=__builtin_amdgcn_mfma_f32_32x32x16_bf16(PAF(3),VFR(3),o[0],0,0,0), C1,8); \
    GAPB(o[1]=__builtin_amdgcn_mfma_f32_32x32x16_bf16(PAF(3),VFR(7),o[1],0,0,0), C1,12); \
    KBNEXT_ADD(GL,P0,P1); \
    }while(0)
  int t=1;
  #undef CMASK
  #define CMASK(P0,P1,t) do{}while(0)
#if ATT_GUEST
  bool gpend=false; int grow=0; const unsigned gdst=(unsigned)__builtin_amdgcn_readfirstlane(lds0+LDS_GW+wid*GW_STRIDE);
#endif
  for(;t+5<NT;t+=2){
#if ATT_GUEST
    if(gpend){ guest_finish(G,grow,shm,wid,lane); gpend=false; SBAR(); }
    if(G.k<G.n){ grow=G.row0+G.k; ++G.k; if(grow<BATCH*SEQ){ asm volatile("s_waitcnt lgkmcnt(0)":::"memory"); guest_issue(G,grow,gdst,lane); gpend=true; } SBAR(); }
#endif
    STEP(pB0,pB1,pA0,pA1,t,true,true,true);     WAIT_BAR(2); RESC(); ROT();
    STEP(pA0,pA1,pB0,pB1,t+1,true,true,true);   WAIT_BAR(2); RESC(); ROT();
  }
#if ATT_GUEST
  if(gpend){ guest_finish(G,grow,shm,wid,lane); gpend=false; SBAR(); }
#endif
  #undef CMASK
  #define CMASK(P0,P1,t) do{int jb_=(t)-(NT-4); if(jb_>=0)cmask(P0,P1,jb_,qrel,hi);}while(0)
  #define ENDW(tt) do{ if((tt)+3<NT){WAIT_BAR(2);} else if((tt)+2<NT){WAIT_BAR(1);} else {WAIT_BAR(0);} }while(0)
  for(;t+1<NT;t+=2){
    STEP(pB0,pB1,pA0,pA1,t,(t+3<NT),(t+1<NT),(t+1<NT));       ENDW(t);   RESC(); ROT();
    STEP(pA0,pA1,pB0,pB1,t+1,(t+4<NT),(t+2<NT),(t+2<NT));     ENDW(t+1); RESC(); ROT();
  }
  STEP(pB0,pB1,pA0,pA1,NT-1,false,false,false); RESC();
  { float sacc=pB0[0]+pB0[1]; _Pragma("unroll") for(int r=2;r<16;++r)sacc+=pB0[r]; _Pragma("unroll") for(int r=0;r<16;++r)sacc+=pB1[r]; l_reg+=sacc;
    pw0=(u32x4){PKW(pB0,0),PKW(pB0,2),PKW(pB0,4),PKW(pB0,6)};pw1=(u32x4){PKW(pB0,8),PKW(pB0,10),PKW(pB0,12),PKW(pB0,14)};pw2=(u32x4){PKW(pB1,0),PKW(pB1,2),PKW(pB1,4),PKW(pB1,6)};pw3=(u32x4){PKW(pB1,8),PKW(pB1,10),PKW(pB1,12),PKW(pB1,14)};
    SBAR(); pv(o,vb0+sl_cur,PAF(0),PAF(1),PAF(2),PAF(3)); }
#if ATT_PRE
  asm volatile("s_waitcnt lgkmcnt(0)\n\ts_barrier":::"memory");
  if(pre_next){DMA_K(0,0);DMA_V(0,0);DMA_K(1,SLOTB);
    const bf16*Qn=Q+(rowbase+(long)qb_next*QB+wid*QBLK)*DM+h*D;
    #pragma unroll
    for(int d0=0;d0<4;++d0)qr[d0]=*reinterpret_cast<const bf16x8*>(&Qn[(long)r32*DM+d0*16+hi*8]); }
#endif
  #undef PKW
  #undef PAF
  #undef VFR
  #undef PIN
  #undef MX3
  #undef GAPA
  #undef GAPB
  #undef EX
  #undef VRD
  #undef KRD
  #undef STEP
  #undef ENDW
  {auto rr=__builtin_amdgcn_permlane32_swap(__float_as_uint(l_reg),__float_as_uint(l_reg),false,false);l_reg=__uint_as_float(rr[0])+__uint_as_float(rr[1]);}
  if(hi==0)wsf[32+r32]=l_reg;asm volatile("s_waitcnt lgkmcnt(0)":::"memory");
  float rli[16];
  #pragma unroll
  for(int r=0;r<16;++r)rli[r]=__builtin_amdgcn_rcpf(wsf[32+crow(r,hi)]);
  bf16*Ow=O+(rowbase+q0+wid*QBLK)*DM+h*D;
  { bf16*stg=(bf16*)(shm+LDS_OST)+wid*2048;
    #pragma unroll
    for(int r=0;r<16;++r){const int orow=crow(r,hi);
      #pragma unroll
      for(int d0=0;d0<2;++d0)stg[orow*64+d0*32+r32]=__float2bfloat16(o[d0][r]*rli[r]);}
    asm volatile("s_waitcnt lgkmcnt(0)":::"memory");
    #pragma unroll
    for(int i=0;i<4;++i){const int row=i*8+(lane>>3),ch=lane&7; const u32x4 v=*(const u32x4*)(stg+row*64+ch*8); ATTN_STORE16(Ow+(long)row*DM+ch*8,v);} }
#if ATT_PRE
  asm volatile("s_waitcnt lgkmcnt(0)":::"memory");
#else
  asm volatile("s_waitcnt lgkmcnt(0)\n\ts_barrier":::"memory");
#endif
  #undef DMA_K
  #undef DMA_V
  #undef CMASK
  #undef START
  #undef KBINIT
  #undef RESC
  #undef ROT
}
constexpr int ATTN_LDS_BYTES=LDS_BYTES_G; static_assert(LDS_BYTES_G<=131072,"attention scratch + guest buffers must fit the phase ring");
struct AttnTensors { const bf16* Q; const bf16* K; const bf16* V; bf16* O; const float* F; };
struct AttnUnit { int bh; int qb; };
struct StaticOrder {
  int v,G;
  __device__ __forceinline__ explicit StaticOrder(int grid,int block):v(block),G(grid){}
  __device__ __forceinline__ bool next(int i,AttnUnit&u)const{ const int L=(i>>3)*G+v; if(L>=BATCH*NHEAD)return false; u.bh=L; u.qb=7-(i&7); return true; }
  __device__ __forceinline__ void a_ready(const AttnUnit&)const{}
  __device__ __forceinline__ void done(const AttnUnit&)const{}
};
template<class Sched,int THRL=8> __device__ __forceinline__ void attn_phase(char*lds,const AttnTensors&T,const Sched&S,Guest&G){
  AttnUnit u;
  int bh_prev=-1;
  bool pre=false; bf16x8 qr[4];
  for(int i=0;S.next(i,u);++i){ AttnUnit un; un.qb=0; const bool pn=ATT_PRE&&S.next(i+1,un)&&un.bh==u.bh;
    S.a_ready(u); attn_unit<THRL>(u.bh/NHEAD,u.bh%NHEAD,u.qb,T.Q,T.K,T.V,T.O,T.F+(long)u.bh*SEQ,u.bh!=bh_prev,lds,G,pre,pn,un.qb,qr); bh_prev=u.bh; pre=pn; S.done(u); }
}
#undef SBAR
#undef WAIT_BAR
}

constexpr int NWAVES = 8;
constexpr int NB = 16, SEQ = 2048, NT = NB * SEQ, D = 1024, DEPTH = 2, INW = 13352;
constexpr int NPN_IN = 52, NIN_ROWS = 52 * 256 + 64;
constexpr float RMS_EPS = 1e-6f;
constexpr int MAXTILES = 320;
constexpr int PROWS = MAXTILES * 256;

constexpr size_t MiB = (size_t)1 << 20;
constexpr size_t WS_CTL = 0, CTL_ZERO_BYTES = 1 * MiB;
constexpr size_t WS_WIN = 1 * MiB;
constexpr size_t WS_WBR = 28 * MiB;
constexpr size_t WS_WOUT = 34 * MiB;
constexpr size_t WS_WRT = 36 * MiB;
constexpr size_t WS_ROUTE = 37 * MiB;
constexpr size_t WS_ROWTOK = 36 * MiB + 512 * 1024;
constexpr size_t WS_FB = 38 * MiB;
constexpr size_t WS_SSQS = 40 * MiB;
constexpr size_t WS_SSQM = 42 * MiB;
constexpr size_t WS_SMALL = 44 * MiB;
constexpr size_t WS_WGU = 52 * MiB;
constexpr size_t WS_WDN = 180 * MiB;
constexpr size_t WS_H = 244 * MiB;
constexpr size_t WS_YATT = 308 * MiB, WS_YSSD = 372 * MiB, WS_YML = 436 * MiB;
constexpr size_t WS_PROJ = 500 * MiB;
constexpr size_t WS_RAWH = 756 * MiB;
constexpr size_t WS_XSSD = 772 * MiB;
constexpr size_t WS_RAWH2 = 836 * MiB;
constexpr size_t WS_END = 852 * MiB;
constexpr size_t WS_HG = WS_PROJ, WS_ACT = WS_PROJ + 160 * MiB;
static_assert((size_t)PROWS * 1024 * 2 == 160 * MiB && WS_ACT + (size_t)PROWS * 512 * 2 <= WS_END, "moe overlay");
constexpr int CW_TMO = 0, CW_CODE = 1, CW_BAR = 4096, CW_CNT = 16384, CW_WG = 65536;

constexpr int RING_OFF = 0, RING_BYTES = 131072;
constexpr int LDSCTL_OFF = RING_BYTES, MISC_OFF = LDSCTL_OFF + 320, TAB_OFF = LDSCTL_OFF + 1024;
constexpr int LDS_BYTES = 147456;

#define GAS __attribute__((address_space(1)))
#define LAS __attribute__((address_space(3)))
typedef unsigned short bf16;
typedef unsigned v4u __attribute__((ext_vector_type(4)));
typedef unsigned v2u __attribute__((ext_vector_type(2)));
typedef float f32x4 __attribute__((ext_vector_type(4)));
typedef GAS unsigned gu32;
#define RLX_AGENT __ATOMIC_RELAXED, __HIP_MEMORY_SCOPE_AGENT
#define LDS_WAIT() asm volatile("s_waitcnt lgkmcnt(0)" ::: "memory")
__device__ __forceinline__ unsigned pk2(float lo, float hi) { return pg8::cvt_pk_bf16(lo, hi); }
__device__ __forceinline__ unsigned f2bf(float f) { return pg8::cvt_pk_bf16(f, f) & 0xffffu; }
__device__ __forceinline__ float bf2f(unsigned short u) { return __builtin_bit_cast(float, (unsigned)u << 16); }
__device__ __forceinline__ float blo(unsigned w) { return __builtin_bit_cast(float, w << 16); }
__device__ __forceinline__ float bhi(unsigned w) { return __builtin_bit_cast(float, w & 0xffff0000u); }
__device__ __forceinline__ float sigmoid_f(float x) { return 1.0f / (1.0f + expf(-x)); }
__device__ __forceinline__ float silu_f(float x) { return x / (1.0f + expf(-x)); }
__device__ __forceinline__ float logsigmoid_f(float x) { return fminf(x, 0.f) - log1pf(expf(-fabsf(x))); }
__device__ __forceinline__ float softplus_f(float x) { return fmaxf(x, 0.f) + log1pf(expf(-fabsf(x))); }
__device__ __forceinline__ float wave_sum(float v) {
#pragma unroll
    for (int o = 1; o < 64; o <<= 1) v += __shfl_xor(v, o);
    return v;
}
#define XB_TMO      128
#define XB_XCNT(j)  (256  + 64 * (j))
#define XB_XSUB(j)  (1280 + 64 * (j))
#define XB_XGEN(j)  (2304 + 64 * (j))
#define XB_TOP      3328
#define XB_TOPGEN   3392
#define XCD_BAR_WORDS 3456
#define XB_SPIN_CAP (1u << 20)

__device__ __forceinline__ unsigned xb_ld(unsigned* p)              { return __hip_atomic_load(p, __ATOMIC_RELAXED, __HIP_MEMORY_SCOPE_AGENT); }
__device__ __forceinline__ unsigned xb_add(unsigned* p, unsigned v) { return __hip_atomic_fetch_add(p, v, __ATOMIC_RELAXED, __HIP_MEMORY_SCOPE_AGENT); }
__device__ __forceinline__ unsigned xb_xcc_id() { return (unsigned)__builtin_amdgcn_s_getreg((3 << 11) | 20) & 0xFu; }
#define XB_SPIN(cond, bar) do { unsigned _sp = 0; while (cond) { __builtin_amdgcn_s_sleep(1); \
    if ((++_sp & 255u) == 0u) { if (xb_ld(&(bar)[XB_TMO])) break; if (_sp > XB_SPIN_CAP) { atomicAdd(&(bar)[XB_TMO], 1u); break; } } } } while (0)

struct XcdBarrier {
    unsigned* bar; unsigned x;
    volatile LAS unsigned* st;
};

__device__ __forceinline__ XcdBarrier xcd_barrier_post(unsigned* bar, volatile LAS unsigned* st) {
    XcdBarrier b; b.bar = bar; b.x = xb_xcc_id(); b.st = st;
    if (threadIdx.x == 0) (void)xb_add(&bar[XB_XCNT(b.x)], 1u);
    return b;
}
__device__ __forceinline__ void xcd_barrier_complete(unsigned* bar, unsigned x, unsigned& nloc, unsigned& nx) {
    const unsigned G = gridDim.x * gridDim.y * gridDim.z;
    unsigned sum, cnt, mine, sp = 0u;
    for (;;) {
        sum = 0u; cnt = 0u; mine = 0u;
#pragma nounroll
        for (unsigned j = 0; j < 16; ++j) { const unsigned c = xb_ld(&bar[XB_XCNT(j)]); sum += c; cnt += (c > 0u) ? 1u : 0u; mine = (j == x) ? c : mine; }
        if (sum == G) break;
        __builtin_amdgcn_s_sleep(1);
        if ((++sp & 255u) == 0u) { if (xb_ld(&bar[XB_TMO])) break; if (sp > XB_SPIN_CAP) { atomicAdd(&bar[XB_TMO], 1u); break; } }
    }
    nloc = mine > 0u ? mine : 1u; nx = cnt > 0u ? cnt : 1u;
}

__device__ __forceinline__ void xcd_barrier(const XcdBarrier& b) {
    asm volatile("s_waitcnt vmcnt(0)" ::: "memory");
    __syncthreads();
    if (threadIdx.x == 0) {
        unsigned* bar = b.bar;
        __builtin_amdgcn_s_waitcnt(0);
        unsigned nloc = b.st[0], nx = b.st[1];
        if (nloc == 0u) { xcd_barrier_complete(bar, b.x, nloc, nx); b.st[0] = nloc; b.st[1] = nx; }
        const unsigned old = xb_add(&bar[XB_XSUB(b.x)], 1u);
        const unsigned gen = old / nloc;
        if (old + 1u == (gen + 1u) * nloc) {
            __builtin_amdgcn_fence(__ATOMIC_RELEASE, "agent");
            asm volatile("s_waitcnt vmcnt(0)" ::: "memory");
            const unsigned og = xb_add(&bar[XB_TOP], 1u);
            const unsigned tg = og / nx;
            if (og + 1u == (tg + 1u) * nx) xb_add(&bar[XB_TOPGEN], 1u);
            else XB_SPIN(xb_ld(&bar[XB_TOPGEN]) == tg, bar);
            __builtin_amdgcn_fence(__ATOMIC_ACQUIRE, "agent");
            xb_add(&bar[XB_XGEN(b.x)], 1u);
            asm volatile("s_waitcnt vmcnt(0)" ::: "memory");
        } else {
            XB_SPIN(xb_ld(&bar[XB_XGEN(b.x)]) == gen, bar);
            __builtin_amdgcn_fence(__ATOMIC_ACQUIRE, "agent");
            asm volatile("s_waitcnt vmcnt(0)" ::: "memory");
        }
    }
    __syncthreads();
}


struct Args { const float* in[27]; float* out; unsigned char* ws; int ph_lo, ph_hi; };
typedef const __attribute__((address_space(4))) Args* KArgs;
__device__ __forceinline__ KArgs kargs() { KArgs p = (KArgs)__builtin_amdgcn_kernarg_segment_ptr(); asm volatile("" : "+s"(p)); return p; }
struct Frame {
    LAS unsigned char* lds;
    volatile LAS unsigned* MISC;
    gu32* ctl;
    int tid, lane, wave, G, bid;
    unsigned char* ws; float* out;
};
enum { I_X = 0, I_N1W, I_WIN, I_AFB, I_SCW, I_SCB, I_SDTB, I_SALOG, I_SD, I_SNW, I_MCW, I_MCB, I_MIB, I_MFB, I_MNW, I_GB, I_WBR, I_WOUT, I_N2W, I_WG, I_BG, I_WER, I_BER, I_WGATE, I_WUP, I_WDOWN, I_FNW };

__device__ __forceinline__ int incol(int n) {
    if (n < 1024) return 6176 + n;
    if (n < 2048) return 7200 + (n - 1024);
    if (n < 3072) return 8224 + (n - 2048);
    if (n < 4096) return 9256 + (n - 3072);
    if (n < 7168) return n - 4096;
    if (n < 10240) return 3088 + (n - 7168);
    if (n < 13312) return 10280 + (n - 10240);
    const int j = n - 13312;
    if (j < 16) return 3072 + j; if (j < 32) return 6160 + (j - 16); if (j < 36) return 9248 + (j - 32); if (j < 40) return 9252 + (j - 36); return -1;
}
__device__ __forceinline__ void tr_item(const float* cp, int ld, int K, bf16* WT, int n0, int k0, LAS float* scr, int lane, const float* ksc = nullptr) {
    float tv[32];
#pragma unroll
    for (int i = 0; i < 32; ++i) { const int kk = 2 * i + (lane >> 5); tv[i] = cp ? NT_LOAD(cp + (size_t)(k0 + kk) * ld) : 0.f; if (ksc) tv[i] *= ksc[k0 + kk]; }
#pragma unroll
    for (int i = 0; i < 32; ++i) { const int kk = 2 * i + (lane >> 5); scr[kk * 33 + (lane & 31)] = tv[i]; }
    LDS_WAIT(); asm volatile("" ::: "memory");
    const int c = lane & 7;
#pragma unroll
    for (int j = 0; j < 4; ++j) { const int n = (lane >> 3) + 8 * j; const LAS float* s = scr + (8 * c) * 33 + n;
        v4u o; o.x = pk2(s[0 * 33], s[1 * 33]); o.y = pk2(s[2 * 33], s[3 * 33]); o.z = pk2(s[4 * 33], s[5 * 33]); o.w = pk2(s[6 * 33], s[7 * 33]);
        *(GAS v4u*)(WT + (size_t)(n0 + n) * K + k0 + 8 * c) = o; }
    LDS_WAIT(); asm volatile("" ::: "memory");
}
__device__ __forceinline__ void p_convert(Frame& F, KArgs A, int L) {
    LAS float* scr = (LAS float*)(F.lds + RING_OFF + F.wave * 16384);
    const int gw = F.bid * NWAVES + F.wave, NGW = F.G * NWAVES, lane = F.lane;
    constexpr int NBI = NIN_ROWS / 32, I_IN = 16 * NBI, I_BR = 3 * 512, I_OUT = 512, I_GU = 64 * 512, I_DN = 64 * 256;
    const int NITEMS = (USE_GUEST_CVT && F.G == 256) ? I_IN + I_BR + I_OUT : I_IN + I_BR + I_OUT + I_GU + I_DN;
    const float* w_in = A->in[I_WIN] + (size_t)L * 1024 * INW;
    for (int it = gw; it < NITEMS; it += NGW) {
        int r = it;
        if (r < I_IN) { const int kb = r / NBI, nb = r % NBI; const int c = incol(nb * 32 + (lane & 31));
            tr_item(c < 0 ? nullptr : w_in + c, INW, 1024, (bf16*)(F.ws + WS_WIN), nb * 32, kb * 64, scr, lane); continue; }
        r -= I_IN;
        if (r < I_BR) { const int b = r / 512, rr = r % 512, kb = rr / 32, nb = rr % 32;
            tr_item(A->in[I_WBR] + (size_t)(L * 3 + b) * 1048576 + nb * 32 + (lane & 31), 1024, 1024, (bf16*)(F.ws + WS_WBR) + (size_t)b * 1048576, nb * 32, kb * 64, scr, lane,
                    (FIX_PURE && b == 1) ? A->in[I_SNW] + (size_t)L * D : (FIX_PURE && b == 2) ? A->in[I_MNW] + (size_t)L * D : nullptr); continue; }
        r -= I_BR;
        if (r < I_OUT) { const int kb = r / 32, nb = r % 32;
            tr_item(A->in[I_WOUT] + (size_t)L * 1048576 + nb * 32 + (lane & 31), 1024, 1024, (bf16*)(F.ws + WS_WOUT), nb * 32, kb * 64, scr, lane); continue; }
        r -= I_OUT;
        if (r < I_GU) { const int e = r / 512, rr = r % 512, kb = rr / 32, nb = rr % 32; const int n = nb * 32 + (lane & 31), q = n >> 3, i = n & 7;
            const float* src = ((i < 4) ? A->in[I_WGATE] : A->in[I_WUP]) + (size_t)(L * 64 + e) * 524288 + 4 * q + (i & 3);
            tr_item(src, 512, 1024, (bf16*)(F.ws + WS_WGU) + (size_t)e * 1048576, nb * 32, kb * 64, scr, lane); continue; }
        r -= I_GU;
        { const int e = r / 256, rr = r % 256, kb = rr / 32, nb = rr % 32;
            tr_item(A->in[I_WDOWN] + (size_t)(L * 64 + e) * 524288 + nb * 32 + (lane & 31), 1024, 512, (bf16*)(F.ws + WS_WDN) + (size_t)e * 524288, nb * 32, kb * 64, scr, lane); }
    }
    bf16* wrh = (bf16*)(F.ws + WS_WRT); bf16* wrl = wrh + 80 * 1024;
    const float* wg = A->in[I_WG] + (size_t)L * 1024 * 8; const float* we = A->in[I_WER] + (size_t)L * 1024 * 64;
    for (int idx = F.bid * 512 + F.tid; idx < 80 * 1024; idx += F.G * 512) { const int c = idx >> 10, k = idx & 1023; const float v = (c < 8) ? wg[k * 8 + c] : (c < 72) ? we[k * 64 + (c - 8)] : 0.f;
        const unsigned hi = f2bf(v); wrh[idx] = (bf16)hi; wrl[idx] = (bf16)f2bf(v - bf2f((unsigned short)hi)); }
}

template <int COMBINE, int FINAL>
__device__ __forceinline__ void p_norm(Frame& F, const float* xin, float* X, const float* w, bf16* H) {
    const int gw = F.bid * NWAVES + F.wave, NGW = F.G * NWAVES, lane = F.lane;
    const int* tok_pos = (const int*)(F.ws + WS_ROUTE + 3 * 262144); const float* tok_w = (const float*)(F.ws + WS_ROUTE + 262144);
    const bf16* Y = (const bf16*)(F.ws + WS_HG);
    f32x4 wv[4];
#pragma unroll
    for (int j = 0; j < 4; ++j) wv[j] = ((const f32x4*)w)[lane + 64 * j];
    for (int m0 = 2 * gw; m0 < NT; m0 += 2 * NGW) {
        f32x4 v[2][4]; v2u ya[2][4], yb[2][4]; float w0[2], w1[2];
#pragma unroll
        for (int r = 0; r < 2; ++r) { const int m = m0 + r;
            const f32x4* xr = (const f32x4*)((COMBINE ? X : xin) + (size_t)m * D) + lane;
#pragma unroll
            for (int j = 0; j < 4; ++j) v[r][j] = NT_LOAD(xr + 64 * j);
            if (COMBINE) { const int p0 = tok_pos[2 * m], p1 = tok_pos[2 * m + 1]; w0[r] = tok_w[2 * m]; w1[r] = tok_w[2 * m + 1];
                const v2u* y0 = (const v2u*)(Y + (size_t)p0 * D) + lane; const v2u* y1 = (const v2u*)(Y + (size_t)p1 * D) + lane;
#pragma unroll
                for (int j = 0; j < 4; ++j) { ya[r][j] = NT_LOAD(y0 + 64 * j); yb[r][j] = NT_LOAD(y1 + 64 * j); } } }
#pragma unroll
        for (int r = 0; r < 2; ++r) { const int m = m0 + r;
            if (COMBINE) {
#pragma unroll
                for (int j = 0; j < 4; ++j) { const v2u a = ya[r][j], b = yb[r][j];
                    v[r][j].x += w0[r] * blo(a.x) + w1[r] * blo(b.x); v[r][j].y += w0[r] * bhi(a.x) + w1[r] * bhi(b.x); v[r][j].z += w0[r] * blo(a.y) + w1[r] * blo(b.y); v[r][j].w += w0[r] * bhi(a.y) + w1[r] * bhi(b.y); }
                if (!FINAL) { f32x4* xo = (f32x4*)(X + (size_t)m * D) + lane;
#pragma unroll
                    for (int j = 0; j < 4; ++j) NT_STORE(v[r][j], xo + 64 * j); }
            }
            float s = 0.f;
#pragma unroll
            for (int j = 0; j < 4; ++j) s += (v[r][j].x * v[r][j].x + v[r][j].y * v[r][j].y) + (v[r][j].z * v[r][j].z + v[r][j].w * v[r][j].w);
            const float rstd = 1.0f / sqrtf(wave_sum(s) * (1.f / D) + RMS_EPS);
            if (FINAL) { f32x4* xo = (f32x4*)(X + (size_t)m * D) + lane;
#pragma unroll
                for (int j = 0; j < 4; ++j) NT_STORE(v[r][j] * rstd * wv[j], xo + 64 * j);
            } else { GAS unsigned long long* o8 = (GAS unsigned long long*)(H + (size_t)m * D) + lane;
#pragma unroll
                for (int j = 0; j < 4; ++j) { const f32x4 y = v[r][j] * rstd * wv[j]; o8[64 * j] = (unsigned long long)pk2(y.x, y.y) | ((unsigned long long)pk2(y.z, y.w) << 32); } }
        }
    }
}

__device__ __forceinline__ void p_small(Frame& F) {
    typedef short bf16x8 __attribute__((ext_vector_type(8)));
    const int gw = F.bid * NWAVES + F.wave, NGW = F.G * NWAVES, lane = F.lane, r = lane & 15, g = lane >> 4;
    const bf16* H = (const bf16*)(F.ws + WS_H); const bf16* W = (const bf16*)(F.ws + WS_WIN) + (size_t)(NPN_IN * 256) * 1024; float* SM = (float*)(F.ws + WS_SMALL);
    for (int task = gw; task < NT / 16; task += NGW) {
        const int m0 = task * 16;
        const bf16x8* ap = (const bf16x8*)(H + (size_t)(m0 + r) * D + 8 * g);
        const bf16x8* bp0 = (const bf16x8*)(W + (size_t)(r) * D + 8 * g); const bf16x8* bp1 = (const bf16x8*)(W + (size_t)(16 + r) * D + 8 * g); const bf16x8* bp2 = (const bf16x8*)(W + (size_t)(32 + r) * D + 8 * g);
        f32x4 c0 = (f32x4){0.f, 0.f, 0.f, 0.f}, c1 = c0, c2 = c0;
#pragma unroll 8
        for (int ks = 0; ks < 32; ++ks) { const bf16x8 a = ap[ks * 4], b0 = bp0[ks * 4], b1 = bp1[ks * 4], b2 = bp2[ks * 4];
            c0 = __builtin_amdgcn_mfma_f32_16x16x32_bf16(a, b0, c0, 0, 0, 0); c1 = __builtin_amdgcn_mfma_f32_16x16x32_bf16(a, b1, c1, 0, 0, 0); c2 = __builtin_amdgcn_mfma_f32_16x16x32_bf16(a, b2, c2, 0, 0, 0); }
#pragma unroll
        for (int i = 0; i < 4; ++i) { float* o = SM + (size_t)(m0 + 4 * g + i) * 64 + r; o[0] = c0[i]; o[16] = c1[i]; o[32] = c2[i]; }
    }
}

__device__ __forceinline__ void p_fcum(Frame& F, KArgs A, int L) {
    LAS float* wt = (LAS float*)(F.lds + RING_OFF);
    const int lane = F.lane, t = F.tid, w = F.wave;
    for (int bh = F.bid; bh < NB * 16; bh += F.G) {
        const int b = bh >> 4, h = bh & 15; const float fb = A->in[I_AFB][L * 16 + h];
        const float* sm = (const float*)(F.ws + WS_SMALL) + (size_t)b * SEQ * 64 + h;
        float* out = (float*)(F.ws + WS_FB) + (size_t)bh * SEQ;
        float v[4]; float tot = 0.f;
#pragma unroll
        for (int i = 0; i < 4; ++i) v[i] = sm[(size_t)(t * 4 + i) * 64];
#pragma unroll
        for (int i = 0; i < 4; ++i) { v[i] = logsigmoid_f(v[i] + fb); tot += v[i]; }
        float inc = tot;
#pragma unroll
        for (int o = 1; o < 64; o <<= 1) { const float u = __shfl_up(inc, o); if (lane >= o) inc += u; }
        if (lane == 63) wt[w] = inc;
        __syncthreads();
        float run = inc - tot;
#pragma unroll
        for (int j = 0; j < NWAVES; ++j) run += (j < w) ? wt[j] : 0.f;
        f32x4 o4; run += v[0]; o4.x = run; run += v[1]; o4.y = run; run += v[2]; o4.z = run; run += v[3]; o4.w = run; *(f32x4*)(out + t * 4) = o4;
        __syncthreads();
    }
}

__device__ __forceinline__ void att_simple_unit(Frame& F, int b, int h, int qb) {
    LAS float* sK = (LAS float*)(F.lds + RING_OFF); LAS float* sV = sK + 4096; LAS float* sF = sV + 4096;
    const bf16* Q = (const bf16*)(F.ws + WS_PROJ); const bf16* K = (const bf16*)(F.ws + WS_PROJ + pg8::SLAB); const bf16* V = (const bf16*)(F.ws + WS_PROJ + 2 * pg8::SLAB);
    const float* FB = (const float*)(F.ws + WS_FB) + (size_t)(b * 16 + h) * SEQ;
    bf16* O = (bf16*)(F.ws + WS_YATT);
    const int tid = F.tid, t = qb * 512 + tid; const size_t row = (size_t)b * SEQ + t;
    float q[64], o[64];
    { const v4u* qp = (const v4u*)(Q + row * D + h * 64);
#pragma unroll
      for (int i = 0; i < 8; ++i) { const v4u w = qp[i]; q[8 * i + 0] = blo(w.x) * 0.125f; q[8 * i + 1] = bhi(w.x) * 0.125f; q[8 * i + 2] = blo(w.y) * 0.125f; q[8 * i + 3] = bhi(w.y) * 0.125f;
          q[8 * i + 4] = blo(w.z) * 0.125f; q[8 * i + 5] = bhi(w.z) * 0.125f; q[8 * i + 6] = blo(w.w) * 0.125f; q[8 * i + 7] = bhi(w.w) * 0.125f; } }
#pragma unroll
    for (int d = 0; d < 64; ++d) o[d] = 0.f;
    const float Fq = FB[t]; float mrun = -INFINITY, l = 0.f;
    const int ntile = (qb * 512 + 512) / 64;
    const int key = tid >> 3, dc = (tid & 7) * 8;
    for (int kt = 0; kt < ntile; ++kt) {
        __syncthreads();
        { const size_t kr = ((size_t)b * SEQ + kt * 64 + key) * D + h * 64 + dc; const v4u kw = *(const v4u*)(K + kr), vw = *(const v4u*)(V + kr);
          LAS float* kd = sK + key * 64 + dc; LAS float* vd = sV + key * 64 + dc;
          kd[0] = blo(kw.x); kd[1] = bhi(kw.x); kd[2] = blo(kw.y); kd[3] = bhi(kw.y); kd[4] = blo(kw.z); kd[5] = bhi(kw.z); kd[6] = blo(kw.w); kd[7] = bhi(kw.w);
          vd[0] = blo(vw.x); vd[1] = bhi(vw.x); vd[2] = blo(vw.y); vd[3] = bhi(vw.y); vd[4] = blo(vw.z); vd[5] = bhi(vw.z); vd[6] = blo(vw.w); vd[7] = bhi(vw.w);
          if (tid < 64) sF[tid] = FB[kt * 64 + tid]; }
        __syncthreads();
        for (int j = 0; j < 64; ++j) {
            const int pos = kt * 64 + j;
            if (pos <= t) {
                float s = Fq - sF[j];
                const LAS f32x4* kp = (const LAS f32x4*)(sK + j * 64);
#pragma unroll
                for (int d4 = 0; d4 < 16; ++d4) { const f32x4 kv = kp[d4]; s += q[4 * d4] * kv.x + q[4 * d4 + 1] * kv.y + q[4 * d4 + 2] * kv.z + q[4 * d4 + 3] * kv.w; }
                const float mn = fmaxf(mrun, s), corr = __expf(mrun - mn), p = __expf(s - mn);
                l = l * corr + p; mrun = mn;
                const LAS f32x4* vp = (const LAS f32x4*)(sV + j * 64);
#pragma unroll
                for (int d4 = 0; d4 < 16; ++d4) { const f32x4 vv = vp[d4]; o[4 * d4] = o[4 * d4] * corr + p * vv.x; o[4 * d4 + 1] = o[4 * d4 + 1] * corr + p * vv.y; o[4 * d4 + 2] = o[4 * d4 + 2] * corr + p * vv.z; o[4 * d4 + 3] = o[4 * d4 + 3] * corr + p * vv.w; }
            }
        }
    }
    const float rl = 1.0f / l;
    v4u* op = (v4u*)(O + row * D + h * 64);
#pragma unroll
    for (int i = 0; i < 8; ++i) { v4u w; w.x = pk2(o[8 * i] * rl, o[8 * i + 1] * rl); w.y = pk2(o[8 * i + 2] * rl, o[8 * i + 3] * rl); w.z = pk2(o[8 * i + 4] * rl, o[8 * i + 5] * rl); w.w = pk2(o[8 * i + 6] * rl, o[8 * i + 7] * rl); op[i] = w; }
}
__device__ __forceinline__ void p_att_simple(Frame& F) {
    for (int u = F.bid; u < 1024; u += F.G) { const int qb = 3 - (u >> 8), bh = u & 255; att_simple_unit(F, bh >> 4, bh & 15, qb); }
    __syncthreads();
}

__device__ __forceinline__ void ssd_simple_unit(Frame& F, KArgs A, int L, int b, int h) {
    constexpr int TB = 32;
    LAS float* cv = (LAS float*)(F.lds + RING_OFF);
    LAS float* sdt = cv + TB * 320; LAS float* sda = sdt + TB; LAS float* yb = sda + TB;
    const int tid = F.tid, g = h >> 2;
    const bf16* SZ = (const bf16*)(F.ws + WS_PROJ); const bf16* XBC = (const bf16*)(F.ws + WS_PROJ + pg8::SLAB) + (size_t)b * SEQ * 2048;
    const float* SM = (const float*)(F.ws + WS_SMALL) + (size_t)b * SEQ * 64;
    bf16* YO = (bf16*)(F.ws + WS_YSSD); float* SSQ = (float*)(F.ws + WS_SSQS);
    int ch = -1;
    if (tid < 64) ch = h * 64 + tid; else if (tid < 192) ch = 1024 + g * 128 + (tid - 64); else if (tid < 320) ch = 1536 + g * 128 + (tid - 192);
    float cw0 = 0.f, cw1 = 0.f, cw2 = 0.f, cw3 = 0.f, cb = 0.f;
    if (ch >= 0) { const float* cw = A->in[I_SCW] + (size_t)L * 4 * 2048 + ch; cw0 = cw[0]; cw1 = cw[2048]; cw2 = cw[4096]; cw3 = cw[6144]; cb = A->in[I_SCB][L * 2048 + ch]; }
    const float Aneg = -expf(A->in[I_SALOG][L * 16 + h]), dtb = A->in[I_SDTB][L * 16 + h], Dh = A->in[I_SD][L * 16 + h];
    float st[16];
#pragma unroll
    for (int j = 0; j < 16; ++j) st[j] = 0.f;
    const int p = tid >> 3, nq = tid & 7;
    float r0 = 0.f, r1 = 0.f, r2 = 0.f;
    for (int t0 = 0; t0 < SEQ; t0 += TB) {
        if (ch >= 0) {
#pragma unroll
            for (int s = 0; s < TB; ++s) { const float r3 = bf2f(XBC[(size_t)(t0 + s) * 2048 + ch]); const float y = cb + cw0 * r0 + cw1 * r1 + cw2 * r2 + cw3 * r3; cv[s * 320 + tid] = silu_f(y); r0 = r1; r1 = r2; r2 = r3; }
        } else if (tid < 320 + TB) { const int s = tid - 320; const float dt = softplus_f(SM[(size_t)(t0 + s) * 64 + 16 + h] + dtb); sdt[s] = dt; sda[s] = expf(dt * Aneg); }
        __syncthreads();
        for (int s = 0; s < TB; ++s) {
            const float xv = cv[s * 320 + p], dt = sdt[s], dA = sda[s], dx = dt * xv; float acc = 0.f;
#pragma unroll
            for (int j = 0; j < 16; ++j) { st[j] = st[j] * dA + dx * cv[s * 320 + 64 + nq * 16 + j]; acc += cv[s * 320 + 192 + nq * 16 + j] * st[j]; }
            acc += __shfl_xor(acc, 1); acc += __shfl_xor(acc, 2); acc += __shfl_xor(acc, 4);
            if (nq == 0) { const float z = bf2f(SZ[((size_t)b * SEQ + t0 + s) * D + h * 64 + p]); yb[s * 64 + p] = (acc + Dh * xv) * silu_f(z); }
        }
        __syncthreads();
        if (tid < TB) { float q = 0.f; for (int i = 0; i < 64; ++i) { const float y = yb[tid * 64 + i]; q += y * y; } SSQ[((size_t)b * SEQ + t0 + tid) * 16 + h] = q; }
        for (int i = tid; i < TB * 64; i += 512) { const int s = i >> 6, pp = i & 63; YO[((size_t)b * SEQ + t0 + s) * D + h * 64 + pp] = (bf16)f2bf(yb[i]); }
        __syncthreads();
    }
}
__device__ __forceinline__ void p_ssd_simple(Frame& F, KArgs A, int L) {
    for (int u = F.bid; u < NB * 16; u += F.G) ssd_simple_unit(F, A, L, u >> 4, u & 15);
}

__device__ __forceinline__ void ml_simple_unit(Frame& F, KArgs A, int L, int b, int h, int vs) {
    constexpr int TB = 16;
    LAS float* sq = (LAS float*)(F.lds + RING_OFF); LAS float* sk = sq + TB * 256; LAS float* sv = sk + TB * 256; LAS float* sg = sv + TB * 64;
    LAS float* red = sg + 2 * TB; LAS float* redd = red + 2 * 8 * 64; LAS float* hb = redd + 16;
    const int tid = F.tid, w = tid >> 6, v = tid & 63;
    const bf16* MQ = (const bf16*)(F.ws + WS_PROJ); const bf16* MK = (const bf16*)(F.ws + WS_PROJ + pg8::SLAB); const bf16* MV = (const bf16*)(F.ws + WS_PROJ + 2 * pg8::SLAB);
    const float* SM = (const float*)(F.ws + WS_SMALL) + (size_t)b * SEQ * 64;
    bf16* YO = (bf16*)(F.ws + WS_YML); float* SSQ = (float*)(F.ws + WS_SSQM);
    const bool isk = tid >= 256; const int cc = h * 256 + (tid & 255), cidx = (isk ? 1024 : 0) + cc;
    const bf16* src = (isk ? MK : MQ) + (size_t)b * SEQ * D + cc;
    const float* cw = A->in[I_MCW] + (size_t)L * 4 * 2048 + cidx; const float cw0 = cw[0], cw1 = cw[2048], cw2 = cw[4096], cw3 = cw[6144], cb = A->in[I_MCB][L * 2048 + cidx];
    const float ib = A->in[I_MIB][L * 4 + h], fbias = A->in[I_MFB][L * 4 + h];
    const float ksc = isk ? 0.0625f : 1.0f;
    float C[32], n[32];
#pragma unroll
    for (int j = 0; j < 32; ++j) { C[j] = 0.f; n[j] = 0.f; }
    float m = 0.f, r0 = 0.f, r1 = 0.f, r2 = 0.f;
    for (int t0 = 0; t0 < SEQ; t0 += TB) {
#pragma unroll
        for (int s = 0; s < TB; ++s) { const float r3 = bf2f(src[(size_t)(t0 + s) * D]); const float y = cb + cw0 * r0 + cw1 * r1 + cw2 * r2 + cw3 * r3; (isk ? sk : sq)[s * 256 + (tid & 255)] = silu_f(y) * ksc; r0 = r1; r1 = r2; r2 = r3; }
        for (int i = tid; i < TB * 64; i += 512) { const int s = i >> 6, j = i & 63; sv[i] = bf2f(MV[((size_t)b * SEQ + t0 + s) * D + h * 256 + vs * 64 + j]); }
        if (tid < TB) { const float* r = SM + (size_t)(t0 + tid) * 64; sg[2 * tid] = r[32 + h] + ib; sg[2 * tid + 1] = logsigmoid_f(r[36 + h] + fbias); }
        __syncthreads();
        for (int s = 0; s < TB; ++s) {
            const float ig = sg[2 * s], lf = sg[2 * s + 1]; const float mn = fmaxf(lf + m, ig); const float fs = expf(lf + m - mn), is = expf(ig - mn); m = mn;
            const float vv = sv[s * 64 + v]; float nump = 0.f, denp = 0.f;
#pragma unroll
            for (int j = 0; j < 32; ++j) { const float kd = sk[s * 256 + w * 32 + j] * is, qd = sq[s * 256 + w * 32 + j]; C[j] = fs * C[j] + kd * vv; nump += qd * C[j]; n[j] = fs * n[j] + kd; denp += qd * n[j]; }
            const int par = s & 1;
            red[(par * 8 + w) * 64 + v] = nump; if (v == 0) redd[par * 8 + w] = denp;
            __syncthreads();
            if (w == 0) { float num = 0.f, den = 0.f;
#pragma unroll
                for (int ww = 0; ww < 8; ++ww) { num += red[(par * 8 + ww) * 64 + v]; den += redd[par * 8 + ww]; }
                hb[s * 64 + v] = num / fmaxf(fabsf(den), expf(-m)); }
        }
        __syncthreads();
        if (tid < TB) { float q = 0.f; for (int i = 0; i < 64; ++i) { const float y = hb[tid * 64 + i]; q += y * y; } SSQ[((size_t)b * SEQ + t0 + tid) * 16 + h * 4 + vs] = q; }
        for (int i = tid; i < TB * 64; i += 512) { const int s = i >> 6, j = i & 63; YO[((size_t)b * SEQ + t0 + s) * D + h * 256 + vs * 64 + j] = (bf16)f2bf(hb[i]); }
        __syncthreads();
    }
}
__device__ __forceinline__ void p_ml_simple(Frame& F, KArgs A, int L) {
    for (int u = F.bid; u < NB * 16; u += F.G) ml_simple_unit(F, A, L, u >> 4, (u >> 2) & 3, u & 3);
}

template <int ML>
__device__ __forceinline__ void p_fix(Frame& F, KArgs A, int L) {
    const int gw = F.bid * NWAVES + F.wave, NGW = F.G * NWAVES, lane = F.lane;
    bf16* Y = (bf16*)(F.ws + (ML ? WS_YML : WS_XSSD)); const float* SSQ = (const float*)(F.ws + (ML ? WS_SSQM : WS_SSQS));
    const bf16* MO = (const bf16*)(F.ws + WS_PROJ + 3 * pg8::SLAB);
    const float* nw = A->in[ML ? I_MNW : I_SNW] + (size_t)L * D;
    f32x4 wv[2][2];
#pragma unroll
    for (int j = 0; j < 2; ++j) { wv[j][0] = *(const f32x4*)(nw + 8 * (lane + 64 * j)); wv[j][1] = *(const f32x4*)(nw + 8 * (lane + 64 * j) + 4); }
    for (int m0 = gw * 4; m0 < NT; m0 += NGW * 4) {
        v4u y[4][2], o[4][2]; float rs[4][2];
#pragma unroll
        for (int r = 0; r < 4; ++r)
#pragma unroll
            for (int j = 0; j < 2; ++j) { y[r][j] = NT_LOAD((const v4u*)(Y + (size_t)(m0 + r) * D + 8 * (lane + 64 * j))); if (ML && !FIX_PURE) o[r][j] = *(const v4u*)(MO + (size_t)(m0 + r) * D + 8 * (lane + 64 * j));
                const f32x4 q = *(const f32x4*)(SSQ + (size_t)(m0 + r) * 16 + 4 * ((lane >> 5) + 2 * j)); rs[r][j] = ((q.x + q.y) + (q.z + q.w)) * (1.f / 256.f) + RMS_EPS; }
#pragma unroll
        for (int r = 0; r < 4; ++r)
#pragma unroll
            for (int j = 0; j < 2; ++j) { const float rstd = 1.0f / sqrtf(rs[r][j]); const unsigned yw[4] = {y[r][j].x, y[r][j].y, y[r][j].z, y[r][j].w}; unsigned ow[4] = {0u, 0u, 0u, 0u}; if (ML && !FIX_PURE) { ow[0] = o[r][j].x; ow[1] = o[r][j].y; ow[2] = o[r][j].z; ow[3] = o[r][j].w; }
                unsigned res[4];
#pragma unroll
                for (int e = 0; e < 4; ++e) { const float w0 = (e < 2) ? wv[j][0][2 * e] : wv[j][1][2 * e - 4], w1 = (e < 2) ? wv[j][0][2 * e + 1] : wv[j][1][2 * e - 3];
                    float a = blo(yw[e]) * rstd * (FIX_PURE ? 1.f : w0), b2 = bhi(yw[e]) * rstd * (FIX_PURE ? 1.f : w1);
                    if (ML && !FIX_PURE) { a *= sigmoid_f(blo(ow[e])); b2 *= sigmoid_f(bhi(ow[e])); }
                    res[e] = pk2(a, b2); }
                v4u w; w.x = res[0]; w.y = res[1]; w.z = res[2]; w.w = res[3]; NT_STORE(w, (v4u*)(Y + (size_t)(m0 + r) * D + 8 * (lane + 64 * j))); }
    }
}

__device__ __forceinline__ void p_probe_copy(Frame& F, int k) {
    const int gw = F.bid * NWAVES + F.wave, NGW = F.G * NWAVES, lane = F.lane;
    const bf16* Y = (const bf16*)(F.ws + WS_WGU + (size_t)k * 64 * MiB); bf16* O = (bf16*)(F.ws + WS_END + (size_t)k * 64 * MiB);
    for (int m0 = gw * 4; m0 < NT; m0 += NGW * 4) {
        v4u y[4][2];
#pragma unroll
        for (int r = 0; r < 4; ++r)
#pragma unroll
            for (int j = 0; j < 2; ++j) y[r][j] = *(const v4u*)(Y + (size_t)(m0 + r) * D + 8 * (lane + 64 * j));
#pragma unroll
        for (int r = 0; r < 4; ++r)
#pragma unroll
            for (int j = 0; j < 2; ++j) *(v4u*)(O + (size_t)(m0 + r) * D + 8 * (lane + 64 * j)) = y[r][j];
    }
}
template <int ML>
__device__ __forceinline__ void p_fix_row(Frame& F, KArgs A, int L, int m) {
    const int lane = F.lane;
    bf16* Y = (bf16*)(F.ws + (ML ? WS_YML : WS_XSSD)); const float* SSQ = (const float*)(F.ws + (ML ? WS_SSQM : WS_SSQS));
    const bf16* MO = (const bf16*)(F.ws + WS_PROJ + 3 * pg8::SLAB);
    const float* nw = A->in[ML ? I_MNW : I_SNW] + (size_t)L * D;
#pragma unroll
    for (int j = 0; j < 2; ++j) { const v4u y = *(const v4u*)(Y + (size_t)m * D + 8 * (lane + 64 * j)); v4u o = (v4u){0u, 0u, 0u, 0u}; if (ML && !FIX_PURE) o = *(const v4u*)(MO + (size_t)m * D + 8 * (lane + 64 * j));
        const f32x4 q = *(const f32x4*)(SSQ + (size_t)m * 16 + 4 * ((lane >> 5) + 2 * j)); const float rstd = 1.0f / sqrtf(((q.x + q.y) + (q.z + q.w)) * (1.f / 256.f) + RMS_EPS);
        const f32x4 w0 = *(const f32x4*)(nw + 8 * (lane + 64 * j)), w1 = *(const f32x4*)(nw + 8 * (lane + 64 * j) + 4);
        const float wv[8] = {w0.x, w0.y, w0.z, w0.w, w1.x, w1.y, w1.z, w1.w}; const unsigned yw[4] = {y.x, y.y, y.z, y.w}, ow[4] = {o.x, o.y, o.z, o.w}; unsigned res[4];
#pragma unroll
        for (int e = 0; e < 4; ++e) { float a = blo(yw[e]) * rstd * (FIX_PURE ? 1.f : wv[2 * e]), b2 = bhi(yw[e]) * rstd * (FIX_PURE ? 1.f : wv[2 * e + 1]);
            if (ML && !FIX_PURE) { a *= sigmoid_f(blo(ow[e])); b2 *= sigmoid_f(bhi(ow[e])); }
            res[e] = pk2(a, b2); }
        v4u w; w.x = res[0]; w.y = res[1]; w.z = res[2]; w.w = res[3]; *(v4u*)(Y + (size_t)m * D + 8 * (lane + 64 * j)) = w; }
}

__device__ __forceinline__ void p_router(Frame& F, KArgs A, int L) {
    typedef short bf16x8 __attribute__((ext_vector_type(8)));
    const int gw = F.bid * NWAVES + F.wave, NGW = F.G * NWAVES, lane = F.lane, r = lane & 15, g = lane >> 4;
    const float* X = F.out; bf16* H = (bf16*)(F.ws + WS_H);
    const float* nw = A->in[I_N2W] + (size_t)L * D; const bf16* wrh = (const bf16*)(F.ws + WS_WRT); const bf16* wrl = wrh + 80 * 1024;
    const float* bg = A->in[I_BG] + L * 8; const float* ber = A->in[I_BER] + L * 64;
    int* tok_e = (int*)(F.ws + WS_ROUTE); float* tok_w = (float*)(F.ws + WS_ROUTE + 262144); int* tok_rank = (int*)(F.ws + WS_ROUTE + 2 * 262144);
    unsigned* cnt = (unsigned*)F.ctl + CW_CNT + 64 * L;
    LAS float* LG = (LAS float*)(F.lds + RING_OFF) + F.wave * (16 * 80);
    LAS int* lc = (LAS int*)(F.lds + RING_OFF + 49152); LAS int* lb = lc + 64;
    const bool two = ROUTER_2LVL && ((NT / 16) % NGW == 0);
    const bool three = ROUTER_NOATOM && two && (NT / 16 == NGW);
    int* cw = (int*)F.ctl + CW_WG + 16384 * L;
    if (two) { if (F.tid < 64) lc[F.tid] = 0; __syncthreads(); }
    for (int task = gw; task < NT / 16; task += NGW) {
        const int m0 = task * 16; const float* xr = X + (size_t)(m0 + r) * D + 8 * g;
        float s = 0.f;
#if RESID_SSQ
        { const f32x4 q = *(const f32x4*)((const float*)(F.ws + WS_SSQS) + (size_t)(m0 + r) * 16 + 4 * g); s = (q.x + q.y) + (q.z + q.w); }
#else
#pragma unroll 8
        for (int ks = 0; ks < 32; ++ks) { const f32x4 a = *(const f32x4*)(xr + 32 * ks), b = *(const f32x4*)(xr + 32 * ks + 4); s += (a.x * a.x + a.y * a.y) + (a.z * a.z + a.w * a.w) + (b.x * b.x + b.y * b.y) + (b.z * b.z + b.w * b.w); }
#endif
        s += __shfl_xor(s, 16); s += __shfl_xor(s, 32);
        const float rstd = 1.0f / sqrtf(s * (1.f / D) + RMS_EPS);
        f32x4 acc[5];
#pragma unroll
        for (int j = 0; j < 5; ++j) acc[j] = (f32x4){0.f, 0.f, 0.f, 0.f};
        bf16* hr = H + (size_t)(m0 + r) * D + 8 * g;
#pragma unroll 4
        for (int ks = 0; ks < 32; ++ks) {
#if ROUTER_NT
            const f32x4 a = NT_LOAD((const f32x4*)(xr + 32 * ks)), b = NT_LOAD((const f32x4*)(xr + 32 * ks + 4));
#else
            const f32x4 a = *(const f32x4*)(xr + 32 * ks), b = *(const f32x4*)(xr + 32 * ks + 4);
#endif
            const f32x4 wa = *(const f32x4*)(nw + 32 * ks + 8 * g), wb = *(const f32x4*)(nw + 32 * ks + 8 * g + 4);
            float hv[8] = {a.x * rstd * wa.x, a.y * rstd * wa.y, a.z * rstd * wa.z, a.w * rstd * wa.w, b.x * rstd * wb.x, b.y * rstd * wb.y, b.z * rstd * wb.z, b.w * rstd * wb.w};
            bf16x8 ah, al;
#pragma unroll
            for (int e = 0; e < 8; ++e) { const unsigned hi = f2bf(hv[e]); ah[e] = (short)hi; al[e] = (short)f2bf(hv[e] - bf2f((unsigned short)hi)); }
            *(bf16x8*)(hr + 32 * ks) = ah;
#pragma unroll
            for (int j = 0; j < 5; ++j) { const size_t wo = (size_t)(16 * j + r) * 1024 + 32 * ks + 8 * g; const bf16x8 bh = *(const bf16x8*)(wrh + wo), bl = *(const bf16x8*)(wrl + wo);
                acc[j] = __builtin_amdgcn_mfma_f32_16x16x32_bf16(ah, bh, acc[j], 0, 0, 0); acc[j] = __builtin_amdgcn_mfma_f32_16x16x32_bf16(ah, bl, acc[j], 0, 0, 0); acc[j] = __builtin_amdgcn_mfma_f32_16x16x32_bf16(al, bh, acc[j], 0, 0, 0); }
        }
#pragma unroll
        for (int j = 0; j < 5; ++j)
#pragma unroll
            for (int i = 0; i < 4; ++i) LG[(4 * g + i) * 80 + 16 * j + r] = acc[j][i];
        LDS_WAIT(); asm volatile("" ::: "memory");
        int se1 = 0, se2 = 0, sk1 = 0, sk2 = 0;
        if (lane < 16) {
            const LAS float* lg = LG + lane * 80; const int m = m0 + lane;
            float gl[8], gmax; int gsel = 0;
#pragma unroll
            for (int j = 0; j < 8; ++j) gl[j] = lg[j] + bg[j];
            gmax = gl[0];
#pragma unroll
            for (int j = 1; j < 8; ++j) if (gl[j] > gmax) { gmax = gl[j]; gsel = j; }
            float den = 0.f;
#pragma unroll
            for (int j = 0; j < 8; ++j) den += expf(gl[j] - gmax);
            const float pg = 1.0f / den;
            float el[8];
#pragma unroll
            for (int j = 0; j < 8; ++j) el[j] = lg[8 + gsel * 8 + j] + ber[gsel * 8 + j];
            int i1 = 0; float v1 = el[0];
#pragma unroll
            for (int j = 1; j < 8; ++j) if (el[j] > v1) { v1 = el[j]; i1 = j; }
            int i2 = -1; float v2 = -INFINITY;
#pragma unroll
            for (int j = 0; j < 8; ++j) if (j != i1 && el[j] > v2) { v2 = el[j]; i2 = j; }
            const float ex = expf(v2 - v1); const float w1 = pg / (1.0f + ex), w2 = pg * ex / (1.0f + ex);
            const int e1 = gsel * 8 + i1, e2 = gsel * 8 + i2;
            tok_e[2 * m] = e1; tok_e[2 * m + 1] = e2; tok_w[2 * m] = w1; tok_w[2 * m + 1] = w2;
            if (two) { se1 = e1; se2 = e2; sk1 = __hip_atomic_fetch_add(lc + e1, 1, __ATOMIC_RELAXED, __HIP_MEMORY_SCOPE_WORKGROUP); sk2 = __hip_atomic_fetch_add(lc + e2, 1, __ATOMIC_RELAXED, __HIP_MEMORY_SCOPE_WORKGROUP); }
            else { const unsigned k1 = __hip_atomic_fetch_add(cnt + e1, 1u, RLX_AGENT), k2 = __hip_atomic_fetch_add(cnt + e2, 1u, RLX_AGENT); tok_rank[2 * m] = (int)k1; tok_rank[2 * m + 1] = (int)k2; }
        }
        LDS_WAIT(); asm volatile("" ::: "memory");
        if (two) {
            __syncthreads();
            if (F.tid < 64) { const int c = lc[F.tid]; if (three) { cw[(size_t)F.bid * 64 + F.tid] = c; lb[F.tid] = 0; } else lb[F.tid] = c ? (int)__hip_atomic_fetch_add(cnt + F.tid, (unsigned)c, RLX_AGENT) : 0; }
            __syncthreads();
            if (lane < 16) { const int m = m0 + lane; tok_rank[2 * m] = lb[se1] + sk1; tok_rank[2 * m + 1] = lb[se2] + sk2; }
            __syncthreads();
            if (F.tid < 64) lc[F.tid] = 0;
            __syncthreads();
        }
    }
}

__device__ __forceinline__ void moe_table(Frame& F, int L, const LAS int* totp = nullptr) {
    LAS int* tab = (LAS int*)(F.lds + TAB_OFF);
    if (F.wave == 0) {
        const unsigned* cnt = (const unsigned*)F.ctl + CW_CNT + 64 * L; const int lane = F.lane;
        const int n = totp ? totp[lane] : (int)__hip_atomic_load(cnt + lane, RLX_AGENT), tiles = (n + 255) >> 8, rem = n & 255;
        const int tail = (MOE_ROWSKIP == 1 && rem != 0 && rem <= 128) ? 1 : 0;
        int inc = tiles, ia = tiles - tail, ib = tail;
#pragma unroll
        for (int o = 1; o < 64; o <<= 1) { const int t = __shfl_up(inc, o), ta = __shfl_up(ia, o), tb = __shfl_up(ib, o); if (lane >= o) { inc += t; ia += ta; ib += tb; } }
        const int t0 = inc - tiles, a0 = ia - (tiles - tail), b0 = __shfl(ia, 63) + ib - tail;
        tab[lane] = t0; if (lane == 63) tab[64] = inc;
        for (int t = 0; t < tiles; ++t) { const bool is_tail = tail && t == tiles - 1; const int valid = (n - 256 * t) < 256 ? (n - 256 * t) : 256;
            tab[pg8::MOE_ORDER_OFF + (is_tail ? b0 : a0 + t)] = (t0 + t) | (lane << 9) | (valid << 15); }
    }
    __syncthreads();
}
__device__ __forceinline__ void p_gather(Frame& F, int L) {
    const int NGW = F.G * NWAVES; const bool three = ROUTER_NOATOM && ROUTER_2LVL && (NT / 16 == NGW);
    LAS int* part = (LAS int*)(F.lds + RING_OFF); LAS int* tot = part + 1024; LAS int* bs = tot + 64;
    unsigned* cnt = (unsigned*)F.ctl + CW_CNT + 64 * L;
    const int w0 = (2 * F.bid < 256) ? 2 * F.bid : 0;
    if (three) {
        const int* cw = (const int*)F.ctl + CW_WG + 16384 * L; const int lane = F.lane, v = F.wave;
        int all = 0, lt = 0;
#pragma unroll 8
        for (int i = 0; i < 32; ++i) { const int w = 32 * v + i; const int c = cw[w * 64 + lane]; all += c; lt += (w < w0) ? c : 0; }
        part[(v * 2 + 0) * 64 + lane] = all; part[(v * 2 + 1) * 64 + lane] = lt;
        __syncthreads();
        if (v == 0) { int t = 0, b = 0;
#pragma unroll
            for (int j = 0; j < 8; ++j) { t += part[(j * 2 + 0) * 64 + lane]; b += part[(j * 2 + 1) * 64 + lane]; }
            tot[lane] = t; bs[lane] = b; bs[64 + lane] = b + cw[w0 * 64 + lane];
            if (F.bid == 0) cnt[lane] = (unsigned)t; }
        __syncthreads();
    }
    moe_table(F, L, three ? (const LAS int*)tot : nullptr);
    const LAS int* tab = (const LAS int*)(F.lds + TAB_OFF);
    const int* tok_e = (const int*)(F.ws + WS_ROUTE); const int* tok_rank = (const int*)(F.ws + WS_ROUTE + 2 * 262144); int* tok_pos = (int*)(F.ws + WS_ROUTE + 3 * 262144);
    int* row_tok = (int*)(F.ws + WS_ROWTOK);
    for (int a = F.bid * 512 + F.tid; a < 2 * NT; a += F.G * 512) { const int e = tok_e[a]; int pos = tab[e] * 256 + tok_rank[a]; if (three) pos += bs[(((a >> 1) >> 7) - w0) * 64 + e]; tok_pos[a] = pos; row_tok[pos] = a >> 1; }
    for (int e = F.bid; e < 64; e += F.G) { const int c0 = tab[e] * 256 + (three ? tot[e] : (int)__hip_atomic_load(cnt + e, RLX_AGENT)), c1 = tab[e + 1] * 256;
        for (int r = c0 + F.tid; r < c1; r += 512) row_tok[r] = 0; }
}

__device__ __forceinline__ void p_conv2(Frame& F, const bf16* src0, int ld0, const bf16* src1, int ld1, bf16* dst0, bf16* dst1, const float* cw, const float* cb, float sc0, float sc1) {
    const int gw = F.bid * NWAVES + F.wave, NGW = F.G * NWAVES, lane = F.lane;
    for (int task = gw; task < 2048; task += NGW) {
        const int which = task >> 10, rem = task & 1023, chalf = rem & 1, rb = rem >> 1;
        const int c = chalf * 512 + lane * 8, cc = which * 1024 + c;
        const bf16* src = (which ? src1 : src0) + c; const int ld = which ? ld1 : ld0; bf16* dst = (which ? dst1 : dst0) + c; const float sc = which ? sc1 : sc0;
        float w[4][8], bb[8];
#pragma unroll
        for (int k = 0; k < 4; ++k) { const f32x4 a = *(const f32x4*)(cw + k * 2048 + cc), b2 = *(const f32x4*)(cw + k * 2048 + cc + 4); w[k][0] = a.x; w[k][1] = a.y; w[k][2] = a.z; w[k][3] = a.w; w[k][4] = b2.x; w[k][5] = b2.y; w[k][6] = b2.z; w[k][7] = b2.w; }
        { const f32x4 a = *(const f32x4*)(cb + cc), b2 = *(const f32x4*)(cb + cc + 4); bb[0] = a.x; bb[1] = a.y; bb[2] = a.z; bb[3] = a.w; bb[4] = b2.x; bb[5] = b2.y; bb[6] = b2.z; bb[7] = b2.w; }
        const int row0 = rb * 64; const bool first = (row0 & (SEQ - 1)) == 0;
        float r0[8], r1[8], r2[8];
#pragma unroll
        for (int e = 0; e < 8; ++e) { r0[e] = 0.f; r1[e] = 0.f; r2[e] = 0.f; }
        if (!first) {
            const v4u a = *(const v4u*)(src + (size_t)(row0 - 3) * ld), b2 = *(const v4u*)(src + (size_t)(row0 - 2) * ld), c2 = *(const v4u*)(src + (size_t)(row0 - 1) * ld);
            r0[0] = blo(a.x); r0[1] = bhi(a.x); r0[2] = blo(a.y); r0[3] = bhi(a.y); r0[4] = blo(a.z); r0[5] = bhi(a.z); r0[6] = blo(a.w); r0[7] = bhi(a.w);
            r1[0] = blo(b2.x); r1[1] = bhi(b2.x); r1[2] = blo(b2.y); r1[3] = bhi(b2.y); r1[4] = blo(b2.z); r1[5] = bhi(b2.z); r1[6] = blo(b2.w); r1[7] = bhi(b2.w);
            r2[0] = blo(c2.x); r2[1] = bhi(c2.x); r2[2] = blo(c2.y); r2[3] = bhi(c2.y); r2[4] = blo(c2.z); r2[5] = bhi(c2.z); r2[6] = blo(c2.w); r2[7] = bhi(c2.w);
        }
        for (int rr = 0; rr < 64; rr += 8) {
            v4u in[8];
#pragma unroll
            for (int i = 0; i < 8; ++i) in[i] = *(const v4u*)(src + (size_t)(row0 + rr + i) * ld);
#pragma unroll
            for (int i = 0; i < 8; ++i) {
                float r3[8]; r3[0] = blo(in[i].x); r3[1] = bhi(in[i].x); r3[2] = blo(in[i].y); r3[3] = bhi(in[i].y); r3[4] = blo(in[i].z); r3[5] = bhi(in[i].z); r3[6] = blo(in[i].w); r3[7] = bhi(in[i].w);
                float y[8];
#pragma unroll
                for (int e = 0; e < 8; ++e) { const float t = bb[e] + w[0][e] * r0[e] + w[1][e] * r1[e] + w[2][e] * r2[e] + w[3][e] * r3[e]; y[e] = t * __builtin_amdgcn_rcpf(1.0f + __expf(-t)) * sc; r0[e] = r1[e]; r1[e] = r2[e]; r2[e] = r3[e]; }
                v4u o; o.x = pk2(y[0], y[1]); o.y = pk2(y[2], y[3]); o.z = pk2(y[4], y[5]); o.w = pk2(y[6], y[7]);
                *(v4u*)(dst + (size_t)(row0 + rr + i) * 1024) = o;
            }
        }
    }
}

__device__ __forceinline__ void p_convfix(Frame& F, bf16* d0, bf16* d1, const float* cw, const float* cb, float sc1, size_t rawh_off) {
    const bf16* rawh = (const bf16*)(F.ws + rawh_off);
    for (int p = F.bid * 512 + F.tid; p < 512 * 256; p += F.G * 512) {
        const int cg = p & 255, B = p >> 8; const int ch = cg * 8; const bool seq0 = (B & 31) == 0;
        v4u sl[6];
#pragma unroll
        for (int k = 0; k < 6; ++k) { sl[k] = (v4u){0u, 0u, 0u, 0u}; if (!(seq0 && k < 3)) sl[k] = *(const v4u*)(rawh + ((size_t)B * 6 + k) * 2048 + ch); }
        float w[4][8], bb[8];
#pragma unroll
        for (int h = 0; h < 2; ++h) { const f32x4 a0 = *(const f32x4*)(cw + ch + 4 * h), a1 = *(const f32x4*)(cw + 2048 + ch + 4 * h), a2 = *(const f32x4*)(cw + 4096 + ch + 4 * h), a3 = *(const f32x4*)(cw + 6144 + ch + 4 * h), b4 = *(const f32x4*)(cb + ch + 4 * h);
#pragma unroll
            for (int e = 0; e < 4; ++e) { w[0][4 * h + e] = a0[e]; w[1][4 * h + e] = a1[e]; w[2][4 * h + e] = a2[e]; w[3][4 * h + e] = a3[e]; bb[4 * h + e] = b4[e]; } }
        float x[6][8];
#pragma unroll
        for (int k = 0; k < 6; ++k) { const v4u v = sl[k]; x[k][0] = blo(v.x); x[k][1] = bhi(v.x); x[k][2] = blo(v.y); x[k][3] = bhi(v.y); x[k][4] = blo(v.z); x[k][5] = bhi(v.z); x[k][6] = blo(v.w); x[k][7] = bhi(v.w); }
        const float sc = ch >= 1024 ? sc1 : 1.0f; bf16* dst = (ch >= 1024 ? d1 : d0) + (size_t)(B * 64) * 1024 + (ch & 1023);
#pragma unroll
        for (int r = 0; r < 3; ++r) { float y[8];
#pragma unroll
            for (int e = 0; e < 8; ++e) { const float t = bb[e] + w[0][e] * x[r][e] + w[1][e] * x[r + 1][e] + w[2][e] * x[r + 2][e] + w[3][e] * x[r + 3][e];
                y[e] = t * __builtin_amdgcn_rcpf(1.0f + __expf(-t)) * sc; }
            v4u o; o.x = pk2(y[0], y[1]); o.y = pk2(y[2], y[3]); o.z = pk2(y[4], y[5]); o.w = pk2(y[6], y[7]);
            *(v4u*)(dst + (size_t)r * 1024) = o; }
    }
}

namespace mixk {
typedef short bf16x8 __attribute__((ext_vector_type(8)));
typedef short s16x4 __attribute__((ext_vector_type(4)));
typedef float f32x16 __attribute__((ext_vector_type(16)));
__device__ __forceinline__ unsigned offb(unsigned row, unsigned ch) { return 2048u * (row >> 3) + 512u * (ch >> 2) + 64u * (row & 7u) + 16u * ((ch & 3u) ^ ((row >> 2) & 3u)); }
__device__ __forceinline__ s16x4 trrd(const LAS unsigned char* p) { return __builtin_bit_cast(s16x4, __builtin_amdgcn_ds_read_tr16_b64_v4i16((LAS s16x4*)p)); }
struct FragBase { unsigned re, t0, t1; };
struct FragBase16 { unsigned r16, u0, u1; };
__device__ __forceinline__ FragBase frag_base(int lane) {
    FragBase f; const unsigned l31 = lane & 31, h = lane >> 5, x = (l31 >> 2) & 3;
    f.re = 2048u * (l31 >> 3) + 64u * (l31 & 7) + 16u * (h ^ x);
    const unsigned blk = (lane >> 4) & 1, q = (lane & 15) >> 2, p = lane & 3, cc = 2 * blk + (p >> 1);
    f.t0 = 2048u * h + 64u * q + 16u * (cc ^ (2 * h)) + 8u * (p & 1); f.t1 = 2048u * h + 64u * (4 + q) + 16u * (cc ^ (2 * h + 1)) + 8u * (p & 1);
    return f;
}
__device__ __forceinline__ FragBase16 frag_base16(int lane, int c16  ) {
    FragBase16 f; const unsigned l15 = lane & 15, g = lane >> 4, q = (lane & 15) >> 2, p = lane & 3;
    f.r16 = 2048u * (l15 >> 3) + 64u * (l15 & 7) + 16u * (g ^ ((l15 >> 2) & 3));
    const unsigned c2 = 2 * (c16 & 1) + (p >> 1);
    f.u0 = 2048u * g + 512u * (c16 >> 1) + 64u * q + 16u * (c2 ^ ((2 * g) & 3)) + 8u * (p & 1); f.u1 = 2048u * g + 512u * (c16 >> 1) + 64u * (4 + q) + 16u * (c2 ^ ((2 * g + 1) & 3)) + 8u * (p & 1);
    return f;
}
__device__ __forceinline__ bf16x8 rowfrag(const LAS unsigned char* tile, const FragBase& f, int rb, int s) { return *(const LAS bf16x8*)(tile + rb * 8192 + (s >> 1) * 512 + (f.re ^ ((unsigned)(s & 1) << 5))); }
__device__ __forceinline__ bf16x8 trfrag(const LAS unsigned char* tile, const FragBase& f, int c, int ks) {
    const s16x4 lo = trrd(tile + 4096 * ks + 512 * c + f.t0), hi = trrd(tile + 4096 * ks + 512 * c + f.t1);
    return (bf16x8){lo[0], lo[1], lo[2], lo[3], hi[0], hi[1], hi[2], hi[3]};
}
__device__ __forceinline__ bf16x8 rowfrag16(const LAS unsigned char* tile, const FragBase16& f, int rb, int s) { return *(const LAS bf16x8*)(tile + rb * 4096 + s * 512 + f.r16); }
__device__ __forceinline__ bf16x8 trfrag16(const LAS unsigned char* tile, const FragBase16& f, int ks) {
    const s16x4 lo = trrd(tile + 8192 * ks + f.u0), hi = trrd(tile + 8192 * ks + f.u1);
    return (bf16x8){lo[0], lo[1], lo[2], lo[3], hi[0], hi[1], hi[2], hi[3]};
}
__device__ __forceinline__ float fast_logsigmoid(float x) { return fminf(x, 0.f) - __logf(1.0f + __expf(-fabsf(x))); }
__device__ __forceinline__ float fast_softplus(float x) { return fmaxf(x, 0.f) + __logf(1.0f + __expf(-fabsf(x))); }
constexpr int SC_A = 0, SC_M = 128, SC_INTER = 256, SC_EMT = 384, SC_WK = 512, SC_DEN1 = 640, SC_DEN2 = 1152, SC_N0 = 1280, SC_N1 = 1536, SC_MISC = 1792;

template <int CTRL, int RM> __device__ __forceinline__ float dpp_keep(float old, float v) { return __builtin_bit_cast(float, __builtin_amdgcn_update_dpp(__builtin_bit_cast(int, old), __builtin_bit_cast(int, v), CTRL, RM, 0xF, false)); }
__device__ __forceinline__ float scan_add(float v) {
    v += dpp_keep<0x111, 0xF>(0.f, v); v += dpp_keep<0x112, 0xF>(0.f, v); v += dpp_keep<0x114, 0xF>(0.f, v); v += dpp_keep<0x118, 0xF>(0.f, v);
    v += dpp_keep<0x142, 0xA>(0.f, v); v += dpp_keep<0x143, 0xC>(0.f, v); return v;
}
__device__ __forceinline__ float scan_max(float v) {
    v = fmaxf(v, dpp_keep<0x111, 0xF>(-INFINITY, v)); v = fmaxf(v, dpp_keep<0x112, 0xF>(-INFINITY, v)); v = fmaxf(v, dpp_keep<0x114, 0xF>(-INFINITY, v)); v = fmaxf(v, dpp_keep<0x118, 0xF>(-INFINITY, v));
    v = fmaxf(v, dpp_keep<0x142, 0xA>(-INFINITY, v)); v = fmaxf(v, dpp_keep<0x143, 0xC>(-INFINITY, v)); return v;
}
__device__ __forceinline__ float lane63(float v) { return __builtin_bit_cast(float, __builtin_amdgcn_readlane(__builtin_bit_cast(int, v), 63)); }
__device__ __forceinline__ void guest_piece(Frame& F, KArgs A, int L, int id, int lane, const float*& src, int& ld, bf16*& dst, int& dk) {
    const int kq = lane & 7, g = lane >> 3; const int e = id / 768, r = id - e * 768;
    if (r < 512) { const int m = r >> 8, rr = r & 255, kb = rr >> 4, nb = rr & 15;
        src = (m ? A->in[I_WUP] : A->in[I_WGATE]) + (size_t)(L * 64 + e) * 524288 + (size_t)(kb * 64 + 8 * kq) * 512 + nb * 32 + 4 * g; ld = 512;
        dst = (bf16*)(F.ws + WS_WGU) + (size_t)e * 1048576 + (size_t)(8 * (nb * 8 + g) + 4 * m) * 1024 + kb * 64 + 8 * kq; dk = 1024; }
    else { const int rr = r - 512, kb = rr >> 5, nb = rr & 31;
        src = A->in[I_WDOWN] + (size_t)(L * 64 + e) * 524288 + (size_t)(kb * 64 + 8 * kq) * 1024 + nb * 32 + 4 * g; ld = 1024;
        dst = (bf16*)(F.ws + WS_WDN) + (size_t)e * 524288 + (size_t)(nb * 32 + 4 * g) * 512 + kb * 64 + 8 * kq; dk = 512; }
}
template <int MODE>
__device__ __forceinline__ void chunk_unit(Frame& F, KArgs A, int L, int b, int h, int vs, const bool guest) {
    constexpr int NH = (MODE == 0) ? 2 : 1;
    LAS unsigned char* QH = F.lds + RING_OFF; LAS unsigned char* KH = QH + 32768; LAS unsigned char* VV = QH + 65536; LAS unsigned char* CS = QH + 98304;
    LAS float* SC = (LAS float*)(F.lds + LDSCTL_OFF + 2048);
    int tid0 = F.tid; asm volatile("" : "+v"(tid0)); const int w = F.wave;
    const size_t rowb = (size_t)b * SEQ;
    const bf16 *Qg, *Kg, *Vg; int vcol;
    if (MODE == 0) { Qg = (const bf16*)(F.ws + WS_YATT) + h * 256; Kg = (const bf16*)(F.ws + WS_YSSD) + h * 256; Vg = (const bf16*)(F.ws + WS_PROJ + 2 * pg8::SLAB) + h * 256 + vs * 64; vcol = h * 256 + vs * 64; }
    else { const int g = h >> 2; Qg = (const bf16*)(F.ws + WS_PROJ + 1 * pg8::SLAB) + 512 + g * 128; Kg = (const bf16*)(F.ws + WS_PROJ + 1 * pg8::SLAB) + g * 128; Vg = (const bf16*)(F.ws + WS_XSSD) + h * 64; vcol = h * 64; }
    bf16* Yg = (bf16*)(F.ws + (MODE == 0 ? WS_YML : WS_XSSD)) + vcol;
    float* SSQ = (float*)(F.ws + (MODE == 0 ? WS_SSQM : WS_SSQS));
    const float* SM = (const float*)(F.ws + WS_SMALL) + rowb * 64;
    v4u qpre[4], kpre[4], vpre[2];
#define MIX_LOADQK(c_, hh_) do { const int r7_ = (tid >> 2) & 7, x_ = (2 * (tid >> 7) + (r7_ >> 2)) & 3; \
        const size_t go = (rowb + (size_t)(c_) * 128 + 8 * (tid >> 7) + r7_) * 1024 + (hh_) * 128 + (4 * ((tid >> 5) & 3) + ((tid & 3) ^ x_)) * 8; \
        _Pragma("unroll") for (int i = 0; i < 4; ++i) { qpre[i] = *(const v4u*)(Qg + go + (size_t)i * 32768); kpre[i] = *(const v4u*)(Kg + go + (size_t)i * 32768); } } while (0)
#define MIX_LOADV(c_) do { const int r7_ = (tid >> 2) & 7, x_ = (2 * (tid >> 6) + (r7_ >> 2)) & 3; \
        const size_t go = (rowb + (size_t)(c_) * 128 + 8 * (tid >> 6) + r7_) * 1024 + (4 * ((tid >> 5) & 1) + ((tid & 3) ^ x_)) * 8; vpre[0] = NT_LOAD((const v4u*)(Vg + go)); vpre[1] = NT_LOAD((const v4u*)(Vg + go + 65536)); } while (0)
#define MIX_STOREQK() do { _Pragma("unroll") for (int i = 0; i < 4; ++i) { *(LAS v4u*)(QH + 16u * tid + 8192u * i) = qpre[i]; *(LAS v4u*)(KH + 16u * tid + 8192u * i) = kpre[i]; } } while (0)
    const int tid = tid0;
    f32x16 Cacc[NH];
#pragma unroll
    for (int hh = 0; hh < NH; ++hh)
#pragma unroll
        for (int r = 0; r < 16; ++r) Cacc[hh][r] = 0.f;
    for (int i = tid; i < 8192; i += 512) ((LAS unsigned*)CS)[i] = 0u;
    if (MODE == 0) { for (int i = tid; i < 512; i += 512) SC[SC_N0 + i] = 0.f; }
    float m_prev = 0.f;
    const float p_ib = (MODE == 0) ? A->in[I_MIB][L * 4 + h] : 0.f, p_fb = (MODE == 0) ? A->in[I_MFB][L * 4 + h] : 0.f;
    const float p_dtb = (MODE == 1) ? A->in[I_SDTB][L * 16 + h] : 0.f, p_A = (MODE == 1) ? -expf(A->in[I_SALOG][L * 16 + h]) : 0.f, p_D = (MODE == 1) ? A->in[I_SD][L * 16 + h] : 0.f;
    float gq0 = 0.f, gq1 = 0.f, gr0 = 0.f, gr1 = 0.f;
#define MIX_LOADG(c_) do { const float* sm_ = SM + (size_t)((c_) * 128 + 2 * (tid & 63)) * 64; if (MODE == 0) { gq0 = sm_[36 + h]; gq1 = sm_[64 + 36 + h]; gr0 = sm_[32 + h]; gr1 = sm_[64 + 32 + h]; } else { gq0 = sm_[16 + h]; gq1 = sm_[64 + 16 + h]; } } while (0)
    if (w == 0) MIX_LOADG(0);
    MIX_LOADQK(0, 0); MIX_LOADV(0);
    __syncthreads();

    for (int c = 0; c < SEQ / 128; ++c) {
        int tid = F.tid; asm volatile("" : "+v"(tid)); int lane = tid & 63;
        const int hl = lane >> 5, l31 = lane & 31; const FragBase fb = frag_base(lane);
        LAS float* nOld = SC + ((c & 1) ? SC_N1 : SC_N0); LAS float* nNew = SC + ((c & 1) ? SC_N0 : SC_N1);
        if (w == 0) {
            float x0, x1, y0, y1;
            if (MODE == 0) { x0 = fast_logsigmoid(gq0 + p_fb); x1 = fast_logsigmoid(gq1 + p_fb); y0 = gr0 + p_ib; y1 = gr1 + p_ib; }
            else { const float d0 = fast_softplus(gq0 + p_dtb), d1 = fast_softplus(gq1 + p_dtb); x0 = d0 * p_A; x1 = d1 * p_A; y0 = __logf(d0); y1 = __logf(d1); }
            if (c + 1 < SEQ / 128) MIX_LOADG(c + 1);
            const float ps = x0 + x1, inc = scan_add(ps);
            const float b0 = inc - ps + x0, b1 = inc;
            const float a0 = y0 - b0, a1 = y1 - b1;
            float M0, M1, Mlast, inter0, inter1, emt0 = 0.f, emt1 = 0.f, wk0, wk1, cs;
            if (MODE == 0) {
                const float im = scan_max(fmaxf(a0, a1));
                const float ex = dpp_keep<0x138, 0xF>(-INFINITY, im);
                const float c0 = fmaxf(ex, a0), c1 = fmaxf(c0, a1);
                M0 = fmaxf(m_prev, c0); M1 = fmaxf(m_prev, c1); Mlast = lane63(M1);
                inter0 = __expf(m_prev - M0); inter1 = __expf(m_prev - M1); emt0 = __expf(-b0 - M0); emt1 = __expf(-b1 - M1);
                wk0 = __expf(a0 - Mlast); wk1 = __expf(a1 - Mlast); cs = __expf(m_prev - Mlast);
                m_prev = lane63(b1) + Mlast;
            } else {
                M0 = -b0; M1 = -b1; const float bl = lane63(b1); inter0 = __expf(b0); inter1 = __expf(b1);
                wk0 = __expf(bl + a0); wk1 = __expf(bl + a1); cs = __expf(bl);
            }
            SC[SC_A + 2 * lane] = a0; SC[SC_A + 2 * lane + 1] = a1; SC[SC_M + 2 * lane] = M0; SC[SC_M + 2 * lane + 1] = M1;
            SC[SC_INTER + 2 * lane] = inter0; SC[SC_INTER + 2 * lane + 1] = inter1; SC[SC_EMT + 2 * lane] = emt0; SC[SC_EMT + 2 * lane + 1] = emt1;
            SC[SC_WK + 2 * lane] = wk0; SC[SC_WK + 2 * lane + 1] = wk1; if (lane == 0) SC[SC_MISC] = cs;
        }
        MIX_STOREQK();
        __syncthreads();
#pragma unroll
        for (int i = 0; i < 2; ++i) { const int rg = (tid >> 6) + 8 * i, row = 8 * rg + ((tid >> 2) & 7); const float wk = SC[SC_WK + row]; const v4u v = vpre[i];
            const unsigned va = 2048u * rg + 512u * ((tid >> 5) & 1) + 64u * ((tid >> 2) & 7) + 16u * (tid & 3);
            *(LAS v4u*)(VV + va) = v; v4u o; o.x = pk2(blo(v.x) * wk, bhi(v.x) * wk); o.y = pk2(blo(v.y) * wk, bhi(v.y) * wk); o.z = pk2(blo(v.z) * wk, bhi(v.z) * wk); o.w = pk2(blo(v.w) * wk, bhi(v.w) * wk);
            *(LAS v4u*)(VV + va + 1024u) = o; }
        if (NH == 2) MIX_LOADQK(c, 1);
        const float cs = SC[SC_MISC];
#pragma unroll
        for (int hh = 0; hh < NH; ++hh)
#pragma unroll
            for (int r = 0; r < 16; ++r) Cacc[hh][r] *= cs;
        __syncthreads();
        const int tau = w >> 1, nu = w & 1;
        f32x16 X0, X1, N2; f32x4 d2 = (f32x4){0.f, 0.f, 0.f, 0.f}; unsigned ppk[2][8];
#pragma unroll
        for (int r = 0; r < 16; ++r) { X0[r] = 0.f; X1[r] = 0.f; N2[r] = 0.f; }
        const bool x0on = (2 * nu) <= tau, x1on = (2 * nu + 1) <= tau;
#pragma unroll
        for (int hh = 0; hh < NH; ++hh) {
            if (hh == 1) { __syncthreads(); MIX_STOREQK(); __syncthreads(); }
#define MIX_SB() __builtin_amdgcn_sched_barrier(0)
            {
                bf16x8 qf = rowfrag(QH, fb, tau, 0), cf = trfrag(CS, fb, 2 * hh + nu, 0), k0 = rowfrag(KH, fb, 2 * nu, 0), k1 = rowfrag(KH, fb, 2 * nu + 1, 0);
#pragma unroll
                for (int ks = 0; ks < 8; ++ks) { const int kn = (ks + 1) & 7;
                    const bf16x8 qn = rowfrag(QH, fb, tau, kn), cn = trfrag(CS, fb, 2 * hh + nu, kn), k0n = rowfrag(KH, fb, 2 * nu, kn), k1n = rowfrag(KH, fb, 2 * nu + 1, kn);
                    N2 = __builtin_amdgcn_mfma_f32_32x32x16_bf16(qf, cf, N2, 0, 0, 0);
                    if (x0on) X0 = __builtin_amdgcn_mfma_f32_32x32x16_bf16(k0, qf, X0, 0, 0, 0);
                    if (x1on) X1 = __builtin_amdgcn_mfma_f32_32x32x16_bf16(k1, qf, X1, 0, 0, 0);
                    MIX_SB(); qf = qn; cf = cn; k0 = k0n; k1 = k1n; }
            }
            MIX_SB();
            if (hh == NH - 1) {
                const int t = 32 * tau + l31; const float Mt = SC[SC_M + t];
#pragma unroll
                for (int xi = 0; xi < 2; ++xi) {
                    const int sig = 2 * nu + xi; const f32x16& X = xi ? X1 : X0; float cs1 = 0.f;
#pragma unroll
                    for (int g = 0; g < 4; ++g) { const int s0 = 32 * sig + 8 * g + 4 * hl; const f32x4 av = *(const LAS f32x4*)(SC + SC_A + s0); float p[4];
#pragma unroll
                        for (int i = 0; i < 4; ++i) { const float e = __expf(av[i] - Mt); p[i] = (s0 + i <= t) ? X[4 * g + i] * e : 0.f; cs1 += p[i]; }
                        ppk[xi][2 * g] = pk2(p[0], p[1]); ppk[xi][2 * g + 1] = pk2(p[2], p[3]); }
                    if (MODE == 0 && sig <= tau) { cs1 += __shfl_xor(cs1, 32); if (hl == 0) SC[SC_DEN1 + sig * 128 + t] = cs1; }
                }
                MIX_SB();
            }
            {
                bf16x8 kf = trfrag(KH, fb, tau, 0), vf = trfrag(VV, fb, 2 + nu, 0);
#pragma unroll
                for (int ks = 0; ks < 8; ++ks) { const int kn = (ks + 1) & 7; const bf16x8 kfn = trfrag(KH, fb, tau, kn), vfn = trfrag(VV, fb, 2 + nu, kn);
                    Cacc[hh] = __builtin_amdgcn_mfma_f32_32x32x16_bf16(kf, vf, Cacc[hh], 0, 0, 0); MIX_SB(); kf = kfn; vf = vfn; }
            }
            MIX_SB();
            if (MODE == 0) {
                f32x4 nacc = (f32x4){0.f, 0.f, 0.f, 0.f}; int lane16 = lane; asm volatile("" : "+v"(lane16)); const FragBase16 fb16 = frag_base16(lane16, w);
#pragma unroll
                for (int ks = 0; ks < 4; ++ks) {
                    bf16x8 nb = (bf16x8){0, 0, 0, 0, 0, 0, 0, 0}, wb = nb;
                    if ((lane & 15) == 0) { const LAS float* np = nOld + hh * 128 + 32 * ks + 8 * (lane >> 4); const LAS float* wp = SC + SC_WK + 32 * ks + 8 * (lane >> 4);
#pragma unroll
                        for (int j = 0; j < 8; ++j) { nb[j] = (short)f2bf(np[j]); wb[j] = (short)f2bf(wp[j]); } }
                    const bf16x8 qa = rowfrag16(QH, fb16, w, ks); d2 = __builtin_amdgcn_mfma_f32_16x16x32_bf16(qa, nb, d2, 0, 0, 0);
                    const bf16x8 ka = trfrag16(KH, fb16, ks); nacc = __builtin_amdgcn_mfma_f32_16x16x32_bf16(ka, wb, nacc, 0, 0, 0); MIX_SB();
                }
                if ((lane & 15) == 0) {
#pragma unroll
                    for (int r = 0; r < 4; ++r) { const int d = hh * 128 + 16 * w + 4 * (lane >> 4) + r; nNew[d] = cs * nOld[d] + nacc[r]; }
                }
            }
        }
        if (MODE == 0) { if ((lane & 15) == 0) {
#pragma unroll
            for (int r = 0; r < 4; ++r) SC[SC_DEN2 + 16 * w + 4 * (lane >> 4) + r] = d2[r]; } }
        __syncthreads();
#if USE_GUEST_CVT
        f32x4 gv[8]; bf16* gdst = nullptr; int gdk = 0;
        const bool gon = guest && (MODE == 0 || (c & 1) == 0);
        if (gon) { const int gid = (MODE == 0) ? (c * 256 + F.bid) * 8 + w : 32768 + ((c >> 1) * 256 + F.bid) * 8 + w; const float* gsrc; int gld; guest_piece(F, A, L, gid, lane, gsrc, gld, gdst, gdk);
#pragma unroll
            for (int j = 0; j < 8; ++j) gv[j] = NT_LOAD((const f32x4*)(gsrc + (size_t)j * gld)); }
        MIX_SB();
#endif
        if (c + 1 < SEQ / 128) { MIX_LOADQK(c + 1, 0); if (MODE == 0) MIX_LOADV(c + 1); }
        v4u og0 = (v4u){0u, 0u, 0u, 0u}, og1 = og0;
        if (MODE == 1 && SSD_ZPRE) { const bf16* zp = (const bf16*)(F.ws + WS_PROJ) + (rowb + (size_t)c * 128 + (tid >> 2)) * 1024 + h * 64 + (tid & 3) * 16; og0 = NT_LOAD((const v4u*)zp); og1 = NT_LOAD((const v4u*)(zp + 8)); }
        if (MODE == 0 && FIX_PURE) { const bf16* op = (const bf16*)(F.ws + WS_PROJ + 3 * pg8::SLAB) + (rowb + (size_t)c * 128 + (tid >> 2)) * 1024 + vcol + (tid & 3) * 16; og0 = NT_LOAD((const v4u*)op); og1 = NT_LOAD((const v4u*)(op + 8)); }
        if (MODE == 0 && tid < 128) {
            float den = SC[SC_INTER + tid] * SC[SC_DEN2 + tid];
#pragma unroll
            for (int sg = 0; sg < 4; ++sg) if (sg <= (tid >> 5)) den += SC[SC_DEN1 + sg * 128 + tid];
            SC[SC_EMT + tid] = 1.0f / fmaxf(fabsf(den), SC[SC_EMT + tid]);
        }
        {
            const unsigned pb = 2048u * (4 * tau + (l31 >> 3)) + 64u * (l31 & 7) + 16u * ((l31 >> 2) & 3) + 8u * hl;
#pragma unroll
            for (int xi = 0; xi < 2; ++xi) {
                const int sig = 2 * nu + xi; if (sig > tau) continue;
#pragma unroll
                for (int g = 0; g < 4; ++g) { v2u o; o.x = ppk[xi][2 * g]; o.y = ppk[xi][2 * g + 1]; *(LAS v2u*)(QH + (pb ^ (16u * g)) + 512u * sig) = o; }
            }
            MIX_SB();
            const unsigned cb = 8192u * tau + 512u * nu + 256u * hl + 2u * (l31 & 7), e0 = 16u * ((l31 >> 3) ^ hl);
#pragma unroll
            for (int hh = 0; hh < NH; ++hh)
#pragma unroll
                for (int r = 0; r < 16; ++r) { const int g = r >> 2, i = r & 3;
                    *(LAS unsigned short*)(CS + cb + 1024u * hh + 2048u * g + 64u * i + (e0 ^ (32u * (g & 1)))) = (unsigned short)f2bf(Cacc[hh][r]); }
            MIX_SB();
        }
        __syncthreads();
        {
            f32x16 N1;
#pragma unroll
            for (int r = 0; r < 16; ++r) N1[r] = 0.f;
            for (int ks = 0; ks < 2 * (tau + 1); ++ks) { const bf16x8 pf = rowfrag(QH, fb, tau, ks); const bf16x8 vf = trfrag(VV, fb, nu, ks); N1 = __builtin_amdgcn_mfma_f32_32x32x16_bf16(pf, vf, N1, 0, 0, 0); MIX_SB(); }
            LAS float* HT = (LAS float*)KH;
            MIX_SB();
#pragma unroll
            for (int g = 0; g < 4; ++g) { const int t0 = 32 * tau + 8 * g + 4 * hl; const f32x4 iv = *(const LAS f32x4*)(SC + SC_INTER + t0); f32x4 rv = (f32x4){1.f, 1.f, 1.f, 1.f}; if (MODE == 0) rv = *(const LAS f32x4*)(SC + SC_EMT + t0);
#pragma unroll
                for (int i = 0; i < 4; ++i) HT[(t0 + i) * 64 + 32 * nu + l31] = (N1[4 * g + i] + iv[i] * N2[4 * g + i]) * rv[i];
                MIX_SB(); }
        }
        __syncthreads();
        if (MODE == 1 && SSD_VEARLY && c + 1 < SEQ / 128) MIX_LOADV(c + 1);
        {
            const int t = tid >> 2, q4 = tid & 3; const LAS float* hp = (const LAS float*)KH + t * 64 + q4 * 16; float y[16];
#pragma unroll
            for (int i = 0; i < 4; ++i) { const f32x4 v = *(const LAS f32x4*)(hp + 4 * i); y[4 * i] = v.x; y[4 * i + 1] = v.y; y[4 * i + 2] = v.z; y[4 * i + 3] = v.w; }
            const size_t grow = rowb + (size_t)c * 128 + t;
            if (MODE == 1) {
                const bf16* zp = (const bf16*)(F.ws + WS_PROJ) + grow * 1024 + h * 64 + q4 * 16; v4u z0, z1; if (SSD_ZPRE) { z0 = og0; z1 = og1; } else { z0 = NT_LOAD((const v4u*)zp); z1 = NT_LOAD((const v4u*)(zp + 8)); }
                const v4u x0 = *(const LAS v4u*)(VV + offb(t, 2 * q4)), x1 = *(const LAS v4u*)(VV + offb(t, 2 * q4 + 1));
                const unsigned zz[8] = {z0.x, z0.y, z0.z, z0.w, z1.x, z1.y, z1.z, z1.w}, xx[8] = {x0.x, x0.y, x0.z, x0.w, x1.x, x1.y, x1.z, x1.w};
#pragma unroll
                for (int i = 0; i < 8; ++i) { const float za = blo(zz[i]), zb = bhi(zz[i]); y[2 * i] = (y[2 * i] + p_D * blo(xx[i])) * (za * __builtin_amdgcn_rcpf(1.0f + __expf(-za))); y[2 * i + 1] = (y[2 * i + 1] + p_D * bhi(xx[i])) * (zb * __builtin_amdgcn_rcpf(1.0f + __expf(-zb))); }
            }
            float q = 0.f;
#pragma unroll
            for (int i = 0; i < 16; ++i) q += y[i] * y[i];
            q += __shfl_xor(q, 1); q += __shfl_xor(q, 2);
            if (q4 == 0) SSQ[grow * 16 + (MODE == 0 ? h * 4 + vs : h)] = q;
            if (MODE == 0 && FIX_PURE) { const unsigned gg[8] = {og0.x, og0.y, og0.z, og0.w, og1.x, og1.y, og1.z, og1.w};
#pragma unroll
                for (int i = 0; i < 8; ++i) { y[2 * i] *= __builtin_amdgcn_rcpf(1.0f + __expf(-blo(gg[i]))); y[2 * i + 1] *= __builtin_amdgcn_rcpf(1.0f + __expf(-bhi(gg[i]))); } }
            v4u o0, o1; o0.x = pk2(y[0], y[1]); o0.y = pk2(y[2], y[3]); o0.z = pk2(y[4], y[5]); o0.w = pk2(y[6], y[7]); o1.x = pk2(y[8], y[9]); o1.y = pk2(y[10], y[11]); o1.z = pk2(y[12], y[13]); o1.w = pk2(y[14], y[15]);
            bf16* yp = Yg + grow * 1024 + q4 * 16; *(v4u*)yp = o0; *(v4u*)(yp + 8) = o1;
        }
        if (MODE == 1 && !SSD_VEARLY && c + 1 < SEQ / 128) MIX_LOADV(c + 1);
#if USE_GUEST_CVT
        MIX_SB();
        if (gon) {
#pragma unroll
            for (int i = 0; i < 4; ++i) { v4u o; o.x = pk2(gv[0][i], gv[1][i]); o.y = pk2(gv[2][i], gv[3][i]); o.z = pk2(gv[4][i], gv[5][i]); o.w = pk2(gv[6][i], gv[7][i]); NT_STORE(o, (v4u*)(gdst + (size_t)i * gdk)); } }
#endif
        __syncthreads();
    }
#undef MIX_LOADQK
#undef MIX_LOADV
#undef MIX_LOADG
#undef MIX_STOREQK
#undef MIX_SB
}
}
__device__ __forceinline__ void p_ml_chunk(Frame& F, KArgs A, int L) { const bool guest = USE_GUEST_CVT && F.G == 256; for (int u = F.bid; u < NB * 16; u += F.G) mixk::chunk_unit<0>(F, A, L, u >> 4, (u >> 2) & 3, u & 3, guest); }
__device__ __forceinline__ void p_ssd_chunk(Frame& F, KArgs A, int L) { const bool guest = USE_GUEST_CVT && F.G == 256; for (int u = F.bid; u < NB * 16; u += F.G) mixk::chunk_unit<1>(F, A, L, u >> 4, u & 15, 0, guest); }


#define MAKE_FRAME(F, A) KArgs A = kargs(); Frame F; \
        { extern __shared__ __attribute__((aligned(16))) unsigned char lds_[]; int t_ = threadIdx.x, b_ = blockIdx.x, g_ = gridDim.x; asm volatile("" : "+v"(t_)); asm volatile("" : "+s"(b_), "+s"(g_)); \
          F.lds = (LAS unsigned char*)lds_; F.MISC = (volatile LAS unsigned*)(F.lds + MISC_OFF); F.tid = t_; F.lane = t_ & 63; F.wave = __builtin_amdgcn_readfirstlane(t_ >> 6); \
          F.G = g_; F.bid = b_; F.ws = A->ws; F.out = A->out; F.ctl = (gu32*)(F.ws + WS_CTL); }
static_assert(FIX_PURE == 1 && USE_EPI_CONV == 1 && !USE_SIMPLE_ML && !USE_SIMPLE_SSD, "the phase order (SSD before attention) needs the mLSTM output gate consumed in the chunk phase and the fused conv epilogue");
template <unsigned MASK>
__global__ void __launch_bounds__(NWAVES * 64, 2) mk_fwd(Args) {
    extern __shared__ __attribute__((aligned(16))) unsigned char lds[];
    { const int t0 = threadIdx.x; for (int u = t0; u < (LDS_BYTES - LDSCTL_OFF) / 4; u += NWAVES * 64) ((LAS unsigned*)((LAS unsigned char*)lds + LDSCTL_OFF))[u] = 0u; }
    __syncthreads();
    XcdBarrier bar = xcd_barrier_post((unsigned*)(kargs()->ws + WS_CTL) + CW_BAR, (volatile LAS unsigned*)((LAS unsigned char*)lds + MISC_OFF) + 8);
    int pid = 0;
#define PH_BEGIN(k) if constexpr ((MASK >> (k)) & 1u) if (kargs()->ph_lo <= pid && pid < kargs()->ph_hi) { \
        for (int rep_ = 0; rep_ < (((((unsigned)(REPEAT_MASK)) >> (k)) & 1u) && L == 0 ? 2 : 1); ++rep_) { MAKE_FRAME(F, A) unsigned char* const ws = F.ws; (void)ws; (void)A;
#define PH_END   } if (pid + 1 < kargs()->ph_hi) { bar.bar = (unsigned*)(kargs()->ws + WS_CTL) + CW_BAR; xcd_barrier(bar); if (PROBE_BAR2) xcd_barrier(bar); } } ++pid;
#define GEMM_IN(EPI, E, pn0, npn) GEMM_IN_GAP(EPI, E, pn0, npn, 1 << 30, 0)
#define GEMM_IN_GAP(EPI, E, pn0, npn, gap_at, gap_len) do { pg8::Gemm g{(const pg8::bf16_t*)(ws + WS_H), (const pg8::bf16_t*)(ws + WS_WIN), NT, NPN_IN * 256, 1024}; \
        pg8::RangeOrder S; S.init(NT, (npn), (pn0), F.G, F.bid, (gap_at), (gap_len)); \
        pg8::gemm_phase<EPI, pg8::RangeOrder, GEMM_ALIGN, GEMM_SP2>(F.lds + RING_OFF, g, S, E); } while (0)

    { constexpr int L = 0;
        PH_BEGIN(0)
            p_convert(F, A, L);
            if (L == 0) p_norm<0, 0>(F, A->in[I_X], F.out, A->in[I_N1W], (bf16*)(ws + WS_H));
            else p_norm<1, 0>(F, nullptr, F.out, A->in[I_N1W] + (size_t)L * D, (bf16*)(ws + WS_H));
        PH_END
        PH_BEGIN(1) { pg8::EpiProjConv E{ws + WS_PROJ, (pg8::bf16_t*)(ws + WS_YATT), (pg8::bf16_t*)(ws + WS_YSSD), A->in[I_MCW] + (size_t)L * 4 * 2048, A->in[I_MCB] + (size_t)L * 2048, (pg8::bf16_t*)(ws + WS_RAWH), 0.0625f,
                                            (pg8::bf16_t*)(ws + WS_XSSD), (pg8::bf16_t*)(ws + WS_PROJ + 1 * pg8::SLAB), A->in[I_SCW] + (size_t)L * 4 * 2048, A->in[I_SCB] + (size_t)L * 2048, (pg8::bf16_t*)(ws + WS_RAWH2)};
                      if (PROBE_EPINULL && rep_ == 1) { pg8::EpiNull EN;
                          if (PROBE_EPINULL == 2) { pg8::Gemm g{(const pg8::bf16_t*)(ws + WS_H), (const pg8::bf16_t*)(ws + WS_WIN), NT, NPN_IN * 256, 1024}; pg8::ConstOrder S{nullptr, nullptr, 14};
                                                    pg8::gemm_phase<pg8::EpiNull, pg8::ConstOrder, GEMM_ALIGN, GEMM_SP2>(F.lds + RING_OFF, g, S, EN); }
                          else GEMM_IN_GAP(pg8::EpiNull, EN, 0, 28, 16, 12); } else { GEMM_IN_GAP(pg8::EpiProjConv, E, 0, 28, 16, 12); } } if (!(PROBE_EPINULL && rep_ == 1)) p_small(F); PH_END
        PH_BEGIN(2) p_convfix(F, (bf16*)(ws + WS_YATT), (bf16*)(ws + WS_YSSD), A->in[I_MCW] + (size_t)L * 4 * 2048, A->in[I_MCB] + (size_t)L * 2048, 0.0625f, WS_RAWH);
                    p_convfix(F, (bf16*)(ws + WS_XSSD), (bf16*)(ws + WS_PROJ + 1 * pg8::SLAB), A->in[I_SCW] + (size_t)L * 4 * 2048, A->in[I_SCB] + (size_t)L * 2048, 1.0f, WS_RAWH2); p_fcum(F, A, L); PH_END
        PH_BEGIN(3) p_ml_chunk(F, A, L); if (PROBE_ML2 && L == 0) p_ml_chunk(F, A, L); p_ssd_chunk(F, A, L); PH_END
#if ATT_GUEST && !USE_SIMPLE_ATT
        PH_BEGIN(4) { pg8::EpiProj E{ws + WS_PROJ}; GEMM_IN(pg8::EpiProj, E, 16, 12); } PH_END
#else
#if PHASE_SPLIT
        PH_BEGIN(4) for (int pass = 0; pass < 2; ++pass) { if ((pass == 0) == ((F.bid & 8) == 0)) { p_fix<1>(F, A, L); p_fix<0>(F, A, L); } else { pg8::EpiProj E{ws + WS_PROJ}; GEMM_IN(pg8::EpiProj, E, 16, 12); } } PH_END
#else
        PH_BEGIN(4) if (PROBE_COPY && L == 0) { for (int pc = 0; pc < PROBE_COPY; ++pc) p_probe_copy(F, pc); } p_fix<1>(F, A, L); p_fix<0>(F, A, L); { pg8::EpiProj E{ws + WS_PROJ}; GEMM_IN(pg8::EpiProj, E, 16, 12); } PH_END
#endif
#endif
        PH_BEGIN(5)
#if USE_SIMPLE_ATT
            p_att_simple(F);
#else
            const attn_body::AttnTensors AT{(const attn_body::bf16*)(ws + WS_PROJ), (const attn_body::bf16*)(ws + WS_PROJ + pg8::SLAB), (const attn_body::bf16*)(ws + WS_PROJ + 2 * pg8::SLAB), (attn_body::bf16*)(ws + WS_YATT), (const float*)(ws + WS_FB)};
            const attn_body::StaticOrder S((int)F.G, (int)F.bid);
            const int g_n = (NT + (int)F.G * NWAVES - 1) / ((int)F.G * NWAVES);
            attn_body::Guest GU{(attn_body::bf16*)(ws + WS_YML), (attn_body::bf16*)(ws + WS_XSSD), (const float*)(ws + WS_SSQM), (const float*)(ws + WS_SSQS), ((int)F.bid * NWAVES + (int)F.wave) * g_n, ATT_GUEST ? 0 : g_n, g_n};
            attn_body::attn_phase<attn_body::StaticOrder, ATT_THRL>((char*)F.lds + RING_OFF, AT, S, GU);
#if ATT_GUEST
            for (; GU.k < GU.n; ++GU.k) { const int row = GU.row0 + GU.k; if (row < NT) { p_fix_row<1>(F, A, L, row); p_fix_row<0>(F, A, L, row); } }
#endif
#endif
        PH_END
#if GATE_FUSE
        PH_BEGIN(9)
            pg8::RangeOrder S0; S0.init(NT, 4, 0, F.G, F.bid); pg8::Unit u0; const bool any0 = S0.next(0, u0);
            const size_t TSTEP = (size_t)256 * 1024 * 2;
            const char* const hA0 = (const char*)(ws + WS_H) + (size_t)u0.pm * TSTEP;
            const pg8::EpiGate EG{ws + WS_PROJ, A->in[I_GB] + (size_t)L * 3072};
#define P9_GATE(b, CIN) do { pg8::Gemm g{(const pg8::bf16_t*)(ws + WS_H), (const pg8::bf16_t*)(ws + WS_WIN), NT, NPN_IN * 256, 1024}; pg8::RangeOrder S; S.init(NT, 4, 40 + 4 * (b), F.G, F.bid); \
                const size_t yoff_ = ((b) == 0) ? WS_YATT : ((b) == 1) ? WS_XSSD : WS_YML; \
                pg8::gemm_phase<pg8::EpiGate, pg8::RangeOrder, true, true, (CIN) && GEMM_CHAIN, GEMM_CHAIN>(F.lds + RING_OFF, g, S, EG, (const char*)(ws + yoff_) + (size_t)u0.pm * TSTEP, (const char*)(ws + WS_WBR) + (size_t)(b) * 2097152 + (size_t)u0.pn * TSTEP); \
                if (!GEMM_CHAIN) { asm volatile("s_waitcnt vmcnt(0)" ::: "memory"); __syncthreads(); } } while (0)
#define P9_MIX(b, COUT) do { const size_t yoff_ = ((b) == 0) ? WS_YATT : ((b) == 1) ? WS_XSSD : WS_YML; \
                pg8::Gemm g{(const pg8::bf16_t*)(ws + yoff_), (const pg8::bf16_t*)(ws + WS_WBR) + (size_t)(b) * 1048576, NT, 1024, 1024}; pg8::RangeOrder S; S.init(NT, 4, 0, F.G, F.bid); \
                pg8::EpiBranch E{(pg8::bf16_t*)(ws + WS_PROJ + 3 * pg8::SLAB), (const pg8::bf16_t*)(ws + WS_PROJ + (size_t)(b) * pg8::SLAB), (b) == 0 ? 1 : 0}; \
                pg8::gemm_phase<pg8::EpiBranch, pg8::RangeOrder, true, true, GEMM_CHAIN, (COUT) && GEMM_CHAIN>(F.lds + RING_OFF, g, S, E, hA0, (const char*)(ws + WS_WIN) + (size_t)(u0.pn + 40 + 4 * ((b) + 1)) * TSTEP); \
                if (!(GEMM_CHAIN && (COUT))) { asm volatile("s_waitcnt vmcnt(0)" ::: "memory"); __syncthreads(); } } while (0)
            if (any0) { P9_GATE(0, false); P9_MIX(0, true); P9_GATE(1, true); P9_MIX(1, true); P9_GATE(2, true); P9_MIX(2, false); }
#undef P9_GATE
#undef P9_MIX
        PH_END
#else
        PH_BEGIN(9) { pg8::EpiGate E{ws + WS_PROJ, A->in[I_GB] + (size_t)L * 3072}; GEMM_IN(pg8::EpiGate, E, 40, 12); } PH_END
        PH_BEGIN(10)
            for (int b = 0; b < 3; ++b) {
                const size_t yoff = (b == 0) ? WS_YATT : (b == 1) ? WS_XSSD : WS_YML;
                pg8::Gemm g{(const pg8::bf16_t*)(ws + yoff), (const pg8::bf16_t*)(ws + WS_WBR) + (size_t)b * 1048576, NT, 1024, 1024};
                pg8::RangeOrder S; S.init(NT, 4, 0, F.G, F.bid);
                pg8::EpiBranch E{(pg8::bf16_t*)(ws + WS_H), (const pg8::bf16_t*)(ws + WS_PROJ + (size_t)b * pg8::SLAB), b == 0 ? 1 : 0};
                pg8::gemm_phase<pg8::EpiBranch, pg8::RangeOrder, true, true>(F.lds + RING_OFF, g, S, E);
                asm volatile("s_waitcnt vmcnt(0)" ::: "memory"); __syncthreads();
            }
        PH_END
#endif
        PH_BEGIN(11)
            pg8::Gemm g{(const pg8::bf16_t*)(ws + (GATE_FUSE ? WS_PROJ + 3 * pg8::SLAB : WS_H)), (const pg8::bf16_t*)(ws + WS_WOUT), NT, 1024, 1024};
            pg8::RangeOrder S; S.init(NT, 4, 0, F.G, F.bid);
            pg8::EpiResid E{L == 0 ? A->in[I_X] : (const float*)F.out, F.out, (float*)(ws + WS_SSQS)};
            pg8::gemm_phase<pg8::EpiResid, pg8::RangeOrder, true, true>(F.lds + RING_OFF, g, S, E);
        PH_END
        PH_BEGIN(12) p_router(F, A, L); PH_END
        PH_BEGIN(13) p_gather(F, L); PH_END
        PH_BEGIN(14)
            if (!MOE_TABLE_ONCE) moe_table(F, L);
            pg8::Gemm g{(const pg8::bf16_t*)(ws + WS_H), (const pg8::bf16_t*)(ws + WS_WGU), NT, 65536, 1024};
            pg8::MoeOrderG S{(const PG8_LAS int*)(F.lds + TAB_OFF), F.G, F.bid, (const int*)(ws + WS_ROWTOK), (const PG8_LAS int*)(F.lds + LDSCTL_OFF + 2048)};
            pg8::EpiGU E{(pg8::bf16_t*)(ws + WS_ACT)};
            pg8::gemm_phase<pg8::EpiGU, pg8::MoeOrderG, true, true>(F.lds + RING_OFF, g, S, E);
        PH_END
        PH_BEGIN(15)
            if (!MOE_TABLE_ONCE) moe_table(F, L);
            pg8::Gemm g{(const pg8::bf16_t*)(ws + WS_ACT), (const pg8::bf16_t*)(ws + WS_WDN), PROWS, 65536, 512};
            pg8::MoeOrder S{(const PG8_LAS int*)(F.lds + TAB_OFF), F.G, F.bid, nullptr, nullptr};
            pg8::EpiRows E{(pg8::bf16_t*)(ws + WS_HG)};
            pg8::gemm_phase<pg8::EpiRows, pg8::MoeOrder, true, true>(F.lds + RING_OFF, g, S, E);
        PH_END
    }
    { constexpr int L = 1;
        PH_BEGIN(0)
            p_convert(F, A, L);
            if (L == 0) p_norm<0, 0>(F, A->in[I_X], F.out, A->in[I_N1W], (bf16*)(ws + WS_H));
            else p_norm<1, 0>(F, nullptr, F.out, A->in[I_N1W] + (size_t)L * D, (bf16*)(ws + WS_H));
        PH_END
        PH_BEGIN(1) { pg8::EpiProjConv E{ws + WS_PROJ, (pg8::bf16_t*)(ws + WS_YATT), (pg8::bf16_t*)(ws + WS_YSSD), A->in[I_MCW] + (size_t)L * 4 * 2048, A->in[I_MCB] + (size_t)L * 2048, (pg8::bf16_t*)(ws + WS_RAWH), 0.0625f,
                                            (pg8::bf16_t*)(ws + WS_XSSD), (pg8::bf16_t*)(ws + WS_PROJ + 1 * pg8::SLAB), A->in[I_SCW] + (size_t)L * 4 * 2048, A->in[I_SCB] + (size_t)L * 2048, (pg8::bf16_t*)(ws + WS_RAWH2)};
                      if (PROBE_EPINULL && rep_ == 1) { pg8::EpiNull EN;
                          if (PROBE_EPINULL == 2) { pg8::Gemm g{(const pg8::bf16_t*)(ws + WS_H), (const pg8::bf16_t*)(ws + WS_WIN), NT, NPN_IN * 256, 1024}; pg8::ConstOrder S{nullptr, nullptr, 14};
                                                    pg8::gemm_phase<pg8::EpiNull, pg8::ConstOrder, GEMM_ALIGN, GEMM_SP2>(F.lds + RING_OFF, g, S, EN); }
                          else GEMM_IN_GAP(pg8::EpiNull, EN, 0, 28, 16, 12); } else { GEMM_IN_GAP(pg8::EpiProjConv, E, 0, 28, 16, 12); } } if (!(PROBE_EPINULL && rep_ == 1)) p_small(F); PH_END
        PH_BEGIN(2) p_convfix(F, (bf16*)(ws + WS_YATT), (bf16*)(ws + WS_YSSD), A->in[I_MCW] + (size_t)L * 4 * 2048, A->in[I_MCB] + (size_t)L * 2048, 0.0625f, WS_RAWH);
                    p_convfix(F, (bf16*)(ws + WS_XSSD), (bf16*)(ws + WS_PROJ + 1 * pg8::SLAB), A->in[I_SCW] + (size_t)L * 4 * 2048, A->in[I_SCB] + (size_t)L * 2048, 1.0f, WS_RAWH2); p_fcum(F, A, L); PH_END
        PH_BEGIN(3) p_ml_chunk(F, A, L); if (PROBE_ML2 && L == 0) p_ml_chunk(F, A, L); p_ssd_chunk(F, A, L); PH_END
#if ATT_GUEST && !USE_SIMPLE_ATT
        PH_BEGIN(4) { pg8::EpiProj E{ws + WS_PROJ}; GEMM_IN(pg8::EpiProj, E, 16, 12); } PH_END
#else
#if PHASE_SPLIT
        PH_BEGIN(4) for (int pass = 0; pass < 2; ++pass) { if ((pass == 0) == ((F.bid & 8) == 0)) { p_fix<1>(F, A, L); p_fix<0>(F, A, L); } else { pg8::EpiProj E{ws + WS_PROJ}; GEMM_IN(pg8::EpiProj, E, 16, 12); } } PH_END
#else
        PH_BEGIN(4) if (PROBE_COPY && L == 0) { for (int pc = 0; pc < PROBE_COPY; ++pc) p_probe_copy(F, pc); } p_fix<1>(F, A, L); p_fix<0>(F, A, L); { pg8::EpiProj E{ws + WS_PROJ}; GEMM_IN(pg8::EpiProj, E, 16, 12); } PH_END
#endif
#endif
        PH_BEGIN(5)
#if USE_SIMPLE_ATT
            p_att_simple(F);
#else
            const attn_body::AttnTensors AT{(const attn_body::bf16*)(ws + WS_PROJ), (const attn_body::bf16*)(ws + WS_PROJ + pg8::SLAB), (const attn_body::bf16*)(ws + WS_PROJ + 2 * pg8::SLAB), (attn_body::bf16*)(ws + WS_YATT), (const float*)(ws + WS_FB)};
            const attn_body::StaticOrder S((int)F.G, (int)F.bid);
            const int g_n = (NT + (int)F.G * NWAVES - 1) / ((int)F.G * NWAVES);
            attn_body::Guest GU{(attn_body::bf16*)(ws + WS_YML), (attn_body::bf16*)(ws + WS_XSSD), (const float*)(ws + WS_SSQM), (const float*)(ws + WS_SSQS), ((int)F.bid * NWAVES + (int)F.wave) * g_n, ATT_GUEST ? 0 : g_n, g_n};
            attn_body::attn_phase<attn_body::StaticOrder, ATT_THRL>((char*)F.lds + RING_OFF, AT, S, GU);
#if ATT_GUEST
            for (; GU.k < GU.n; ++GU.k) { const int row = GU.row0 + GU.k; if (row < NT) { p_fix_row<1>(F, A, L, row); p_fix_row<0>(F, A, L, row); } }
#endif
#endif
        PH_END
#if GATE_FUSE
        PH_BEGIN(9)
            pg8::RangeOrder S0; S0.init(NT, 4, 0, F.G, F.bid); pg8::Unit u0; const bool any0 = S0.next(0, u0);
            const size_t TSTEP = (size_t)256 * 1024 * 2;
            const char* const hA0 = (const char*)(ws + WS_H) + (size_t)u0.pm * TSTEP;
            const pg8::EpiGate EG{ws + WS_PROJ, A->in[I_GB] + (size_t)L * 3072};
#define P9_GATE(b, CIN) do { pg8::Gemm g{(const pg8::bf16_t*)(ws + WS_H), (const pg8::bf16_t*)(ws + WS_WIN), NT, NPN_IN * 256, 1024}; pg8::RangeOrder S; S.init(NT, 4, 40 + 4 * (b), F.G, F.bid); \
                const size_t yoff_ = ((b) == 0) ? WS_YATT : ((b) == 1) ? WS_XSSD : WS_YML; \
                pg8::gemm_phase<pg8::EpiGate, pg8::RangeOrder, true, true, (CIN) && GEMM_CHAIN, GEMM_CHAIN>(F.lds + RING_OFF, g, S, EG, (const char*)(ws + yoff_) + (size_t)u0.pm * TSTEP, (const char*)(ws + WS_WBR) + (size_t)(b) * 2097152 + (size_t)u0.pn * TSTEP); \
                if (!GEMM_CHAIN) { asm volatile("s_waitcnt vmcnt(0)" ::: "memory"); __syncthreads(); } } while (0)
#define P9_MIX(b, COUT) do { const size_t yoff_ = ((b) == 0) ? WS_YATT : ((b) == 1) ? WS_XSSD : WS_YML; \
                pg8::Gemm g{(const pg8::bf16_t*)(ws + yoff_), (const pg8::bf16_t*)(ws + WS_WBR) + (size_t)(b) * 1048576, NT, 1024, 1024}; pg8::RangeOrder S; S.init(NT, 4, 0, F.G, F.bid); \
                pg8::EpiBranch E{(pg8::bf16_t*)(ws + WS_PROJ + 3 * pg8::SLAB), (const pg8::bf16_t*)(ws + WS_PROJ + (size_t)(b) * pg8::SLAB), (b) == 0 ? 1 : 0}; \
                pg8::gemm_phase<pg8::EpiBranch, pg8::RangeOrder, true, true, GEMM_CHAIN, (COUT) && GEMM_CHAIN>(F.lds + RING_OFF, g, S, E, hA0, (const char*)(ws + WS_WIN) + (size_t)(u0.pn + 40 + 4 * ((b) + 1)) * TSTEP); \
                if (!(GEMM_CHAIN && (COUT))) { asm volatile("s_waitcnt vmcnt(0)" ::: "memory"); __syncthreads(); } } while (0)
            if (any0) { P9_GATE(0, false); P9_MIX(0, true); P9_GATE(1, true); P9_MIX(1, true); P9_GATE(2, true); P9_MIX(2, false); }
#undef P9_GATE
#undef P9_MIX
        PH_END
#else
        PH_BEGIN(9) { pg8::EpiGate E{ws + WS_PROJ, A->in[I_GB] + (size_t)L * 3072}; GEMM_IN(pg8::EpiGate, E, 40, 12); } PH_END
        PH_BEGIN(10)
            for (int b = 0; b < 3; ++b) {
                const size_t yoff = (b == 0) ? WS_YATT : (b == 1) ? WS_XSSD : WS_YML;
                pg8::Gemm g{(const pg8::bf16_t*)(ws + yoff), (const pg8::bf16_t*)(ws + WS_WBR) + (size_t)b * 1048576, NT, 1024, 1024};
                pg8::RangeOrder S; S.init(NT, 4, 0, F.G, F.bid);
                pg8::EpiBranch E{(pg8::bf16_t*)(ws + WS_H), (const pg8::bf16_t*)(ws + WS_PROJ + (size_t)b * pg8::SLAB), b == 0 ? 1 : 0};
                pg8::gemm_phase<pg8::EpiBranch, pg8::RangeOrder, true, true>(F.lds + RING_OFF, g, S, E);
                asm volatile("s_waitcnt vmcnt(0)" ::: "memory"); __syncthreads();
            }
        PH_END
#endif
        PH_BEGIN(11)
            pg8::Gemm g{(const pg8::bf16_t*)(ws + (GATE_FUSE ? WS_PROJ + 3 * pg8::SLAB : WS_H)), (const pg8::bf16_t*)(ws + WS_WOUT), NT, 1024, 1024};
            pg8::RangeOrder S; S.init(NT, 4, 0, F.G, F.bid);
            pg8::EpiResid E{L == 0 ? A->in[I_X] : (const float*)F.out, F.out, (float*)(ws + WS_SSQS)};
            pg8::gemm_phase<pg8::EpiResid, pg8::RangeOrder, true, true>(F.lds + RING_OFF, g, S, E);
        PH_END
        PH_BEGIN(12) p_router(F, A, L); PH_END
        PH_BEGIN(13) p_gather(F, L); PH_END
        PH_BEGIN(14)
            if (!MOE_TABLE_ONCE) moe_table(F, L);
            pg8::Gemm g{(const pg8::bf16_t*)(ws + WS_H), (const pg8::bf16_t*)(ws + WS_WGU), NT, 65536, 1024};
            pg8::MoeOrderG S{(const PG8_LAS int*)(F.lds + TAB_OFF), F.G, F.bid, (const int*)(ws + WS_ROWTOK), (const PG8_LAS int*)(F.lds + LDSCTL_OFF + 2048)};
            pg8::EpiGU E{(pg8::bf16_t*)(ws + WS_ACT)};
            pg8::gemm_phase<pg8::EpiGU, pg8::MoeOrderG, true, true>(F.lds + RING_OFF, g, S, E);
        PH_END
        PH_BEGIN(15)
            if (!MOE_TABLE_ONCE) moe_table(F, L);
            pg8::Gemm g{(const pg8::bf16_t*)(ws + WS_ACT), (const pg8::bf16_t*)(ws + WS_WDN), PROWS, 65536, 512};
            pg8::MoeOrder S{(const PG8_LAS int*)(F.lds + TAB_OFF), F.G, F.bid, nullptr, nullptr};
            pg8::EpiRows E{(pg8::bf16_t*)(ws + WS_HG)};
            pg8::gemm_phase<pg8::EpiRows, pg8::MoeOrder, true, true>(F.lds + RING_OFF, g, S, E);
        PH_END
    }
    constexpr int L = -1;
    PH_BEGIN(16) p_norm<1, 1>(F, nullptr, F.out, A->in[I_FNW], nullptr); PH_END
#ifdef DBG_STOP
    if constexpr ((MASK >> 17) & 1u) {
        KArgs A = kargs(); unsigned char* ws = A->ws; float* out = A->out; const size_t offs[4] = {DBG_D0, DBG_D1, DBG_D2, DBG_D3};
        for (size_t i = (size_t)blockIdx.x * 512 + threadIdx.x; i < (size_t)NT * D; i += (size_t)gridDim.x * 512) { float v = 0.f;
            for (int k = 0; k < 4; ++k) if (offs[k]) v += bf2f(((const bf16*)(ws + offs[k]))[i]);
            out[i] = v; }
    }
#endif
#undef PH_BEGIN
#undef PH_END
#undef GEMM_IN
}
constexpr int PIDS_PER_LAYER = 13 - (GATE_FUSE ? 1 : 0);

typedef void (*kern_t)(Args);
extern "C" void kernel_launch(void* const* d_in, const int* in_sizes, int n_in, void* d_out, int out_size, void* d_ws, size_t ws_size, hipStream_t stream) {
    static int grid = 0;
#if defined(ONLY_KIND)
    static const kern_t kerns[1] = { mk_fwd<1u << ONLY_KIND> };
    constexpr int NK = 1;
#elif MK_N_LAUNCHES == 1
    static const kern_t kerns[1] = { mk_fwd<0xffffffffu> };
    constexpr int NK = 1;
#else
    static const kern_t kerns[18] = { mk_fwd<1u << 0>, mk_fwd<1u << 1>, mk_fwd<1u << 2>, mk_fwd<1u << 3>, mk_fwd<1u << 4>, mk_fwd<1u << 5>, mk_fwd<1u << 6>, mk_fwd<1u << 7>, mk_fwd<1u << 8>, mk_fwd<1u << 9>,
                                      mk_fwd<1u << 10>, mk_fwd<1u << 11>, mk_fwd<1u << 12>, mk_fwd<1u << 13>, mk_fwd<1u << 14>, mk_fwd<1u << 15>, mk_fwd<1u << 16>, mk_fwd<1u << 17> };
    constexpr int NK = 18;
#endif
    if (grid == 0) {
        if (n_in != 27 || in_sizes[0] != NT * D || out_size != NT * D || ws_size < WS_END) { fprintf(stderr, "kernel_launch: unexpected shapes (n_in %d, in0 %d, out %d, ws %zu < %zu); nothing launched\n", n_in, n_in > 0 ? in_sizes[0] : -1, out_size, ws_size, (size_t)WS_END); grid = -1; return; }
        int dev = 0, cus = 0, per_cu = 0;
        if (hipGetDevice(&dev) != hipSuccess || hipDeviceGetAttribute(&cus, hipDeviceAttributeMultiprocessorCount, dev) != hipSuccess) { grid = -1; return; }
        for (int k = 0; k < NK; ++k)
            if (hipFuncSetAttribute((const void*)kerns[k], hipFuncAttributeMaxDynamicSharedMemorySize, LDS_BYTES) != hipSuccess) { fprintf(stderr, "kernel_launch: hipFuncSetAttribute failed\n"); grid = -1; return; }
        if (hipOccupancyMaxActiveBlocksPerMultiprocessor(&per_cu, (const void*)kerns[0], NWAVES * 64, LDS_BYTES) != hipSuccess || per_cu < 1) { fprintf(stderr, "kernel_launch: occupancy query says %d\n", per_cu); }
        (void)hipGetLastError();
        grid = cus;
    }
    if (grid < 0) return;
    if (hipMemsetAsync((char*)d_ws + WS_CTL, 0, CTL_ZERO_BYTES, stream) != hipSuccess) return;
    Args a{};
    for (int i = 0; i < 27; ++i) a.in[i] = (const float*)d_in[i];
    a.out = (float*)d_out; a.ws = (unsigned char*)d_ws;
    constexpr int NPH = DEPTH * PIDS_PER_LAYER + 1;
#if MK_N_LAUNCHES == 1
    a.ph_lo = 0; a.ph_hi = NPH;
    hipLaunchKernelGGL(kerns[0], dim3(grid), dim3(NWAVES * 64), LDS_BYTES, stream, a);
#else
    int kind_of[PIDS_PER_LAYER]; { int n = 0; for (int k = 0; k < 16; ++k) { if (k >= 6 && k <= 8) continue; kind_of[n++] = k; } }
#ifdef DBG_STOP
    constexpr int NPH_RUN = DBG_STOP;
#else
    constexpr int NPH_RUN = NPH;
#endif
    for (int p = 0; p < NPH_RUN; ++p) { a.ph_lo = p; a.ph_hi = p + 1; const int k = (p == NPH - 1) ? 16 : kind_of[p % PIDS_PER_LAYER];
        hipLaunchKernelGGL(kerns[k], dim3(grid), dim3(NWAVES * 64), LDS_BYTES, stream, a); }
#ifdef DBG_STOP
    if (DBG_D0) { a.ph_lo = 1000; a.ph_hi = 1000; hipLaunchKernelGGL(kerns[17], dim3(grid), dim3(NWAVES * 64), LDS_BYTES, stream, a); }
#endif
#endif
    const hipError_t le = hipPeekAtLastError();
    if (le != hipSuccess) fprintf(stderr, "kernel_launch: launch failed: %s\n", hipGetErrorName(le));
}
```

```cpp
#define MK_N_LAUNCHES 1
#define GEMM_CHAIN 1
#include <hip/hip_runtime.h>
#include <cstdio>
#include <cstdint>
#ifndef MK_N_LAUNCHES
#define MK_N_LAUNCHES 1
#endif
#ifndef PHMASK
#define PHMASK 0xffffffffffffffffull
#endif
#ifndef USE_SIMPLE_ML
#define USE_SIMPLE_ML 0
#endif
#ifndef USE_SIMPLE_SSD
#define USE_SIMPLE_SSD 0
#endif
#ifndef USE_SIMPLE_ATT
#define USE_SIMPLE_ATT 0
#endif
#ifndef REPEAT_MASK
#define REPEAT_MASK 0
#endif
#ifndef ATT_THRL
#define ATT_THRL 24
#endif
#ifndef GEMM_ALIGN
#define GEMM_ALIGN true
#endif
#ifndef GEMM_SP2
#define GEMM_SP2 true
#endif
#ifndef PROBE_BAR2
#define PROBE_BAR2 0
#endif
#ifndef PROBE_CHUNK_BAR
#define PROBE_CHUNK_BAR 0
#endif
#ifndef PROBE_DUP_X
#define PROBE_DUP_X 0
#endif
#ifndef PROBE_SEC
#define PROBE_SEC 0
#endif
#ifndef PG8_WGM
#define PG8_WGM 8
#endif
#ifndef USE_EPI_CONV
#define USE_EPI_CONV 1
#endif
#ifndef USE_GUEST_CVT
#define USE_GUEST_CVT 1
#endif
#ifndef ATT_GUEST
#define ATT_GUEST 0
#endif
#ifndef FIX_PURE
#define FIX_PURE 1
#endif
#ifndef MOE_ROWSKIP
#define MOE_ROWSKIP 2
#endif
#ifndef PROBE_ML2
#define PROBE_ML2 0
#endif
#ifndef PROBE_COPY
#define PROBE_COPY 0
#endif
#ifndef USE_NT
#define USE_NT 1
#endif
#if USE_NT
#define NT_LOAD(p) __builtin_nontemporal_load(p)
#define NT_STORE(v, p) __builtin_nontemporal_store((v), (p))
#else
#define NT_LOAD(p) (*(p))
#define NT_STORE(v, p) (*(p) = (v))
#endif
#ifndef NT_EPI
#define NT_EPI 0
#endif
#if NT_EPI
#define EPI_STORE(v, p) __builtin_nontemporal_store((v), (p))
#else
#define EPI_STORE(v, p) (*(p) = (v))
#endif
#ifndef MOE_B_NT
#define MOE_B_NT 0
#endif
#ifndef ROUTER_NT
#define ROUTER_NT 0
#endif
#ifndef SSD_ZPRE
#define SSD_ZPRE 1
#endif
#ifndef SSD_VEARLY
#define SSD_VEARLY 0
#endif
#ifndef RESID_SSQ
#define RESID_SSQ 1
#endif
#ifndef GATE_FUSE
#define GATE_FUSE 1
#endif
#ifndef MOE_XCD
#define MOE_XCD 1
#endif
#ifndef ATT_PK
#define ATT_PK 1
#endif
#ifndef ATT_KBPRE
#define ATT_KBPRE 0
#endif
#ifndef PROBE_EPINULL
#define PROBE_EPINULL 0
#endif
#ifndef ATT_PRE
#define ATT_PRE 1
#endif
#ifndef GEMM_CHAIN
#define GEMM_CHAIN 0
#endif
#ifndef PHASE_SPLIT
#define PHASE_SPLIT 0
#endif
#ifndef ROUTER_2LVL
#define ROUTER_2LVL 1
#endif
#ifndef ROUTER_NOATOM
#define ROUTER_NOATOM 0
#endif
#ifndef MOE_TABLE_ONCE
#define MOE_TABLE_ONCE 0
#endif
namespace pg8 {
#define PG8_LAS __attribute__((address_space(3)))
typedef unsigned short bf16_t;
typedef short bf16x8 __attribute__((ext_vector_type(8)));
typedef float f32x4 __attribute__((ext_vector_type(4)));
typedef unsigned u32x4 __attribute__((ext_vector_type(4)));
typedef unsigned u32x2 __attribute__((ext_vector_type(2)));
constexpr int BM = 256, BK = 64, HALF = 128, HTB = HALF * BK * 2  , STAGE_BYTES = 8 * HTB, NXCD = 8, WGM = PG8_WGM;

__host__ __device__ __forceinline__ int lds_byte(int r, int c) { const int st = (r >> 4) * 2 + (c >> 5), rr = r & 15, cc = c & 31, ob = rr * 64 + cc * 2; return st * 1024 + (ob ^ (((ob >> 9) & 1) << 5)); }
__host__ __device__ __forceinline__ void stage_rc(int b, int& R, int& C) { const int st = b / 1024, sb = b % 1024, swz = sb ^ (((sb >> 9) & 1) << 5); R = (st >> 1) * 16 + swz / 64; C = (st & 1) * 32 + (swz % 64) / 2; }
__host__ __device__ __forceinline__ int perm32(int rho) { const int n = rho >> 4, i = rho & 15; return 8 * (i >> 2) + 4 * n + (i & 3); }

constexpr int MOE_ORDER_OFF = 768;
struct Unit { int pm, pn; int rows; };
struct Gemm { const bf16_t* A; const bf16_t* Bt; int M, N, K; };

struct StaticOrder {
    static constexpr bool ROWSKIP = false, B_NT = false;
    int nM, nN, nwg, G, c;
    __host__ __device__ void init(int M, int N, int G_, int c_) { nM = M / BM; nN = N / BM; nwg = nM * nN; G = G_; c = c_; }
    __host__ __device__ bool next(int i, Unit& u) const {
        const long L = (long)i * G + c; if (L >= nwg) return false;
        int wgid = (int)L; { const int q = nwg / NXCD, r = nwg % NXCD, xcd = wgid % NXCD, off = wgid / NXCD; wgid = (xcd < r ? xcd * (q + 1) : r * (q + 1) + (xcd - r) * q) + off; }
        const int nig = WGM * nN, gid = wgid / nig, fm = gid * WGM, gsz = (nM - fm) < WGM ? (nM - fm) : WGM;
        u.pm = fm + ((wgid % nig) % gsz); u.pn = (wgid % nig) / gsz; return true;
    }
    __device__ __forceinline__ void a_ready(const Unit&) const {}
    __device__ __forceinline__ void done(const Unit&) const {}
};

typedef float cvt_f32x2 __attribute__((ext_vector_type(2))); typedef __bf16 cvt_bf16x2 __attribute__((ext_vector_type(2)));
__device__ __forceinline__ unsigned cvt_pk_bf16(float lo, float hi) { const cvt_f32x2 v = {lo, hi}; const cvt_bf16x2 b = __builtin_convertvector(v, cvt_bf16x2); return __builtin_bit_cast(unsigned, b); }
typedef float f32x2 __attribute__((ext_vector_type(2)));
__device__ __forceinline__ f32x2 gelu_pk(f32x2 v) {
    const f32x2 av = __builtin_elementwise_abs(v), d = av * 0.2316418882f + 1.0f;
    f32x2 t; t.x = __builtin_amdgcn_rcpf(d.x); t.y = __builtin_amdgcn_rcpf(d.y);
    f32x2 q = t * 0.5307027145f + (-0.7265760135f); q = q * t + 0.7107068705f; q = q * t + (-0.142248368f); q = q * t + 0.127414796f; q = q * t;
    const f32x2 s = (v * v) * (-0.72134752044f);
    f32x2 e; e.x = __builtin_amdgcn_exp2f(s.x); e.y = __builtin_amdgcn_exp2f(s.y);
    const f32x2 m = v * (q * e), r = v - m;
    f32x2 o; o.x = v.x < 0.f ? m.x : r.x; o.y = v.y < 0.f ? m.y : r.y; return o;
}

__device__ __forceinline__ float fast_sigmoid(float x) { return __builtin_amdgcn_rcpf(1.0f + __expf(-x)); }
__device__ __forceinline__ float bf_lo(unsigned w) { return __builtin_bit_cast(float, w << 16); }
__device__ __forceinline__ float bf_hi(unsigned w) { return __builtin_bit_cast(float, w & 0xffff0000u); }
constexpr size_t SLAB = (size_t)64 << 20;

struct EpiProj {
    static constexpr bool PERM = true, AFTER_DRAIN = false;
    unsigned char* proj;
    __device__ __forceinline__ void operator()(const f32x4 (&acc)[2][2][4][2], const Unit& u, int wr, int wc, int fr, int fq) const {
        const int pn = u.pn; const int row0 = u.pm * BM + wr * 64 + fr;
        int ldc = 1024, colt; size_t boff;
        if (pn < 16) { boff = (size_t)(pn >> 2) * SLAB; colt = (pn & 3) * 256; }
        else if (pn < 28) { const int q = pn - 16; boff = (size_t)(q >> 2) * SLAB; colt = (q & 3) * 256; }
        else if (pn < 32) { boff = 0; colt = (pn - 28) * 256; }
        else { boff = SLAB; ldc = 2048; colt = (pn - 32) * 256; }
        bf16_t* base = (bf16_t*)(proj + boff) + colt + wc * 32 + 8 * fq;
        const float sc = (!USE_SIMPLE_ATT && pn >= 16 && pn < 20) ? 0.125f * 1.4426950408889634f : 1.0f;
#pragma unroll
        for (int ai = 0; ai < 2; ++ai)
#pragma unroll
            for (int m = 0; m < 4; ++m) { bf16_t* rowp = base + (size_t)(row0 + ai * HALF + m * 16) * ldc;
#pragma unroll
                for (int bj = 0; bj < 2; ++bj) { const f32x4 v0 = acc[ai][bj][m][0] * sc, v1 = acc[ai][bj][m][1] * sc;
                    u32x4 w; w.x = cvt_pk_bf16(v0[0], v0[1]); w.y = cvt_pk_bf16(v0[2], v0[3]); w.z = cvt_pk_bf16(v1[0], v1[1]); w.w = cvt_pk_bf16(v1[2], v1[3]);
                    EPI_STORE(w, (u32x4*)(rowp + bj * HALF)); } }
    }
};
template <int CTRL> __device__ __forceinline__ float dppf(float v) { return __builtin_bit_cast(float, __builtin_amdgcn_update_dpp(0, __builtin_bit_cast(int, v), CTRL, 0xF, 0xF, true)); }
struct EpiProjConv {
    static constexpr bool PERM = true, AFTER_DRAIN = false;
    unsigned char* proj; bf16_t* d0a; bf16_t* d1a; const float* cwa; const float* cba; bf16_t* rawha; float sc1a;
    bf16_t* d0b; bf16_t* d1b; const float* cwb; const float* cbb; bf16_t* rawhb;
    __device__ __forceinline__ void operator()(const f32x4 (&acc)[2][2][4][2], const Unit& u, int wr, int wc, int fr, int fq) const {
        const int pn = u.pn; const int row0 = u.pm * BM + wr * 64 + fr;
        const int mode = pn >= 28 ? 1 : 0;
        bf16_t* const d0 = mode ? d0b : d0a; bf16_t* const d1 = mode ? d1b : d1a; const float* const cw = mode ? cwb : cwa; const float* const cb = mode ? cbb : cba; bf16_t* const rawh = mode ? rawhb : rawha; const float sc1 = mode ? 1.0f : sc1a;
        int q, which; bool conv;
        if (mode == 0) { q = pn; conv = q < 8; which = q >> 2; } else { q = pn - 28; conv = q >= 4; which = (q - 4) >> 2; }
        if (!conv) {
            bf16_t* base = (bf16_t*)(proj + (mode == 0 ? (size_t)(q >> 2) * SLAB : (size_t)0)) + (q & 3) * 256 + wc * 32 + 8 * fq;
#pragma unroll
            for (int ai = 0; ai < 2; ++ai)
#pragma unroll
                for (int m = 0; m < 4; ++m) { bf16_t* rowp = base + (size_t)(row0 + ai * HALF + m * 16) * 1024;
#pragma unroll
                    for (int bj = 0; bj < 2; ++bj) { const f32x4 v0 = acc[ai][bj][m][0], v1 = acc[ai][bj][m][1];
                        u32x4 w; w.x = cvt_pk_bf16(v0[0], v0[1]); w.y = cvt_pk_bf16(v0[2], v0[3]); w.z = cvt_pk_bf16(v1[0], v1[1]); w.w = cvt_pk_bf16(v1[2], v1[3]);
                        EPI_STORE(w, (u32x4*)(rowp + bj * HALF)); } }
            return;
        }
        bf16_t* dst = (which ? d1 : d0) + (q & 3) * 256 + wc * 32 + 8 * fq; const float sc = which ? sc1 : 1.0f;
        const int cc0 = which * 1024 + (q & 3) * 256 + wc * 32 + 8 * fq;
        const int blk0 = u.pm * 4 + wr;
#pragma unroll
        for (int bj = 0; bj < 2; ++bj)
#pragma unroll
        for (int h = 0; h < 2; ++h) {
            const int cc = cc0 + bj * HALF + 4 * h;
            const f32x4 w0 = *(const f32x4*)(cw + cc), w1 = *(const f32x4*)(cw + 2048 + cc), w2 = *(const f32x4*)(cw + 4096 + cc), w3 = *(const f32x4*)(cw + 6144 + cc), bb = *(const f32x4*)(cb + cc);
#pragma unroll
            for (int ai = 0; ai < 2; ++ai) {
                f32x4 xp = {0.f, 0.f, 0.f, 0.f};
#pragma unroll
                for (int m = 0; m < 4; ++m) {
                    const f32x4 x = acc[ai][bj][m][h]; float y[4];
#pragma unroll
                    for (int e = 0; e < 4; ++e) {
                        const float h1 = dppf<0x111>(x[e]) + dppf<0x10F>(xp[e]);
                        const float h2 = dppf<0x112>(x[e]) + dppf<0x10E>(xp[e]);
                        const float h3 = dppf<0x113>(x[e]) + dppf<0x10D>(xp[e]);
                        const float t = bb[e] + w3[e] * x[e] + w2[e] * h1 + w1[e] * h2 + w0[e] * h3;
                        y[e] = t * fast_sigmoid(t) * sc; }
                    const size_t r = (size_t)(row0 + ai * HALF + m * 16);
                    u32x2 o; o.x = cvt_pk_bf16(y[0], y[1]); o.y = cvt_pk_bf16(y[2], y[3]);
                    EPI_STORE(o, (u32x2*)(dst + r * 1024 + bj * HALF + 4 * h));
                    if (m == 0 || m == 3) {
                        const bool lo3 = (m == 0) && fr < 3, hi3 = (m == 3) && fr >= 13;
                        if (lo3 || hi3) { const int blk = blk0 + 2 * ai + (hi3 ? 1 : 0), slot = hi3 ? fr - 13 : 3 + fr;
                            u32x2 rw; rw.x = cvt_pk_bf16(x[0], x[1]); rw.y = cvt_pk_bf16(x[2], x[3]);
                            *(u32x2*)(rawh + ((size_t)blk * 6 + slot) * 2048 + cc) = rw; } }
                    xp = x;
                }
            }
        }
    }
};

struct EpiNull {
    static constexpr bool PERM = true, AFTER_DRAIN = false;
    __device__ __forceinline__ void operator()(const f32x4 (&acc)[2][2][4][2], const Unit&, int, int, int, int) const {
#pragma unroll
        for (int ai = 0; ai < 2; ++ai)
#pragma unroll
            for (int bj = 0; bj < 2; ++bj)
#pragma unroll
                for (int m = 0; m < 4; ++m) asm volatile("" :: "v"(acc[ai][bj][m][0]), "v"(acc[ai][bj][m][1]));
    }
};
struct EpiGate {
    static constexpr bool PERM = true, AFTER_DRAIN = false;
    unsigned char* proj; const float* gate_bias;
    __device__ __forceinline__ void operator()(const f32x4 (&acc)[2][2][4][2], const Unit& u, int wr, int wc, int fr, int fq) const {
        const int q = u.pn - 40; const int row0 = u.pm * BM + wr * 64 + fr;
        bf16_t* base = (bf16_t*)(proj + (size_t)(q >> 2) * SLAB) + (q & 3) * 256 + wc * 32 + 8 * fq;
        const float* bp = gate_bias + q * 256 + wc * 32 + 8 * fq;
#pragma unroll
        for (int bj = 0; bj < 2; ++bj) { const f32x4 b0 = *(const f32x4*)(bp + bj * HALF), b1 = *(const f32x4*)(bp + bj * HALF + 4);
#pragma unroll
            for (int ai = 0; ai < 2; ++ai)
#pragma unroll
                for (int m = 0; m < 4; ++m) { f32x4 v0 = acc[ai][bj][m][0] + b0, v1 = acc[ai][bj][m][1] + b1;
#pragma unroll
                    for (int e = 0; e < 4; ++e) { v0[e] = fast_sigmoid(v0[e]); v1[e] = fast_sigmoid(v1[e]); }
                    u32x4 w; w.x = cvt_pk_bf16(v0[0], v0[1]); w.y = cvt_pk_bf16(v0[2], v0[3]); w.z = cvt_pk_bf16(v1[0], v1[1]); w.w = cvt_pk_bf16(v1[2], v1[3]);
                    EPI_STORE(w, (u32x4*)(base + (size_t)(row0 + ai * HALF + m * 16) * 1024 + bj * HALF)); } }
    }
};

struct EpiBranch {
    static constexpr bool PERM = true, AFTER_DRAIN = false;
    bf16_t* U; const bf16_t* G; int first;
    __device__ __forceinline__ void operator()(const f32x4 (&acc)[2][2][4][2], const Unit& u, int wr, int wc, int fr, int fq) const {
        const int row0 = u.pm * BM + wr * 64 + fr, col0 = u.pn * BM + wc * 32 + 8 * fq;
#pragma unroll
        for (int ai = 0; ai < 2; ++ai)
#pragma unroll
            for (int mh = 0; mh < 2; ++mh) {
                u32x4 g[2][2], o[2][2];
#pragma unroll
                for (int mm = 0; mm < 2; ++mm)
#pragma unroll
                    for (int bj = 0; bj < 2; ++bj) { const size_t ro = (size_t)(row0 + ai * HALF + (2 * mh + mm) * 16) * 1024 + col0 + bj * HALF;
                        g[mm][bj] = NT_LOAD((const u32x4*)(G + ro)); o[mm][bj] = (u32x4){0u, 0u, 0u, 0u}; if (!first) o[mm][bj] = *(const u32x4*)(U + ro); }
#pragma unroll
                for (int mm = 0; mm < 2; ++mm)
#pragma unroll
                    for (int bj = 0; bj < 2; ++bj) { const int m = 2 * mh + mm; const size_t ro = (size_t)(row0 + ai * HALF + m * 16) * 1024 + col0 + bj * HALF;
                        const f32x4 a0 = acc[ai][bj][m][0], a1 = acc[ai][bj][m][1]; const u32x4 gg = g[mm][bj], oo = o[mm][bj]; u32x4 w;
                        w.x = cvt_pk_bf16(bf_lo(oo.x) + bf_lo(gg.x) * a0[0], bf_hi(oo.x) + bf_hi(gg.x) * a0[1]);
                        w.y = cvt_pk_bf16(bf_lo(oo.y) + bf_lo(gg.y) * a0[2], bf_hi(oo.y) + bf_hi(gg.y) * a0[3]);
                        w.z = cvt_pk_bf16(bf_lo(oo.z) + bf_lo(gg.z) * a1[0], bf_hi(oo.z) + bf_hi(gg.z) * a1[1]);
                        w.w = cvt_pk_bf16(bf_lo(oo.w) + bf_lo(gg.w) * a1[2], bf_hi(oo.w) + bf_hi(gg.w) * a1[3]);
                        *(u32x4*)(U + ro) = w; }
            }
    }
};

struct EpiResid {
    static constexpr bool PERM = true, AFTER_DRAIN = false;
    const float* src; float* dst; float* ssq;
    __device__ __forceinline__ void operator()(const f32x4 (&acc)[2][2][4][2], const Unit& u, int wr, int wc, int fr, int fq) const {
        const int row0 = u.pm * BM + wr * 64 + fr, col0 = u.pn * BM + wc * 32 + 8 * fq;
#pragma unroll
        for (int ai = 0; ai < 2; ++ai)
#pragma unroll
            for (int mh = 0; mh < 2; ++mh) {
                f32x4 s0[2][2], s1[2][2];
#pragma unroll
                for (int mm = 0; mm < 2; ++mm)
#pragma unroll
                    for (int bj = 0; bj < 2; ++bj) { const size_t ro = (size_t)(row0 + ai * HALF + (2 * mh + mm) * 16) * 1024 + col0 + bj * HALF; s0[mm][bj] = NT_LOAD((const f32x4*)(src + ro)); s1[mm][bj] = NT_LOAD((const f32x4*)(src + ro + 4)); }
#pragma unroll
                for (int mm = 0; mm < 2; ++mm) { const int m = 2 * mh + mm; float q = 0.f;
#pragma unroll
                    for (int bj = 0; bj < 2; ++bj) { const size_t ro = (size_t)(row0 + ai * HALF + m * 16) * 1024 + col0 + bj * HALF;
                        const f32x4 o0 = s0[mm][bj] + acc[ai][bj][m][0], o1 = s1[mm][bj] + acc[ai][bj][m][1];
                        *(f32x4*)(dst + ro) = o0; *(f32x4*)(dst + ro + 4) = o1;
                        if (RESID_SSQ) q += ((o0[0] * o0[0] + o0[1] * o0[1]) + (o0[2] * o0[2] + o0[3] * o0[3])) + ((o1[0] * o1[0] + o1[1] * o1[1]) + (o1[2] * o1[2] + o1[3] * o1[3])); }
                    if (RESID_SSQ) { q += __shfl_xor(q, 16); q += __shfl_xor(q, 32); if (fq == 0) ssq[(size_t)(row0 + ai * HALF + m * 16) * 16 + u.pn * 4 + wc] = q; } }
            }
    }
};

struct EpiGU {
    static constexpr bool PERM = true, AFTER_DRAIN = false;
    bf16_t* ACT;
    __device__ __forceinline__ void operator()(const f32x4 (&acc)[2][2][4][2], const Unit& u, int wr, int wc, int fr, int fq) const {
        const int row0 = u.pm * BM + wr * 64 + fr, col0 = (u.pn & 3) * 128 + wc * 16 + 4 * fq;
#pragma unroll
        for (int ai = 0; ai < 2; ++ai)
#pragma unroll
            for (int m = 0; m < 4; ++m) { bf16_t* rowp = ACT + (size_t)(row0 + ai * HALF + m * 16) * 512 + col0;
#pragma unroll
                for (int bj = 0; bj < 2; ++bj) { const f32x4 g = acc[ai][bj][m][0], v = acc[ai][bj][m][1]; float r[4];
#pragma unroll
                    for (int e = 0; e < 4; ++e) r[e] = g[e] * fast_sigmoid(g[e]) * v[e];
                    uint2 w; w.x = cvt_pk_bf16(r[0], r[1]); w.y = cvt_pk_bf16(r[2], r[3]);
                    *(uint2*)(rowp + bj * 64) = w; } }
    }
};

struct EpiRows {
    static constexpr bool PERM = true, AFTER_DRAIN = false;
    bf16_t* Y;
    __device__ __forceinline__ void operator()(const f32x4 (&acc)[2][2][4][2], const Unit& u, int wr, int wc, int fr, int fq) const {
        const int row0 = u.pm * BM + wr * 64 + fr, col0 = (u.pn & 3) * BM + wc * 32 + 8 * fq;
#pragma unroll
        for (int ai = 0; ai < 2; ++ai)
#pragma unroll
            for (int m = 0; m < 4; ++m) { bf16_t* rowp = Y + (size_t)(row0 + ai * HALF + m * 16) * 1024 + col0;
#pragma unroll
                for (int bj = 0; bj < 2; ++bj) { const f32x4 v0 = acc[ai][bj][m][0], v1 = acc[ai][bj][m][1];
                    u32x4 w; w.x = cvt_pk_bf16(v0[0], v0[1]); w.y = cvt_pk_bf16(v0[2], v0[3]); w.z = cvt_pk_bf16(v1[0], v1[1]); w.w = cvt_pk_bf16(v1[2], v1[3]);
                    *(u32x4*)(rowp + bj * HALF) = w; } }
    }
};

struct RangeOrder {
    static constexpr bool GATHER = false, ROWSKIP = false, B_NT = false; const int* row_tok; const PG8_LAS int* tok_lds;
    StaticOrder S; int pn0, gap_at, gap_len;
    __device__ void init(int M, int npn, int pn0_, int G, int c, int gap_at_ = 1 << 30, int gap_len_ = 0) { S.init(M, npn * BM, G, c); pn0 = pn0_; gap_at = gap_at_; gap_len = gap_len_; }
    __device__ __forceinline__ bool next(int i, Unit& u) const { if (!S.next(i, u)) return false; u.pn += pn0; if (u.pn >= gap_at) u.pn += gap_len; return true; }
    __device__ __forceinline__ void a_ready(const Unit&) const {}
    __device__ __forceinline__ void done(const Unit&) const {}
};
struct ConstOrder {
    static constexpr bool GATHER = false, ROWSKIP = false, B_NT = false; const int* row_tok; const PG8_LAS int* tok_lds;
    int n;
    __device__ __forceinline__ bool next(int i, Unit& u) const { if (i >= n) return false; u.pm = 0; u.pn = 0; u.rows = 256; return true; }
    __device__ __forceinline__ void a_ready(const Unit&) const {}
    __device__ __forceinline__ void done(const Unit&) const {}
};
template <bool G_>
struct MoeOrderT {
    static constexpr bool GATHER = G_, ROWSKIP = (MOE_ROWSKIP != 0), B_NT = MOE_B_NT;
    const PG8_LAS int* tile_start;
    int G, c; const int* row_tok; const PG8_LAS int* tok_lds;
    __device__ __forceinline__ bool next(int i, Unit& u) const {
        const int q = (MOE_XCD && (G & 7) == 0) ? (c & 7) * (G >> 3) + (c >> 3) : c;
        const int L = i * G + q, j = L >> 2; if (j >= tile_start[64]) return false;
        const int ent = tile_start[MOE_ORDER_OFF + j];
        u.pm = ent & 511; u.pn = ((ent >> 9) & 63) * 4 + (L & 3); u.rows = ent >> 15; return true;
    }
    __device__ __forceinline__ void a_ready(const Unit&) const {}
    __device__ __forceinline__ void done(const Unit&) const {}
};
typedef MoeOrderT<false> MoeOrder; typedef MoeOrderT<true> MoeOrderG;
template <class Epi, class Sched, bool ALIGN_EPI = false, bool SP2 = false, bool CH_IN = false, bool CH_OUT = false>
__device__ __forceinline__ void gemm_phase(PG8_LAS unsigned char* lds, const Gemm g, const Sched& S, const Epi& E, const char* chA = nullptr, const char* chB = nullptr) {
    static_assert(!(CH_IN || CH_OUT) || (ALIGN_EPI && SP2 && !Epi::AFTER_DRAIN && !Sched::GATHER), "chained calls: aligned epilogues, SP2 loop, plain A");
    static_assert(SP2 || !Sched::GATHER, "the gathered-A form exists only in the SP2 loop");
    int tid_ = threadIdx.x; asm volatile("" : "+v"(tid_));
    const int tid = tid_, wid = __builtin_amdgcn_readfirstlane(tid >> 6), lane = tid & 63, wr = wid >> 2, wc = wid & 3, fr = lane & 15, fq = lane >> 4;
    const int K = g.K, nt = K / BK;
    constexpr bool GATH = Sched::GATHER;
    unsigned voffA[2], voffB[2], voffG[2][2];
#pragma unroll
    for (int i = 0; i < 2; ++i) { int R, C; stage_rc(tid * 16 + i * 8192, R, C); const int Rb = Epi::PERM ? ((R & ~31) + perm32(R & 31)) : R;
        voffA[i] = (unsigned)(R * K + C) * 2u; voffB[i] = (unsigned)(Rb * K + C) * 2u; }
    const size_t kstep = (size_t)(BK * 2);
    const size_t hstep = (size_t)HALF * K * 2;
    const size_t tstep = 2 * hstep;
    const unsigned ldsw = (unsigned)wid * 1024u;
    const int aoff = lds_byte(wr * 64 + fr, fq * 8), boff = lds_byte(wc * 32 + fr, fq * 8);
#define PG8_SA(b, h) (((b) * 2 + (h)) * HTB)
#define PG8_SB(b, h) ((4 + (b) * 2 + (h)) * HTB)
#define PG8_STAGE(bufoff, gbase, voff) do { _Pragma("unroll") for (int _i = 0; _i < 2; ++_i) \
        __builtin_amdgcn_global_load_lds((const unsigned*)((const char*)(gbase) + (voff)[_i]), (PG8_LAS unsigned*)(lds + (bufoff) + ldsw + _i * 8192), 16, 0, 0); } while (0)
#define PG8_STAGE_B(bufoff, gbase, voff) do { _Pragma("unroll") for (int _i = 0; _i < 2; ++_i) \
        __builtin_amdgcn_global_load_lds((const unsigned*)((const char*)(gbase) + (voff)[_i]), (PG8_LAS unsigned*)(lds + (bufoff) + ldsw + _i * 8192), 16, 0, Sched::B_NT ? 2 : 0); } while (0)
#define PG8_STAGE_A(bufoff, gptr, hf) do { if constexpr (GATH) { PG8_STAGE(bufoff, gptr, voffG[hf]); } else { PG8_STAGE(bufoff, (gptr) + (hf) * hstep, voffA); } } while (0)
#define PG8_TOKDMA(u_, slot) do { if (wid < 4) __builtin_amdgcn_global_load_lds((const unsigned*)(S.row_tok + (u_).pm * BM + wid * 64 + lane), (PG8_LAS unsigned*)(S.tok_lds + (slot) * 256 + wid * 64), 4, 0, 0); } while (0)
#define PG8_GOFF(slot) do { _Pragma("unroll") for (int h_ = 0; h_ < 2; ++h_) _Pragma("unroll") for (int i_ = 0; i_ < 2; ++i_) { int R_, C_; stage_rc(tid * 16 + i_ * 8192, R_, C_); voffG[h_][i_] = ((unsigned)S.tok_lds[(slot) * 256 + h_ * HALF + R_] * (unsigned)K + (unsigned)C_) * 2u; } } while (0)
#define PG8_LDA(dst, b, h) do { _Pragma("unroll") for (int m = 0; m < 4; ++m) _Pragma("unroll") for (int k = 0; k < 2; ++k) dst[m][k] = *(const PG8_LAS bf16x8*)(lds + PG8_SA(b, h) + aoff + m * 2048 + k * 1024); } while (0)
#define PG8_LDB(dst, b, h) do { _Pragma("unroll") for (int n = 0; n < 2; ++n) _Pragma("unroll") for (int k = 0; k < 2; ++k) dst[n][k] = *(const PG8_LAS bf16x8*)(lds + PG8_SB(b, h) + boff + n * 2048 + k * 1024); } while (0)
#define PG8_MMA(ai, bj, At, Bt) do { __builtin_amdgcn_s_setprio(1); _Pragma("unroll") for (int m = 0; m < 4; ++m) _Pragma("unroll") for (int n = 0; n < 2; ++n) _Pragma("unroll") for (int k = 0; k < 2; ++k) \
        acc[ai][bj][m][n] = __builtin_amdgcn_mfma_f32_16x16x32_bf16(Bt[n][k], At[m][k], acc[ai][bj][m][n], 0, 0, 0); __builtin_amdgcn_s_setprio(0); } while (0)
#define PG8_WAIT_V(n) asm volatile("s_waitcnt vmcnt(" #n ")" ::: "memory")
#define PG8_WAIT_L(n) asm volatile("s_waitcnt lgkmcnt(" #n ")" ::: "memory")
#define PG8_BAR __builtin_amdgcn_s_barrier()
#define PG8_SCHED __builtin_amdgcn_sched_barrier(0)
    Unit cur, nxt; int ui = 0;
    if (!S.next(0, cur)) return;
    constexpr bool RS = Sched::ROWSKIP;
    bool do0 = true, do1 = true; if constexpr (RS) { do0 = cur.rows > wr * 64; do1 = cur.rows > 128 + wr * 64; }
#define PG8_IF0 if (!RS || do0)
#define PG8_IF1 if (!RS || do1)
#define PG8_IFB if (!RS || do0 || do1)
    f32x4 acc[2][2][4][2];
#pragma unroll
    for (int a = 0; a < 2; ++a)
#pragma unroll
        for (int b = 0; b < 2; ++b)
#pragma unroll
            for (int m = 0; m < 4; ++m)
#pragma unroll
                for (int n = 0; n < 2; ++n) acc[a][b][m][n] = (f32x4){0.f, 0.f, 0.f, 0.f};
    bf16x8 At[4][2], B0[2][2], B1[2][2];
    const char* cA = GATH ? (const char*)g.A : (const char*)g.A + (size_t)cur.pm * tstep; const char* cB = (const char*)g.Bt + (size_t)cur.pn * tstep;
    if constexpr (GATH) { PG8_TOKDMA(cur, 0); PG8_WAIT_V(0); PG8_BAR; PG8_GOFF(0); }
    if constexpr (!CH_IN) {
    S.a_ready(cur);
    if constexpr (SP2) {
        PG8_STAGE_B(PG8_SB(0, 0), cB, voffB); PG8_STAGE_B(PG8_SB(0, 1), cB + hstep, voffB); PG8_STAGE_A(PG8_SA(0, 0), cA, 0); PG8_STAGE_A(PG8_SA(0, 1), cA, 1);
        if (wr == 1) PG8_BAR;
        PG8_WAIT_V(2); PG8_BAR;
        PG8_STAGE_B(PG8_SB(1, 0), cB + kstep, voffB); PG8_STAGE_A(PG8_SA(1, 0), cA + kstep, 0); PG8_STAGE_B(PG8_SB(1, 1), cB + hstep + kstep, voffB);
        PG8_WAIT_V(6); PG8_BAR;
    } else {
        PG8_STAGE_B(PG8_SB(0, 0), cB, voffB); PG8_STAGE(PG8_SA(0, 0), cA, voffA); PG8_STAGE_B(PG8_SB(0, 1), cB + hstep, voffB); PG8_STAGE(PG8_SA(0, 1), cA + hstep, voffA);
        if (wr == 1) PG8_BAR;
        PG8_WAIT_V(4); PG8_BAR;
        PG8_STAGE_B(PG8_SB(1, 0), cB + kstep, voffB); PG8_STAGE(PG8_SA(1, 0), cA + kstep, voffA); PG8_STAGE_B(PG8_SB(1, 1), cB + hstep + kstep, voffB);
        PG8_WAIT_V(6); PG8_BAR;
    }
    }
    for (;;) {
        const bool has_next = S.next(ui + 1, nxt);
        const char* nA = has_next ? (GATH ? (const char*)g.A : (const char*)g.A + (size_t)nxt.pm * tstep) : (CH_OUT ? chA : cA);
        if constexpr (GATH) { if (has_next) PG8_TOKDMA(nxt, (ui + 1) & 1); }
        const char* nB = has_next ? (const char*)g.Bt + (size_t)nxt.pn * tstep : (CH_OUT ? chB : cB);
        for (int t = 0; t < nt; t += 2) {
            const bool last = (t == nt - 2);
            const char* a1 = cA + (size_t)(t + 1) * kstep;
            const char* a2 = last ? nA : cA + (size_t)(t + 2) * kstep; const char* b2 = last ? nB : cB + (size_t)(t + 2) * kstep;
            const char* a3 = a2 + kstep; const char* b3 = b2 + kstep;
            if (last && has_next) S.a_ready(nxt);
            if constexpr (SP2) {
            PG8_IFB { PG8_LDB(B0, 0, 0); PG8_LDB(B1, 0, 1); } PG8_SCHED; PG8_IF0 { PG8_LDA(At, 0, 0); } PG8_STAGE_A(PG8_SA(1, 1), a1, 1);
            if constexpr (GATH) { if (last && has_next) PG8_GOFF((ui + 1) & 1); }
            PG8_WAIT_V(8); PG8_WAIT_L(0); PG8_BAR; PG8_IF0 { PG8_MMA(0, 0, At, B0); PG8_MMA(0, 1, At, B1); } PG8_BAR; PG8_SCHED;
            PG8_IF1 { PG8_LDA(At, 0, 1); } PG8_STAGE_B(PG8_SB(0, 0), b2, voffB); PG8_STAGE_B(PG8_SB(0, 1), b2 + hstep, voffB); PG8_STAGE_A(PG8_SA(0, 0), a2, 0);
            PG8_WAIT_V(8); PG8_WAIT_L(0); PG8_BAR; PG8_IF1 { PG8_MMA(1, 0, At, B0); PG8_MMA(1, 1, At, B1); } PG8_BAR; PG8_SCHED;
            PG8_IFB { PG8_LDB(B0, 1, 0); PG8_LDB(B1, 1, 1); } PG8_SCHED; PG8_IF0 { PG8_LDA(At, 1, 0); } PG8_STAGE_A(PG8_SA(0, 1), a2, 1);
            PG8_WAIT_V(8); PG8_WAIT_L(0); PG8_BAR; PG8_IF0 { PG8_MMA(0, 0, At, B0); PG8_MMA(0, 1, At, B1); } PG8_BAR; PG8_SCHED;
            PG8_IF1 { PG8_LDA(At, 1, 1); } PG8_STAGE_B(PG8_SB(1, 0), b3, voffB); PG8_STAGE_B(PG8_SB(1, 1), b3 + hstep, voffB); PG8_STAGE_A(PG8_SA(1, 0), a3, 0);
            PG8_WAIT_V(8); PG8_WAIT_L(0); PG8_BAR; PG8_IF1 { PG8_MMA(1, 0, At, B0); PG8_MMA(1, 1, At, B1); } PG8_BAR; PG8_SCHED;
            } else {
            PG8_LDB(B0, 0, 0); PG8_SCHED; PG8_LDA(At, 0, 0); PG8_STAGE(PG8_SA(1, 1), a1 + hstep, voffA);
            PG8_WAIT_L(8); PG8_BAR; PG8_WAIT_L(0); PG8_MMA(0, 0, At, B0); PG8_BAR; PG8_SCHED;
            PG8_LDB(B1, 0, 1); PG8_STAGE_B(PG8_SB(0, 0), b2, voffB);
            PG8_BAR; PG8_WAIT_L(0); PG8_MMA(0, 1, At, B1); PG8_BAR;
            PG8_LDA(At, 0, 1); PG8_STAGE(PG8_SA(0, 0), a2, voffA);
            PG8_BAR; PG8_WAIT_L(0); PG8_MMA(1, 0, At, B0); PG8_BAR; PG8_SCHED;
            PG8_STAGE_B(PG8_SB(0, 1), b2 + hstep, voffB);
            PG8_WAIT_V(6); PG8_BAR; PG8_MMA(1, 1, At, B1); PG8_BAR;
            PG8_LDB(B0, 1, 0); PG8_SCHED; PG8_LDA(At, 1, 0); PG8_STAGE(PG8_SA(0, 1), a2 + hstep, voffA);
            PG8_WAIT_L(8); PG8_BAR; PG8_WAIT_L(0); PG8_MMA(0, 0, At, B0); PG8_BAR; PG8_SCHED;
            PG8_LDB(B1, 1, 1); PG8_STAGE_B(PG8_SB(1, 0), b3, voffB);
            PG8_BAR; PG8_WAIT_L(0); PG8_MMA(0, 1, At, B1); PG8_BAR;
            PG8_LDA(At, 1, 1); PG8_STAGE(PG8_SA(1, 0), a3, voffA);
            PG8_BAR; PG8_WAIT_L(0); PG8_MMA(1, 0, At, B0); PG8_BAR; PG8_SCHED;
            PG8_STAGE_B(PG8_SB(1, 1), b3 + hstep, voffB);
            PG8_WAIT_V(6); PG8_BAR; PG8_MMA(1, 1, At, B1); PG8_BAR;
            }
        }
        if constexpr (ALIGN_EPI) { if (wr == 0) PG8_BAR; }
        if constexpr (!Epi::AFTER_DRAIN) { E(acc, cur, wr, wc, fr, fq); S.done(cur); }
        if (!has_next) { if constexpr (CH_OUT) { if (wr == 1) PG8_BAR; } break; }
#pragma unroll
        for (int a = 0; a < 2; ++a)
#pragma unroll
            for (int b = 0; b < 2; ++b)
#pragma unroll
                for (int m = 0; m < 4; ++m)
#pragma unroll
                    for (int n = 0; n < 2; ++n) acc[a][b][m][n] = (f32x4){0.f, 0.f, 0.f, 0.f};
        cur = nxt; cA = nA; cB = nB; ++ui; if constexpr (RS) { do0 = cur.rows > wr * 64; do1 = cur.rows > 128 + wr * 64; }
        if constexpr (ALIGN_EPI) { if (wr == 1) PG8_BAR; }
    }
    if constexpr (!CH_OUT) {
    PG8_WAIT_V(0);
    if constexpr (!ALIGN_EPI) { if (wr == 0) PG8_BAR; }
    PG8_BAR;
    if constexpr (Epi::AFTER_DRAIN) { E.fused(acc, cur, wr, wc, fr, fq, lds, wid, lane); S.done(cur); }
    }
#undef PG8_SA
#undef PG8_IF0
#undef PG8_IF1
#undef PG8_IFB
#undef PG8_SB
#undef PG8_STAGE
#undef PG8_STAGE_B
#undef PG8_LDA
#undef PG8_STAGE_A
#undef PG8_GOFF
#undef PG8_TOKDMA
#undef PG8_LDB
#undef PG8_MMA
#undef PG8_WAIT_V
#undef PG8_WAIT_L
#undef PG8_BAR
#undef PG8_SCHED
}
}
#include <hip/hip_bf16.h>
#include <cmath>
namespace attn_body {
using bf16=__hip_bfloat16;
using bf16x8=__attribute__((ext_vector_type(8)))short;
using s16x4=__attribute__((ext_vector_type(4)))short;
using f32x16=__attribute__((ext_vector_type(16)))float;
using u32x4=__attribute__((ext_vector_type(4)))unsigned;
constexpr int BATCH=16,NHEAD=16,SEQ=2048,D=64,DM=NHEAD*D;
constexpr int NW=8,QBLK=32,QB=QBLK*NW,KVBLK=64,NQB=SEQ/QB;
constexpr int ATTN_PITCH=DM, ATTN_UNIT_ROWS=QB;
__device__ __forceinline__ int crow(int r,int hi){return (r&3)+8*(r>>2)+4*hi;}
#define SBAR() __builtin_amdgcn_sched_barrier(0)
__device__ __forceinline__ void cmask(f32x16&p0,f32x16&p1,int jb,int qrel,int hi){
  const float NEG=-INFINITY; int kb=64*jb+4*hi;
  #pragma unroll
  for(int r=0;r<16;++r){int kv=kb+(r&3)+8*(r>>2); if(kv>qrel)p0[r]=NEG; if(kv+32>qrel)p1[r]=NEG;}
}

constexpr int NSLOT=3, SLOTB=8192;
constexpr int LDS_K=0, LDS_V=NSLOT*SLOTB, LDS_WS=2*NSLOT*SLOTB, LDS_OST=LDS_WS+NW*64*4, LDS_KB=LDS_OST+NW*4096, LDS_BYTES=LDS_KB+SEQ*4;
constexpr int GW_STRIDE=4608, LDS_GW=LDS_BYTES, LDS_BYTES_G=LDS_GW+NW*GW_STRIDE;
struct Guest { bf16* Y0; bf16* Y1; const float* S0; const float* S1; int row0; int k; int n; };
constexpr float C2=0.125f*1.4426950408889634f;
__device__ __forceinline__ void glds16(const void*gsrc,unsigned lds_dst){unsigned keep;
  asm volatile("s_mov_b32 %0, m0\n\ts_mov_b32 m0, %2\n\ts_nop 0\n\tglobal_load_lds_dwordx4 %1, off\n\ts_mov_b32 m0, %0":"=&s"(keep):"v"(gsrc),"s"(lds_dst):"memory");}
__device__ __forceinline__ void glds4(const void*gsrc,unsigned lds_dst){unsigned keep;
  asm volatile("s_mov_b32 %0, m0\n\ts_mov_b32 m0, %2\n\ts_nop 0\n\tglobal_load_lds_dword %1, off\n\ts_mov_b32 m0, %0":"=&s"(keep):"v"(gsrc),"s"(lds_dst):"memory");}
__device__ __forceinline__ float max3f(float a,float b,float c){float r;asm("v_max3_f32 %0, %1, %2, %3":"=v"(r):"v"(a),"v"(b),"v"(c));return r;}
__device__ __forceinline__ float max2f(float a,float b){float r;asm("v_max_f32_e32 %0, %1, %2":"=v"(r):"v"(a),"v"(b));return r;}
__device__ __forceinline__ float fadd_s(float a,float b){float r;asm("v_add_f32_e32 %0, %1, %2":"=v"(r):"v"(a),"v"(b));return r;}
__device__ __forceinline__ float fsub_s(float a,float b){float r;asm("v_sub_f32_e32 %0, %1, %2":"=v"(r):"v"(a),"v"(b));return r;}
typedef float f32x2_t __attribute__((ext_vector_type(2))); typedef __bf16 bf16x2_t __attribute__((ext_vector_type(2)));
__device__ __forceinline__ unsigned cvtpk_s(float lo,float hi){f32x2_t v={lo,hi};bf16x2_t b=__builtin_convertvector(v,bf16x2_t);return __builtin_bit_cast(unsigned,b);}
__device__ __forceinline__ void guest_issue(const Guest&G,int row,unsigned gdst,int lane){
  const bf16*y0=G.Y0+(long)row*1024+8*lane; const bf16*y1=G.Y1+(long)row*1024+8*lane;
  glds16(y0,gdst); glds16(y0+512,gdst+1024); glds16(y1,gdst+2048); glds16(y1+512,gdst+3072); glds4(G.S0+(long)row*16+(lane&15),gdst+4096); glds4(G.S1+(long)row*16+(lane&15),gdst+4352);
}
__device__ __forceinline__ void guest_finish(const Guest&G,int row,const char*shm,int wid,int lane){
  const char*gb=shm+LDS_GW+wid*GW_STRIDE;
  #pragma unroll
  for(int t=0;t<2;++t){ bf16*Y=t?G.Y1:G.Y0;
    #pragma unroll
    for(int j=0;j<2;++j){
      const u32x4 y=*(const u32x4*)(gb+t*2048+j*1024+lane*16);
      const float4 q=*(const float4*)(gb+4096+t*256+16*((lane>>5)+2*j)); const float rstd=__builtin_amdgcn_rsqf(((q.x+q.y)+(q.z+q.w))*(1.f/256.f)+1e-6f);
      u32x4 r;
      #pragma unroll
      for(int e=0;e<4;++e) r[e]=cvtpk_s(__uint_as_float(y[e]<<16)*rstd,__uint_as_float(y[e]&0xffff0000u)*rstd);
      *(u32x4*)(Y+(long)row*1024+8*(lane+64*j))=r;
    } }
}
#define WAIT_BAR(N) asm volatile("s_waitcnt vmcnt(" #N ") lgkmcnt(0)\n\ts_barrier":::"memory")

__device__ __forceinline__ void qkt(f32x16&p0,f32x16&p1,const char*Kslot,const bf16x8*qr,int r32,int hi){
  const char*kb=Kslot+hi*1024+r32*16;
  #pragma unroll
  for(int d0=0;d0<4;++d0){
    const bf16x8 b0=*reinterpret_cast<const bf16x8*>(kb+d0*2048);
    const bf16x8 b1=*reinterpret_cast<const bf16x8*>(kb+d0*2048+512);
    p0=__builtin_amdgcn_mfma_f32_32x32x16_bf16(b0,qr[d0],p0,0,0,0);p1=__builtin_amdgcn_mfma_f32_32x32x16_bf16(b1,qr[d0],p1,0,0,0);}
}
typedef __attribute__((address_space(3))) const char* lds_cptr;
typedef short v4i16_t __attribute__((ext_vector_type(4)));
__device__ __forceinline__ void kload8(bf16x8*kf,lds_cptr kp){
  kf[0]=*(const __attribute__((address_space(3))) bf16x8*)(kp);      kf[1]=*(const __attribute__((address_space(3))) bf16x8*)(kp+512);
  kf[2]=*(const __attribute__((address_space(3))) bf16x8*)(kp+2048); kf[3]=*(const __attribute__((address_space(3))) bf16x8*)(kp+2560);
  kf[4]=*(const __attribute__((address_space(3))) bf16x8*)(kp+4096); kf[5]=*(const __attribute__((address_space(3))) bf16x8*)(kp+4608);
  kf[6]=*(const __attribute__((address_space(3))) bf16x8*)(kp+6144); kf[7]=*(const __attribute__((address_space(3))) bf16x8*)(kp+6656);
}
__device__ __forceinline__ void kload2(bf16x8*kf,lds_cptr kp,int j){ kf[2*j]=*(const __attribute__((address_space(3))) bf16x8*)(kp+j*2048); kf[2*j+1]=*(const __attribute__((address_space(3))) bf16x8*)(kp+j*2048+512); }
__device__ __forceinline__ s16x4 vtr(lds_cptr p){ return __builtin_bit_cast(s16x4,__builtin_amdgcn_ds_read_tr16_b64_v4i16((__attribute__((address_space(3))) v4i16_t*)p)); }
__device__ __forceinline__ float rowmax(const f32x16&p0,const f32x16&p1){
  float a=max3f(p0[0],p0[1],p1[0]),b=max3f(p0[2],p0[3],p1[1]);a=max3f(a,p1[2],p1[3]);
  #pragma unroll
  for(int r=4;r<16;r+=4){a=max3f(a,p0[r],p0[r+1]);b=max3f(b,p0[r+2],p0[r+3]);a=max3f(a,p1[r],p1[r+1]);b=max3f(b,p1[r+2],p1[r+3]);}
  const float m=max2f(a,b);
  auto rr=__builtin_amdgcn_permlane32_swap(__float_as_uint(m),__float_as_uint(m),false,false);
  return max2f(__uint_as_float(rr[0]),__uint_as_float(rr[1]));
}
__device__ __forceinline__ void pv(f32x16*o,int vb,bf16x8 pa0,bf16x8 pa1,bf16x8 pa2,bf16x8 pa3){
  #pragma unroll
  for(int d0=0;d0<2;++d0){s16x4 lo[4],hi[4];
    #pragma unroll
    for(int ks=0;ks<4;++ks){
      asm volatile("ds_read_b64_tr_b16 %0,%1 offset:%c2":"=&v"(lo[ks]):"v"(vb),"i"(d0*4096+ks*1024):"memory");
      asm volatile("ds_read_b64_tr_b16 %0,%1 offset:%c2":"=&v"(hi[ks]):"v"(vb),"i"(d0*4096+ks*1024+512):"memory");}
    asm volatile("s_waitcnt lgkmcnt(0)":::"memory");SBAR();
    #define PK(k) (bf16x8){lo[k][0],lo[k][1],lo[k][2],lo[k][3],hi[k][0],hi[k][1],hi[k][2],hi[k][3]}
    o[d0]=__builtin_amdgcn_mfma_f32_32x32x16_bf16(pa0,PK(0),o[d0],0,0,0);
    o[d0]=__builtin_amdgcn_mfma_f32_32x32x16_bf16(pa1,PK(1),o[d0],0,0,0);
    o[d0]=__builtin_amdgcn_mfma_f32_32x32x16_bf16(pa2,PK(2),o[d0],0,0,0);
    o[d0]=__builtin_amdgcn_mfma_f32_32x32x16_bf16(pa3,PK(3),o[d0],0,0,0);
    #undef PK
  }
}

#ifndef ATTN_STORE16
#define ATTN_STORE16(p,v) NT_STORE((v),(u32x4*)(p))
#endif
template<int THRL> __device__ __forceinline__ void attn_unit(int b,int h,int qb,const bf16*Q,const bf16*__restrict__ K,const bf16*__restrict__ V,bf16*O,const float*__restrict__ Fg,bool stage_kb,char*shm,Guest&G,bool pre_cur,bool pre_next,int qb_next,bf16x8(&qr)[4]){
  int tid_=threadIdx.x; asm volatile("":"+v"(tid_)); const int tid=tid_,lane=tid&63,r32=lane&31,hi=lane>>5; const int wid=__builtin_amdgcn_readfirstlane(tid>>6);
  const long rowbase=(long)b*SEQ; const int q0=qb*QB;
  if(stage_kb){ float*kbw=(float*)(shm+LDS_KB); for(int j=4*tid;j<SEQ;j+=4*NW*64){ const float4 f=*reinterpret_cast<const float4*>(Fg+j); *reinterpret_cast<float4*>(kbw+j)=make_float4(f.x*-1.4426950408889634f,f.y*-1.4426950408889634f,f.z*-1.4426950408889634f,f.w*-1.4426950408889634f);} }
  const float*kb=(const float*)(shm+LDS_KB)+4*hi;
  const bf16*Qw=Q+(rowbase+q0+wid*QBLK)*DM+h*D;
  const bf16*Kh=K+rowbase*DM+h*D,*Vh=V+rowbase*DM+h*D;
  const unsigned lds0=(unsigned)(uintptr_t)shm;
  float*wsf=(float*)(shm+LDS_WS)+wid*64;
  const bf16*ksrc=Kh+(long)lane*DM+wid*8;
  const bf16*vsrc=Vh+(long)(16*(wid&3)+(lane>>2))*DM+(wid>>2)*32+(lane&3)*8;
  const unsigned kdst=lds0+LDS_K+wid*1024, vdst=lds0+LDS_V+wid*1024;
  #define DMA_K(t,slot) glds16(ksrc+(long)(t)*KVBLK*DM,(unsigned)__builtin_amdgcn_readfirstlane(kdst+(slot)))
  #define DMA_V(t,slot) glds16(vsrc+(long)(t)*KVBLK*DM,(unsigned)__builtin_amdgcn_readfirstlane(vdst+(slot)))
  const int vb0=(int)(lds0+LDS_V)+((lane>>4)&1)*32+(lane&3)*8+(4*hi+((lane&15)>>2))*64;
  const char*Kbase=shm+LDS_K; bf16x8 kf[8];
  const lds_cptr shm3=(lds_cptr)shm; const lds_cptr kp0=shm3+LDS_K+hi*1024+r32*16; const lds_cptr vp0=shm3+LDS_V+((lane>>4)&1)*32+(lane&3)*8+(4*hi+((lane&15)>>2))*64;
  const int NT=(q0+QB)/KVBLK;
  if(!(ATT_PRE&&pre_cur)){DMA_K(0,0);DMA_V(0,0);DMA_K(1,SLOTB);}
  if(!(ATT_PRE&&pre_cur)){
  #pragma unroll
  for(int d0=0;d0<4;++d0)qr[d0]=*reinterpret_cast<const bf16x8*>(&Qw[(long)r32*DM+d0*16+hi*8]); }
  float mhat=0.f,l_reg=0.f;f32x16 o[2];o[0]=f32x16{};o[1]=f32x16{};
  const int qrel=wid*QBLK+r32;
  #define CMASK(P0,P1,t) do{int jb_=(t)-(NT-4); if(jb_>=0)cmask(P0,P1,jb_,qrel,hi);}while(0)
  bool resc=false;
#if ATT_PK
  typedef float f32x4v __attribute__((ext_vector_type(4))); typedef float f32x8v __attribute__((ext_vector_type(8)));
  #define KB4(p_) (*reinterpret_cast<const f32x4v*>(p_))
  #define CAT8(x_,y_) __builtin_shufflevector(x_,y_,0,1,2,3,4,5,6,7)
  #define CAT16(x_,y_) __builtin_shufflevector(x_,y_,0,1,2,3,4,5,6,7,8,9,10,11,12,13,14,15)
  #define KBINIT(C0,C1,t) do{ const float*kp_=kb+64*(t); f32x16 mh_; { const float nm_=-mhat; _Pragma("unroll") for(int i_=0;i_<16;++i_)mh_[i_]=nm_; } \
      C0=CAT16(CAT8(KB4(kp_),KB4(kp_+8)),CAT8(KB4(kp_+16),KB4(kp_+24)))+mh_; C1=CAT16(CAT8(KB4(kp_+32),KB4(kp_+40)),CAT8(KB4(kp_+48),KB4(kp_+56)))+mh_; }while(0)
#else
  #define KBINIT(C0,C1,t) do{ const float*kp_=kb+64*(t); _Pragma("unroll") for(int g_=0;g_<4;++g_){ const float4 a_=*reinterpret_cast<const float4*>(kp_+8*g_), b_=*reinterpret_cast<const float4*>(kp_+32+8*g_); \
      C0[4*g_]=a_.x-mhat;C0[4*g_+1]=a_.y-mhat;C0[4*g_+2]=a_.z-mhat;C0[4*g_+3]=a_.w-mhat; C1[4*g_]=b_.x-mhat;C1[4*g_+1]=b_.y-mhat;C1[4*g_+2]=b_.z-mhat;C1[4*g_+3]=b_.w-mhat; } }while(0)
#endif
#if ATT_KBPRE
  #define KBINIT_AT_START(C0,C1,t) do{}while(0)
  #define KBNEXT_LOAD(G,t) f32x4v ka0_,ka1_,ka2_,ka3_,kb0_,kb1_,kb2_,kb3_; if(G){ const float*kn_=kb+64*((t)+1); ka0_=KB4(kn_);ka1_=KB4(kn_+8);ka2_=KB4(kn_+16);ka3_=KB4(kn_+24);kb0_=KB4(kn_+32);kb1_=KB4(kn_+40);kb2_=KB4(kn_+48);kb3_=KB4(kn_+56); }
  #define KBNEXT_ADD(G,N0,N1) if(G){ f32x16 mh_; { const float nm_=-mhat; _Pragma("unroll") for(int i_=0;i_<16;++i_)mh_[i_]=nm_; } N0=CAT16(CAT8(ka0_,ka1_),CAT8(ka2_,ka3_))+mh_; N1=CAT16(CAT8(kb0_,kb1_),CAT8(kb2_,kb3_))+mh_; }
#else
  #define KBINIT_AT_START(C0,C1,t) KBINIT(C0,C1,t)
  #define KBNEXT_LOAD(G,t) do{}while(0)
  #define KBNEXT_ADD(G,N0,N1) do{}while(0)
#endif
  #define START(P0,P1) do{ const float rm=rowmax(P0,P1); resc=false; \
    { const float dl=rm; mhat=fadd_s(mhat,dl); \
      _Pragma("unroll") for(int r=0;r<16;++r){P0[r]=fsub_s(P0[r],dl);P1[r]=fsub_s(P1[r],dl);} \
      } \
    _Pragma("unroll") for(int r=0;r<16;++r)P0[r]=__builtin_amdgcn_exp2f(P0[r]); }while(0)
  #define RESC() do{ if(resc){ asm volatile("s_waitcnt lgkmcnt(0)":::"memory"); \
      _Pragma("unroll") for(int d_=0;d_<2;++d_) _Pragma("unroll") for(int r=0;r<16;++r)o[d_][r]*=wsf[crow(r,hi)]; } }while(0)
  f32x16 pA0,pA1,pB0,pB1;
  int sl_prev=0,sl_cur=0,sl_next=SLOTB;
  #define ROT() do{sl_prev=sl_cur;sl_cur=sl_next;sl_next=(sl_next==(NSLOT-1)*SLOTB)?0:sl_next+SLOTB;}while(0)
  DMA_K(2,2*SLOTB);
  WAIT_BAR(3);
  KBINIT(pA0,pA1,0); qkt(pA0,pA1,Kbase,qr,r32,hi);asm volatile("s_nop 15\n\ts_nop 7":"+v"(pA0),"+v"(pA1));CMASK(pA0,pA1,0);
  START(pA0,pA1);
  _Pragma("unroll") for(int r=0;r<16;++r)pA1[r]=__builtin_amdgcn_exp2f(pA1[r]);
  WAIT_BAR(0);
  DMA_K(3,0);DMA_V(1,SLOTB);
  ROT();
  kload8(kf,kp0+sl_cur);
#if ATT_KBPRE
  KBINIT(pB0,pB1,1);
#endif
  WAIT_BAR(2);
  s16x4 vlo[8],vhi[8]; u32x4 pw0,pw1,pw2,pw3;
  #define PKW(P,B) cvtpk_s(P[B],P[B+1])
  #define PAF(k) __builtin_bit_cast(bf16x8,pw##k)
  #define VFR(i) (bf16x8){vlo[i][0],vlo[i][1],vlo[i][2],vlo[i][3],vhi[i][0],vhi[i][1],vhi[i][2],vhi[i][3]}
  #define PIN(x) asm volatile("":"+v"(x))
  #define MX3(a,b,c) __builtin_fmaxf(__builtin_fmaxf((a),(b)),(c))
#if ATT_PK
  #define GAPA(MF,A0,A1,A2,A3,W0,W1,PW) do{ MF; { const f32x2_t u_={A0,A1}, w_={A2,A3}; asm volatile("v_pk_add_f32 %0, %0, %1\n\tv_pk_add_f32 %0, %0, %2":"+v"(sacc):"v"(u_),"v"(w_)); } W0; W1; PIN(PW); SBAR(); }while(0)
  #define SACC_T f32x2_t
  #define SACC_INIT(P) (f32x2_t){P[0],P[1]}
  #define SACC_SUM(s) ((s).x+(s).y)
#else
  #define GAPA(MF,A0,A1,A2,A3,W0,W1,PW) do{ MF; sacc+=A0; sacc+=A1; sacc+=A2; sacc+=A3; PIN(sacc); W0; W1; PIN(PW); SBAR(); }while(0)
  #define SACC_T float
  #define SACC_INIT(P) (P[0]+P[1])
  #define SACC_SUM(s) (s)
#endif
  #define EX(v) __builtin_amdgcn_exp2f(v)
  #define GAPB(MF,X,B) do{ MF; X[B]=EX(X[B]); X[B+1]=EX(X[B+1]); X[B+2]=EX(X[B+2]); X[B+3]=EX(X[B+3]); PIN(X); SBAR(); }while(0)
  #define VRD(i) do{ vlo[i]=vtr(vp_+(((i)>>2)*4096+((i)&3)*1024)); vhi[i]=vtr(vp_+(((i)>>2)*4096+((i)&3)*1024+512)); }while(0)
  #define KRD(G,j) do{ if(G){ kload2(kf,kp0+sl_next,j); SBAR(); } }while(0)
  #define STEP(C0,C1,P0,P1,t,GK,GV,GL) do{ SBAR(); \
    const lds_cptr vp_=vp0+sl_prev; \
    KBINIT_AT_START(C0,C1,t); SBAR(); VRD(0); SBAR(); SACC_T sacc=SACC_INIT(P0); \
    GAPA(C0=__builtin_amdgcn_mfma_f32_32x32x16_bf16(kf[0],qr[0],C0,0,0,0), P0[2],P0[3],P0[4],P0[5],     pw0[0]=PKW(P0,0), pw0[1]=PKW(P0,2), pw0); \
    VRD(4); SBAR(); GAPA(C1=__builtin_amdgcn_mfma_f32_32x32x16_bf16(kf[1],qr[0],C1,0,0,0), P0[6],P0[7],P0[8],P0[9],     pw0[2]=PKW(P0,4), pw0[3]=PKW(P0,6), pw0); \
    VRD(1); SBAR(); GAPA(C0=__builtin_amdgcn_mfma_f32_32x32x16_bf16(kf[2],qr[1],C0,0,0,0),   P0[10],P0[11],P0[12],P0[13], pw1[0]=PKW(P0,8), pw1[1]=PKW(P0,10), pw1); \
    VRD(5); SBAR(); GAPA(C1=__builtin_amdgcn_mfma_f32_32x32x16_bf16(kf[3],qr[1],C1,0,0,0),   P0[14],P0[15],P1[0],P1[1],   pw1[2]=PKW(P0,12),pw1[3]=PKW(P0,14), pw1); \
    VRD(2); SBAR(); GAPA(C0=__builtin_amdgcn_mfma_f32_32x32x16_bf16(kf[4],qr[2],C0,0,0,0),   P1[2],P1[3],P1[4],P1[5],     pw2[0]=PKW(P1,0), pw2[1]=PKW(P1,2), pw2); \
    VRD(6); SBAR(); GAPA(C1=__builtin_amdgcn_mfma_f32_32x32x16_bf16(kf[5],qr[2],C1,0,0,0),   P1[6],P1[7],P1[8],P1[9],     pw2[2]=PKW(P1,4), pw2[3]=PKW(P1,6), pw2); \
    VRD(3); SBAR(); GAPA(C0=__builtin_amdgcn_mfma_f32_32x32x16_bf16(kf[6],qr[3],C0,0,0,0),   P1[10],P1[11],P1[12],P1[13], pw3[0]=PKW(P1,8), pw3[1]=PKW(P1,10), pw3); \
    VRD(7); SBAR(); GAPA(C1=__builtin_amdgcn_mfma_f32_32x32x16_bf16(kf[7],qr[3],C1,0,0,0),   P1[14],P1[15],0.f,0.f,       pw3[2]=PKW(P1,12),pw3[3]=PKW(P1,14), pw3); \
    l_reg+=SACC_SUM(sacc); \
    if(GK){DMA_K((t)+3,sl_cur);} if(GV){DMA_V((t)+1,sl_next);} \
    CMASK(C0,C1,t); \
    { float a=MX3(C0[0],C0[1],C1[0]),b=MX3(C0[2],C0[3],C1[1]); a=MX3(a,C1[2],C1[3]); \
      _Pragma("unroll") for(int r=4;r<16;r+=4){a=MX3(a,C0[r],C0[r+1]);b=MX3(b,C0[r+2],C0[r+3]);a=MX3(a,C1[r],C1[r+1]);b=MX3(b,C1[r+2],C1[r+3]);} \
      float rm=__builtin_fmaxf(a,b); { auto rr=__builtin_amdgcn_permlane32_swap(__float_as_uint(rm),__float_as_uint(rm),false,false); rm=__builtin_fmaxf(__uint_as_float(rr[0]),__uint_as_float(rr[1])); } \
      resc=false; \
      if(__builtin_expect(__any(rm>(float)THRL),0)){ const float dl=__builtin_fmaxf(rm,0.f); mhat+=dl; \
        _Pragma("unroll") for(int r=0;r<16;++r){C0[r]-=dl;C1[r]-=dl;} \
        const float f=__builtin_amdgcn_exp2f(-dl); l_reg*=f; if(hi==0)wsf[r32]=f; resc=true; } } \
    SBAR(); \
    KBNEXT_LOAD(GL,t); \
    GAPB(o[0]=__builtin_amdgcn_mfma_f32_32x32x16_bf16(PAF(0),VFR(0),o[0],0,0,0), C0,0); \
    GAPB(o[1]=__builtin_amdgcn_mfma_f32_32x32x16_bf16(PAF(0),VFR(4),o[1],0,0,0), C0,4); \
    KRD(GL,0); GAPB(o[0]=__builtin_amdgcn_mfma_f32_32x32x16_bf16(PAF(1),VFR(1),o[0],0,0,0), C0,8); \
    KRD(GL,1); GAPB(o[1]=__builtin_amdgcn_mfma_f32_32x32x16_bf16(PAF(1),VFR(5),o[1],0,0,0), C0,12); \
    KRD(GL,2); GAPB(o[0]=__builtin_amdgcn_mfma_f32_32x32x16_bf16(PAF(2),VFR(2),o[0],0,0,0), C1,0); \
    KRD(GL,3); GAPB(o[1]=__builtin_amdgcn_mfma_f32_32x32x16_bf16(PAF(2),VFR(6),o[1],0,0,0), C1,4); \
    GAPB(o[0]=__builtin_amdgcn_mfma_f32_32x32x16_bf16(PAF(3),VFR(3),o[0],0,0,0), C1,8); \
    GAPB(o[1]=__builtin_amdgcn_mfma_f32_32x32x16_bf16(PAF(3),VFR(7),o[1],0,0,0), C1,12); \
    KBNEXT_ADD(GL,P0,P1); \
    }while(0)
  int t=1;
  #undef CMASK
  #define CMASK(P0,P1,t) do{}while(0)
#if ATT_GUEST
  bool gpend=false; int grow=0; const unsigned gdst=(unsigned)__builtin_amdgcn_readfirstlane(lds0+LDS_GW+wid*GW_STRIDE);
#endif
  for(;t+5<NT;t+=2){
#if ATT_GUEST
    if(gpend){ guest_finish(G,grow,shm,wid,lane); gpend=false; SBAR(); }
    if(G.k<G.n){ grow=G.row0+G.k; ++G.k; if(grow<BATCH*SEQ){ asm volatile("s_waitcnt lgkmcnt(0)":::"memory"); guest_issue(G,grow,gdst,lane); gpend=true; } SBAR(); }
#endif
    STEP(pB0,pB1,pA0,pA1,t,true,true,true);     WAIT_BAR(2); RESC(); ROT();
    STEP(pA0,pA1,pB0,pB1,t+1,true,true,true);   WAIT_BAR(2); RESC(); ROT();
  }
#if ATT_GUEST
  if(gpend){ guest_finish(G,grow,shm,wid,lane); gpend=false; SBAR(); }
#endif
  #undef CMASK
  #define CMASK(P0,P1,t) do{int jb_=(t)-(NT-4); if(jb_>=0)cmask(P0,P1,jb_,qrel,hi);}while(0)
  #define ENDW(tt) do{ if((tt)+3<NT){WAIT_BAR(2);} else if((tt)+2<NT){WAIT_BAR(1);} else {WAIT_BAR(0);} }while(0)
  for(;t+1<NT;t+=2){
    STEP(pB0,pB1,pA0,pA1,t,(t+3<NT),(t+1<NT),(t+1<NT));       ENDW(t);   RESC(); ROT();
    STEP(pA0,pA1,pB0,pB1,t+1,(t+4<NT),(t+2<NT),(t+2<NT));     ENDW(t+1); RESC(); ROT();
  }
  STEP(pB0,pB1,pA0,pA1,NT-1,false,false,false); RESC();
  { float sacc=pB0[0]+pB0[1]; _Pragma("unroll") for(int r=2;r<16;++r)sacc+=pB0[r]; _Pragma("unroll") for(int r=0;r<16;++r)sacc+=pB1[r]; l_reg+=sacc;
    pw0=(u32x4){PKW(pB0,0),PKW(pB0,2),PKW(pB0,4),PKW(pB0,6)};pw1=(u32x4){PKW(pB0,8),PKW(pB0,10),PKW(pB0,12),PKW(pB0,14)};pw2=(u32x4){PKW(pB1,0),PKW(pB1,2),PKW(pB1,4),PKW(pB1,6)};pw3=(u32x4){PKW(pB1,8),PKW(pB1,10),PKW(pB1,12),PKW(pB1,14)};
    SBAR(); pv(o,vb0+sl_cur,PAF(0),PAF(1),PAF(2),PAF(3)); }
#if ATT_PRE
  asm volatile("s_waitcnt lgkmcnt(0)\n\ts_barrier":::"memory");
  if(pre_next){DMA_K(0,0);DMA_V(0,0);DMA_K(1,SLOTB);
    const bf16*Qn=Q+(rowbase+(long)qb_next*QB+wid*QBLK)*DM+h*D;
    #pragma unroll
    for(int d0=0;d0<4;++d0)qr[d0]=*reinterpret_cast<const bf16x8*>(&Qn[(long)r32*DM+d0*16+hi*8]); }
#endif
  #undef PKW
  #undef PAF
  #undef VFR
  #undef PIN
  #undef MX3
  #undef GAPA
  #undef GAPB
  #undef EX
  #undef VRD
  #undef KRD
  #undef STEP
  #undef ENDW
  {auto rr=__builtin_amdgcn_permlane32_swap(__float_as_uint(l_reg),__float_as_uint(l_reg),false,false);l_reg=__uint_as_float(rr[0])+__uint_as_float(rr[1]);}
  if(hi==0)wsf[32+r32]=l_reg;asm volatile("s_waitcnt lgkmcnt(0)":::"memory");
  float rli[16];
  #pragma unroll
  for(int r=0;r<16;++r)rli[r]=__builtin_amdgcn_rcpf(wsf[32+crow(r,hi)]);
  bf16*Ow=O+(rowbase+q0+wid*QBLK)*DM+h*D;
  { bf16*stg=(bf16*)(shm+LDS_OST)+wid*2048;
    #pragma unroll
    for(int r=0;r<16;++r){const int orow=crow(r,hi);
      #pragma unroll
      for(int d0=0;d0<2;++d0)stg[orow*64+d0*32+r32]=__float2bfloat16(o[d0][r]*rli[r]);}
    asm volatile("s_waitcnt lgkmcnt(0)":::"memory");
    #pragma unroll
    for(int i=0;i<4;++i){const int row=i*8+(lane>>3),ch=lane&7; const u32x4 v=*(const u32x4*)(stg+row*64+ch*8); ATTN_STORE16(Ow+(long)row*DM+ch*8,v);} }
#if ATT_PRE
  asm volatile("s_waitcnt lgkmcnt(0)":::"memory");
#else
  asm volatile("s_waitcnt lgkmcnt(0)\n\ts_barrier":::"memory");
#endif
  #undef DMA_K
  #undef DMA_V
  #undef CMASK
  #undef START
  #undef KBINIT
  #undef RESC
  #undef ROT
}
constexpr int ATTN_LDS_BYTES=LDS_BYTES_G; static_assert(LDS_BYTES_G<=131072,"attention scratch + guest buffers must fit the phase ring");
struct AttnTensors { const bf16* Q; const bf16* K; const bf16* V; bf16* O; const float* F; };
struct AttnUnit { int bh; int qb; };
struct StaticOrder {
  int v,G;
  __device__ __forceinline__ explicit StaticOrder(int grid,int block):v(block),G(grid){}
  __device__ __forceinline__ bool next(int i,AttnUnit&u)const{ const int L=(i>>3)*G+v; if(L>=BATCH*NHEAD)return false; u.bh=L; u.qb=7-(i&7); return true; }
  __device__ __forceinline__ void a_ready(const AttnUnit&)const{}
  __device__ __forceinline__ void done(const AttnUnit&)const{}
};
template<class Sched,int THRL=8> __device__ __forceinline__ void attn_phase(char*lds,const AttnTensors&T,const Sched&S,Guest&G){
  AttnUnit u;
  int bh_prev=-1;
  bool pre=false; bf16x8 qr[4];
  for(int i=0;S.next(i,u);++i){ AttnUnit un; un.qb=0; const bool pn=ATT_PRE&&S.next(i+1,un)&&un.bh==u.bh;
    S.a_ready(u); attn_unit<THRL>(u.bh/NHEAD,u.bh%NHEAD,u.qb,T.Q,T.K,T.V,T.O,T.F+(long)u.bh*SEQ,u.bh!=bh_prev,lds,G,pre,pn,un.qb,qr); bh_prev=u.bh; pre=pn; S.done(u); }
}
#undef SBAR
#undef WAIT_BAR
}

constexpr int NWAVES = 8;
constexpr int NB = 16, SEQ = 2048, NT = NB * SEQ, D = 1024, DEPTH = 2, INW = 13352;
constexpr int NPN_IN = 52, NIN_ROWS = 52 * 256 + 64;
constexpr float RMS_EPS = 1e-6f;
constexpr int MAXTILES = 320;
constexpr int PROWS = MAXTILES * 256;

constexpr size_t MiB = (size_t)1 << 20;
constexpr size_t WS_CTL = 0, CTL_ZERO_BYTES = 1 * MiB;
constexpr size_t WS_WIN = 1 * MiB;
constexpr size_t WS_WBR = 28 * MiB;
constexpr size_t WS_WOUT = 34 * MiB;
constexpr size_t WS_WRT = 36 * MiB;
constexpr size_t WS_ROUTE = 37 * MiB;
constexpr size_t WS_ROWTOK = 36 * MiB + 512 * 1024;
constexpr size_t WS_FB = 38 * MiB;
constexpr size_t WS_SSQS = 40 * MiB;
constexpr size_t WS_SSQM = 42 * MiB;
constexpr size_t WS_SMALL = 44 * MiB;
constexpr size_t WS_WGU = 52 * MiB;
constexpr size_t WS_WDN = 180 * MiB;
constexpr size_t WS_H = 244 * MiB;
constexpr size_t WS_YATT = 308 * MiB, WS_YSSD = 372 * MiB, WS_YML = 436 * MiB;
constexpr size_t WS_PROJ = 500 * MiB;
constexpr size_t WS_RAWH = 756 * MiB;
constexpr size_t WS_XSSD = 772 * MiB;
constexpr size_t WS_RAWH2 = 836 * MiB;
constexpr size_t WS_END = 852 * MiB;
constexpr size_t WS_HG = WS_PROJ, WS_ACT = WS_PROJ + 160 * MiB;
static_assert((size_t)PROWS * 1024 * 2 == 160 * MiB && WS_ACT + (size_t)PROWS * 512 * 2 <= WS_END, "moe overlay");
constexpr int CW_TMO = 0, CW_CODE = 1, CW_BAR = 4096, CW_CNT = 16384, CW_WG = 65536;

constexpr int RING_OFF = 0, RING_BYTES = 131072;
constexpr int LDSCTL_OFF = RING_BYTES, MISC_OFF = LDSCTL_OFF + 320, TAB_OFF = LDSCTL_OFF + 1024;
constexpr int LDS_BYTES = 147456;

#define GAS __attribute__((address_space(1)))
#define LAS __attribute__((address_space(3)))
typedef unsigned short bf16;
typedef unsigned v4u __attribute__((ext_vector_type(4)));
typedef unsigned v2u __attribute__((ext_vector_type(2)));
typedef float f32x4 __attribute__((ext_vector_type(4)));
typedef GAS unsigned gu32;
#define RLX_AGENT __ATOMIC_RELAXED, __HIP_MEMORY_SCOPE_AGENT
#define LDS_WAIT() asm volatile("s_waitcnt lgkmcnt(0)" ::: "memory")
__device__ __forceinline__ unsigned pk2(float lo, float hi) { return pg8::cvt_pk_bf16(lo, hi); }
__device__ __forceinline__ unsigned f2bf(float f) { return pg8::cvt_pk_bf16(f, f) & 0xffffu; }
__device__ __forceinline__ float bf2f(unsigned short u) { return __builtin_bit_cast(float, (unsigned)u << 16); }
__device__ __forceinline__ float blo(unsigned w) { return __builtin_bit_cast(float, w << 16); }
__device__ __forceinline__ float bhi(unsigned w) { return __builtin_bit_cast(float, w & 0xffff0000u); }
__device__ __forceinline__ float sigmoid_f(float x) { return 1.0f / (1.0f + expf(-x)); }
__device__ __forceinline__ float silu_f(float x) { return x / (1.0f + expf(-x)); }
__device__ __forceinline__ float logsigmoid_f(float x) { return fminf(x, 0.f) - log1pf(expf(-fabsf(x))); }
__device__ __forceinline__ float softplus_f(float x) { return fmaxf(x, 0.f) + log1pf(expf(-fabsf(x))); }
__device__ __forceinline__ float wave_sum(float v) {
#pragma unroll
    for (int o = 1; o < 64; o <<= 1) v += __shfl_xor(v, o);
    return v;
}
#define XB_TMO      128
#define XB_XCNT(j)  (256  + 64 * (j))
#define XB_XSUB(j)  (1280 + 64 * (j))
#define XB_XGEN(j)  (2304 + 64 * (j))
#define XB_TOP      3328
#define XB_TOPGEN   3392
#define XCD_BAR_WORDS 3456
#define XB_SPIN_CAP (1u << 20)

__device__ __forceinline__ unsigned xb_ld(unsigned* p)              { return __hip_atomic_load(p, __ATOMIC_RELAXED, __HIP_MEMORY_SCOPE_AGENT); }
__device__ __forceinline__ unsigned xb_add(unsigned* p, unsigned v) { return __hip_atomic_fetch_add(p, v, __ATOMIC_RELAXED, __HIP_MEMORY_SCOPE_AGENT); }
__device__ __forceinline__ unsigned xb_xcc_id() { return (unsigned)__builtin_amdgcn_s_getreg((3 << 11) | 20) & 0xFu; }
#define XB_SPIN(cond, bar) do { unsigned _sp = 0; while (cond) { __builtin_amdgcn_s_sleep(1); \
    if ((++_sp & 255u) == 0u) { if (xb_ld(&(bar)[XB_TMO])) break; if (_sp > XB_SPIN_CAP) { atomicAdd(&(bar)[XB_TMO], 1u); break; } } } } while (0)

struct XcdBarrier {
    unsigned* bar; unsigned x;
    volatile LAS unsigned* st;
};

__device__ __forceinline__ XcdBarrier xcd_barrier_post(unsigned* bar, volatile LAS unsigned* st) {
    XcdBarrier b; b.bar = bar; b.x = xb_xcc_id(); b.st = st;
    if (threadIdx.x == 0) (void)xb_add(&bar[XB_XCNT(b.x)], 1u);
    return b;
}
__device__ __forceinline__ void xcd_barrier_complete(unsigned* bar, unsigned x, unsigned& nloc, unsigned& nx) {
    const unsigned G = gridDim.x * gridDim.y * gridDim.z;
    unsigned sum, cnt, mine, sp = 0u;
    for (;;) {
        sum = 0u; cnt = 0u; mine = 0u;
#pragma nounroll
        for (unsigned j = 0; j < 16; ++j) { const unsigned c = xb_ld(&bar[XB_XCNT(j)]); sum += c; cnt += (c > 0u) ? 1u : 0u; mine = (j == x) ? c : mine; }
        if (sum == G) break;
        __builtin_amdgcn_s_sleep(1);
        if ((++sp & 255u) == 0u) { if (xb_ld(&bar[XB_TMO])) break; if (sp > XB_SPIN_CAP) { atomicAdd(&bar[XB_TMO], 1u); break; } }
    }
    nloc = mine > 0u ? mine : 1u; nx = cnt > 0u ? cnt : 1u;
}

__device__ __forceinline__ void xcd_barrier(const XcdBarrier& b) {
    asm volatile("s_waitcnt vmcnt(0)" ::: "memory");
    __syncthreads();
    if (threadIdx.x == 0) {
        unsigned* bar = b.bar;
        __builtin_amdgcn_s_waitcnt(0);
        unsigned nloc = b.st[0], nx = b.st[1];
        if (nloc == 0u) { xcd_barrier_complete(bar, b.x, nloc, nx); b.st[0] = nloc; b.st[1] = nx; }
        const unsigned old = xb_add(&bar[XB_XSUB(b.x)], 1u);
        const unsigned gen = old / nloc;
        if (old + 1u == (gen + 1u) * nloc) {
            __builtin_amdgcn_fence(__ATOMIC_RELEASE, "agent");
            asm volatile("s_waitcnt vmcnt(0)" ::: "memory");
            const unsigned og = xb_add(&bar[XB_TOP], 1u);
            const unsigned tg = og / nx;
            if (og + 1u == (tg + 1u) * nx) xb_add(&bar[XB_TOPGEN], 1u);
            else XB_SPIN(xb_ld(&bar[XB_TOPGEN]) == tg, bar);
            __builtin_amdgcn_fence(__ATOMIC_ACQUIRE, "agent");
            xb_add(&bar[XB_XGEN(b.x)], 1u);
            asm volatile("s_waitcnt vmcnt(0)" ::: "memory");
        } else {
            XB_SPIN(xb_ld(&bar[XB_XGEN(b.x)]) == gen, bar);
            __builtin_amdgcn_fence(__ATOMIC_ACQUIRE, "agent");
            asm volatile("s_waitcnt vmcnt(0)" ::: "memory");
        }
    }
    __syncthreads();
}


struct Args { const float* in[27]; float* out; unsigned char* ws; int ph_lo, ph_hi; };
typedef const __attribute__((address_space(4))) Args* KArgs;
__device__ __forceinline__ KArgs kargs() { KArgs p = (KArgs)__builtin_amdgcn_kernarg_segment_ptr(); asm volatile("" : "+s"(p)); return p; }
struct Frame {
    LAS unsigned char* lds;
    volatile LAS unsigned* MISC;
    gu32* ctl;
    int tid, lane, wave, G, bid;
    unsigned char* ws; float* out;
};
enum { I_X = 0, I_N1W, I_WIN, I_AFB, I_SCW, I_SCB, I_SDTB, I_SALOG, I_SD, I_SNW, I_MCW, I_MCB, I_MIB, I_MFB, I_MNW, I_GB, I_WBR, I_WOUT, I_N2W, I_WG, I_BG, I_WER, I_BER, I_WGATE, I_WUP, I_WDOWN, I_FNW };

__device__ __forceinline__ int incol(int n) {
    if (n < 1024) return 6176 + n;
    if (n < 2048) return 7200 + (n - 1024);
    if (n < 3072) return 8224 + (n - 2048);
    if (n < 4096) return 9256 + (n - 3072);
    if (n < 7168) return n - 4096;
    if (n < 10240) return 3088 + (n - 7168);
    if (n < 13312) return 10280 + (n - 10240);
    const int j = n - 13312;
    if (j < 16) return 3072 + j; if (j < 32) return 6160 + (j - 16); if (j < 36) return 9248 + (j - 32); if (j < 40) return 9252 + (j - 36); return -1;
}
__device__ __forceinline__ void tr_item(const float* cp, int ld, int K, bf16* WT, int n0, int k0, LAS float* scr, int lane, const float* ksc = nullptr) {
    float tv[32];
#pragma unroll
    for (int i = 0; i < 32; ++i) { const int kk = 2 * i + (lane >> 5); tv[i] = cp ? NT_LOAD(cp + (size_t)(k0 + kk) * ld) : 0.f; if (ksc) tv[i] *= ksc[k0 + kk]; }
#pragma unroll
    for (int i = 0; i < 32; ++i) { const int kk = 2 * i + (lane >> 5); scr[kk * 33 + (lane & 31)] = tv[i]; }
    LDS_WAIT(); asm volatile("" ::: "memory");
    const int c = lane & 7;
#pragma unroll
    for (int j = 0; j < 4; ++j) { const int n = (lane >> 3) + 8 * j; const LAS float* s = scr + (8 * c) * 33 + n;
        v4u o; o.x = pk2(s[0 * 33], s[1 * 33]); o.y = pk2(s[2 * 33], s[3 * 33]); o.z = pk2(s[4 * 33], s[5 * 33]); o.w = pk2(s[6 * 33], s[7 * 33]);
        *(GAS v4u*)(WT + (size_t)(n0 + n) * K + k0 + 8 * c) = o; }
    LDS_WAIT(); asm volatile("" ::: "memory");
}
__device__ __forceinline__ void p_convert(Frame& F, KArgs A, int L) {
    LAS float* scr = (LAS float*)(F.lds + RING_OFF + F.wave * 16384);
    const int gw = F.bid * NWAVES + F.wave, NGW = F.G * NWAVES, lane = F.lane;
    constexpr int NBI = NIN_ROWS / 32, I_IN = 16 * NBI, I_BR = 3 * 512, I_OUT = 512, I_GU = 64 * 512, I_DN = 64 * 256;
    const int NITEMS = (USE_GUEST_CVT && F.G == 256) ? I_IN + I_BR + I_OUT : I_IN + I_BR + I_OUT + I_GU + I_DN;
    const float* w_in = A->in[I_WIN] + (size_t)L * 1024 * INW;
    for (int it = gw; it < NITEMS; it += NGW) {
        int r = it;
        if (r < I_IN) { const int kb = r / NBI, nb = r % NBI; const int c = incol(nb * 32 + (lane & 31));
            tr_item(c < 0 ? nullptr : w_in + c, INW, 1024, (bf16*)(F.ws + WS_WIN), nb * 32, kb * 64, scr, lane); continue; }
        r -= I_IN;
        if (r < I_BR) { const int b = r / 512, rr = r % 512, kb = rr / 32, nb = rr % 32;
            tr_item(A->in[I_WBR] + (size_t)(L * 3 + b) * 1048576 + nb * 32 + (lane & 31), 1024, 1024, (bf16*)(F.ws + WS_WBR) + (size_t)b * 1048576, nb * 32, kb * 64, scr, lane,
                    (FIX_PURE && b == 1) ? A->in[I_SNW] + (size_t)L * D : (FIX_PURE && b == 2) ? A->in[I_MNW] + (size_t)L * D : nullptr); continue; }
        r -= I_BR;
        if (r < I_OUT) { const int kb = r / 32, nb = r % 32;
            tr_item(A->in[I_WOUT] + (size_t)L * 1048576 + nb * 32 + (lane & 31), 1024, 1024, (bf16*)(F.ws + WS_WOUT), nb * 32, kb * 64, scr, lane); continue; }
        r -= I_OUT;
        if (r < I_GU) { const int e = r / 512, rr = r % 512, kb = rr / 32, nb = rr % 32; const int n = nb * 32 + (lane & 31), q = n >> 3, i = n & 7;
            const float* src = ((i < 4) ? A->in[I_WGATE] : A->in[I_WUP]) + (size_t)(L * 64 + e) * 524288 + 4 * q + (i & 3);
            tr_item(src, 512, 1024, (bf16*)(F.ws + WS_WGU) + (size_t)e * 1048576, nb * 32, kb * 64, scr, lane); continue; }
        r -= I_GU;
        { const int e = r / 256, rr = r % 256, kb = rr / 32, nb = rr % 32;
            tr_item(A->in[I_WDOWN] + (size_t)(L * 64 + e) * 524288 + nb * 32 + (lane & 31), 1024, 512, (bf16*)(F.ws + WS_WDN) + (size_t)e * 524288, nb * 32, kb * 64, scr, lane); }
    }
    bf16* wrh = (bf16*)(F.ws + WS_WRT); bf16* wrl = wrh + 80 * 1024;
    const float* wg = A->in[I_WG] + (size_t)L * 1024 * 8; const float* we = A->in[I_WER] + (size_t)L * 1024 * 64;
    for (int idx = F.bid * 512 + F.tid; idx < 80 * 1024; idx += F.G * 512) { const int c = idx >> 10, k = idx & 1023; const float v = (c < 8) ? wg[k * 8 + c] : (c < 72) ? we[k * 64 + (c - 8)] : 0.f;
        const unsigned hi = f2bf(v); wrh[idx] = (bf16)hi; wrl[idx] = (bf16)f2bf(v - bf2f((unsigned short)hi)); }
}

template <int COMBINE, int FINAL>
__device__ __forceinline__ void p_norm(Frame& F, const float* xin, float* X, const float* w, bf16* H) {
    const int gw = F.bid * NWAVES + F.wave, NGW = F.G * NWAVES, lane = F.lane;
    const int* tok_pos = (const int*)(F.ws + WS_ROUTE + 3 * 262144); const float* tok_w = (const float*)(F.ws + WS_ROUTE + 262144);
    const bf16* Y = (const bf16*)(F.ws + WS_HG);
    f32x4 wv[4];
#pragma unroll
    for (int j = 0; j < 4; ++j) wv[j] = ((const f32x4*)w)[lane + 64 * j];
    for (int m0 = 2 * gw; m0 < NT; m0 += 2 * NGW) {
        f32x4 v[2][4]; v2u ya[2][4], yb[2][4]; float w0[2], w1[2];
#pragma unroll
        for (int r = 0; r < 2; ++r) { const int m = m0 + r;
            const f32x4* xr = (const f32x4*)((COMBINE ? X : xin) + (size_t)m * D) + lane;
#pragma unroll
            for (int j = 0; j < 4; ++j) v[r][j] = NT_LOAD(xr + 64 * j);
            if (COMBINE) { const int p0 = tok_pos[2 * m], p1 = tok_pos[2 * m + 1]; w0[r] = tok_w[2 * m]; w1[r] = tok_w[2 * m + 1];
                const v2u* y0 = (const v2u*)(Y + (size_t)p0 * D) + lane; const v2u* y1 = (const v2u*)(Y + (size_t)p1 * D) + lane;
#pragma unroll
                for (int j = 0; j < 4; ++j) { ya[r][j] = NT_LOAD(y0 + 64 * j); yb[r][j] = NT_LOAD(y1 + 64 * j); } } }
#pragma unroll
        for (int r = 0; r < 2; ++r) { const int m = m0 + r;
            if (COMBINE) {
#pragma unroll
                for (int j = 0; j < 4; ++j) { const v2u a = ya[r][j], b = yb[r][j];
                    v[r][j].x += w0[r] * blo(a.x) + w1[r] * blo(b.x); v[r][j].y += w0[r] * bhi(a.x) + w1[r] * bhi(b.x); v[r][j].z += w0[r] * blo(a.y) + w1[r] * blo(b.y); v[r][j].w += w0[r] * bhi(a.y) + w1[r] * bhi(b.y); }
                if (!FINAL) { f32x4* xo = (f32x4*)(X + (size_t)m * D) + lane;
#pragma unroll
                    for (int j = 0; j < 4; ++j) NT_STORE(v[r][j], xo + 64 * j); }
            }
            float s = 0.f;
#pragma unroll
            for (int j = 0; j < 4; ++j) s += (v[r][j].x * v[r][j].x + v[r][j].y * v[r][j].y) + (v[r][j].z * v[r][j].z + v[r][j].w * v[r][j].w);
            const float rstd = 1.0f / sqrtf(wave_sum(s) * (1.f / D) + RMS_EPS);
            if (FINAL) { f32x4* xo = (f32x4*)(X + (size_t)m * D) + lane;
#pragma unroll
                for (int j = 0; j < 4; ++j) NT_STORE(v[r][j] * rstd * wv[j], xo + 64 * j);
            } else { GAS unsigned long long* o8 = (GAS unsigned long long*)(H + (size_t)m * D) + lane;
#pragma unroll
                for (int j = 0; j < 4; ++j) { const f32x4 y = v[r][j] * rstd * wv[j]; o8[64 * j] = (unsigned long long)pk2(y.x, y.y) | ((unsigned long long)pk2(y.z, y.w) << 32); } }
        }
    }
}

__device__ __forceinline__ void p_small(Frame& F) {
    typedef short bf16x8 __attribute__((ext_vector_type(8)));
    const int gw = F.bid * NWAVES + F.wave, NGW = F.G * NWAVES, lane = F.lane, r = lane & 15, g = lane >> 4;
    const bf16* H = (const bf16*)(F.ws + WS_H); const bf16* W = (const bf16*)(F.ws + WS_WIN) + (size_t)(NPN_IN * 256) * 1024; float* SM = (float*)(F.ws + WS_SMALL);
    for (int task = gw; task < NT / 16; task += NGW) {
        const int m0 = task * 16;
        const bf16x8* ap = (const bf16x8*)(H + (size_t)(m0 + r) * D + 8 * g);
        const bf16x8* bp0 = (const bf16x8*)(W + (size_t)(r) * D + 8 * g); const bf16x8* bp1 = (const bf16x8*)(W + (size_t)(16 + r) * D + 8 * g); const bf16x8* bp2 = (const bf16x8*)(W + (size_t)(32 + r) * D + 8 * g);
        f32x4 c0 = (f32x4){0.f, 0.f, 0.f, 0.f}, c1 = c0, c2 = c0;
#pragma unroll 8
        for (int ks = 0; ks < 32; ++ks) { const bf16x8 a = ap[ks * 4], b0 = bp0[ks * 4], b1 = bp1[ks * 4], b2 = bp2[ks * 4];
            c0 = __builtin_amdgcn_mfma_f32_16x16x32_bf16(a, b0, c0, 0, 0, 0); c1 = __builtin_amdgcn_mfma_f32_16x16x32_bf16(a, b1, c1, 0, 0, 0); c2 = __builtin_amdgcn_mfma_f32_16x16x32_bf16(a, b2, c2, 0, 0, 0); }
#pragma unroll
        for (int i = 0; i < 4; ++i) { float* o = SM + (size_t)(m0 + 4 * g + i) * 64 + r; o[0] = c0[i]; o[16] = c1[i]; o[32] = c2[i]; }
    }
}

__device__ __forceinline__ void p_fcum(Frame& F, KArgs A, int L) {
    LAS float* wt = (LAS float*)(F.lds + RING_OFF);
    const int lane = F.lane, t = F.tid, w = F.wave;
    for (int bh = F.bid; bh < NB * 16; bh += F.G) {
        const int b = bh >> 4, h = bh & 15; const float fb = A->in[I_AFB][L * 16 + h];
        const float* sm = (const float*)(F.ws + WS_SMALL) + (size_t)b * SEQ * 64 + h;
        float* out = (float*)(F.ws + WS_FB) + (size_t)bh * SEQ;
        float v[4]; float tot = 0.f;
#pragma unroll
        for (int i = 0; i < 4; ++i) v[i] = sm[(size_t)(t * 4 + i) * 64];
#pragma unroll
        for (int i = 0; i < 4; ++i) { v[i] = logsigmoid_f(v[i] + fb); tot += v[i]; }
        float inc = tot;
#pragma unroll
        for (int o = 1; o < 64; o <<= 1) { const float u = __shfl_up(inc, o); if (lane >= o) inc += u; }
        if (lane == 63) wt[w] = inc;
        __syncthreads();
        float run = inc - tot;
#pragma unroll
        for (int j = 0; j < NWAVES; ++j) run += (j < w) ? wt[j] : 0.f;
        f32x4 o4; run += v[0]; o4.x = run; run += v[1]; o4.y = run; run += v[2]; o4.z = run; run += v[3]; o4.w = run; *(f32x4*)(out + t * 4) = o4;
        __syncthreads();
    }
}

__device__ __forceinline__ void att_simple_unit(Frame& F, int b, int h, int qb) {
    LAS float* sK = (LAS float*)(F.lds + RING_OFF); LAS float* sV = sK + 4096; LAS float* sF = sV + 4096;
    const bf16* Q = (const bf16*)(F.ws + WS_PROJ); const bf16* K = (const bf16*)(F.ws + WS_PROJ + pg8::SLAB); const bf16* V = (const bf16*)(F.ws + WS_PROJ + 2 * pg8::SLAB);
    const float* FB = (const float*)(F.ws + WS_FB) + (size_t)(b * 16 + h) * SEQ;
    bf16* O = (bf16*)(F.ws + WS_YATT);
    const int tid = F.tid, t = qb * 512 + tid; const size_t row = (size_t)b * SEQ + t;
    float q[64], o[64];
    { const v4u* qp = (const v4u*)(Q + row * D + h * 64);
#pragma unroll
      for (int i = 0; i < 8; ++i) { const v4u w = qp[i]; q[8 * i + 0] = blo(w.x) * 0.125f; q[8 * i + 1] = bhi(w.x) * 0.125f; q[8 * i + 2] = blo(w.y) * 0.125f; q[8 * i + 3] = bhi(w.y) * 0.125f;
          q[8 * i + 4] = blo(w.z) * 0.125f; q[8 * i + 5] = bhi(w.z) * 0.125f; q[8 * i + 6] = blo(w.w) * 0.125f; q[8 * i + 7] = bhi(w.w) * 0.125f; } }
#pragma unroll
    for (int d = 0; d < 64; ++d) o[d] = 0.f;
    const float Fq = FB[t]; float mrun = -INFINITY, l = 0.f;
    const int ntile = (qb * 512 + 512) / 64;
    const int key = tid >> 3, dc = (tid & 7) * 8;
    for (int kt = 0; kt < ntile; ++kt) {
        __syncthreads();
        { const size_t kr = ((size_t)b * SEQ + kt * 64 + key) * D + h * 64 + dc; const v4u kw = *(const v4u*)(K + kr), vw = *(const v4u*)(V + kr);
          LAS float* kd = sK + key * 64 + dc; LAS float* vd = sV + key * 64 + dc;
          kd[0] = blo(kw.x); kd[1] = bhi(kw.x); kd[2] = blo(kw.y); kd[3] = bhi(kw.y); kd[4] = blo(kw.z); kd[5] = bhi(kw.z); kd[6] = blo(kw.w); kd[7] = bhi(kw.w);
          vd[0] = blo(vw.x); vd[1] = bhi(vw.x); vd[2] = blo(vw.y); vd[3] = bhi(vw.y); vd[4] = blo(vw.z); vd[5] = bhi(vw.z); vd[6] = blo(vw.w); vd[7] = bhi(vw.w);
          if (tid < 64) sF[tid] = FB[kt * 64 + tid]; }
        __syncthreads();
        for (int j = 0; j < 64; ++j) {
            const int pos = kt * 64 + j;
            if (pos <= t) {
                float s = Fq - sF[j];
                const LAS f32x4* kp = (const LAS f32x4*)(sK + j * 64);
#pragma unroll
                for (int d4 = 0; d4 < 16; ++d4) { const f32x4 kv = kp[d4]; s += q[4 * d4] * kv.x + q[4 * d4 + 1] * kv.y + q[4 * d4 + 2] * kv.z + q[4 * d4 + 3] * kv.w; }
                const float mn = fmaxf(mrun, s), corr = __expf(mrun - mn), p = __expf(s - mn);
                l = l * corr + p; mrun = mn;
                const LAS f32x4* vp = (const LAS f32x4*)(sV + j * 64);
#pragma unroll
                for (int d4 = 0; d4 < 16; ++d4) { const f32x4 vv = vp[d4]; o[4 * d4] = o[4 * d4] * corr + p * vv.x; o[4 * d4 + 1] = o[4 * d4 + 1] * corr + p * vv.y; o[4 * d4 + 2] = o[4 * d4 + 2] * corr + p * vv.z; o[4 * d4 + 3] = o[4 * d4 + 3] * corr + p * vv.w; }
            }
        }
    }
    const float rl = 1.0f / l;
    v4u* op = (v4u*)(O + row * D + h * 64);
#pragma unroll
    for (int i = 0; i < 8; ++i) { v4u w; w.x = pk2(o[8 * i] * rl, o[8 * i + 1] * rl); w.y = pk2(o[8 * i + 2] * rl, o[8 * i + 3] * rl); w.z = pk2(o[8 * i + 4] * rl, o[8 * i + 5] * rl); w.w = pk2(o[8 * i + 6] * rl, o[8 * i + 7] * rl); op[i] = w; }
}
__device__ __forceinline__ void p_att_simple(Frame& F) {
    for (int u = F.bid; u < 1024; u += F.G) { const int qb = 3 - (u >> 8), bh = u & 255; att_simple_unit(F, bh >> 4, bh & 15, qb); }
    __syncthreads();
}

__device__ __forceinline__ void ssd_simple_unit(Frame& F, KArgs A, int L, int b, int h) {
    constexpr int TB = 32;
    LAS float* cv = (LAS float*)(F.lds + RING_OFF);
    LAS float* sdt = cv + TB * 320; LAS float* sda = sdt + TB; LAS float* yb = sda + TB;
    const int tid = F.tid, g = h >> 2;
    const bf16* SZ = (const bf16*)(F.ws + WS_PROJ); const bf16* XBC = (const bf16*)(F.ws + WS_PROJ + pg8::SLAB) + (size_t)b * SEQ * 2048;
    const float* SM = (const float*)(F.ws + WS_SMALL) + (size_t)b * SEQ * 64;
    bf16* YO = (bf16*)(F.ws + WS_YSSD); float* SSQ = (float*)(F.ws + WS_SSQS);
    int ch = -1;
    if (tid < 64) ch = h * 64 + tid; else if (tid < 192) ch = 1024 + g * 128 + (tid - 64); else if (tid < 320) ch = 1536 + g * 128 + (tid - 192);
    float cw0 = 0.f, cw1 = 0.f, cw2 = 0.f, cw3 = 0.f, cb = 0.f;
    if (ch >= 0) { const float* cw = A->in[I_SCW] + (size_t)L * 4 * 2048 + ch; cw0 = cw[0]; cw1 = cw[2048]; cw2 = cw[4096]; cw3 = cw[6144]; cb = A->in[I_SCB][L * 2048 + ch]; }
    const float Aneg = -expf(A->in[I_SALOG][L * 16 + h]), dtb = A->in[I_SDTB][L * 16 + h], Dh = A->in[I_SD][L * 16 + h];
    float st[16];
#pragma unroll
    for (int j = 0; j < 16; ++j) st[j] = 0.f;
    const int p = tid >> 3, nq = tid & 7;
    float r0 = 0.f, r1 = 0.f, r2 = 0.f;
    for (int t0 = 0; t0 < SEQ; t0 += TB) {
        if (ch >= 0) {
#pragma unroll
            for (int s = 0; s < TB; ++s) { const float r3 = bf2f(XBC[(size_t)(t0 + s) * 2048 + ch]); const float y = cb + cw0 * r0 + cw1 * r1 + cw2 * r2 + cw3 * r3; cv[s * 320 + tid] = silu_f(y); r0 = r1; r1 = r2; r2 = r3; }
        } else if (tid < 320 + TB) { const int s = tid - 320; const float dt = softplus_f(SM[(size_t)(t0 + s) * 64 + 16 + h] + dtb); sdt[s] = dt; sda[s] = expf(dt * Aneg); }
        __syncthreads();
        for (int s = 0; s < TB; ++s) {
            const float xv = cv[s * 320 + p], dt = sdt[s], dA = sda[s], dx = dt * xv; float acc = 0.f;
#pragma unroll
            for (int j = 0; j < 16; ++j) { st[j] = st[j] * dA + dx * cv[s * 320 + 64 + nq * 16 + j]; acc += cv[s * 320 + 192 + nq * 16 + j] * st[j]; }
            acc += __shfl_xor(acc, 1); acc += __shfl_xor(acc, 2); acc += __shfl_xor(acc, 4);
            if (nq == 0) { const float z = bf2f(SZ[((size_t)b * SEQ + t0 + s) * D + h * 64 + p]); yb[s * 64 + p] = (acc + Dh * xv) * silu_f(z); }
        }
        __syncthreads();
        if (tid < TB) { float q = 0.f; for (int i = 0; i < 64; ++i) { const float y = yb[tid * 64 + i]; q += y * y; } SSQ[((size_t)b * SEQ + t0 + tid) * 16 + h] = q; }
        for (int i = tid; i < TB * 64; i += 512) { const int s = i >> 6, pp = i & 63; YO[((size_t)b * SEQ + t0 + s) * D + h * 64 + pp] = (bf16)f2bf(yb[i]); }
        __syncthreads();
    }
}
__device__ __forceinline__ void p_ssd_simple(Frame& F, KArgs A, int L) {
    for (int u = F.bid; u < NB * 16; u += F.G) ssd_simple_unit(F, A, L, u >> 4, u & 15);
}

__device__ __forceinline__ void ml_simple_unit(Frame& F, KArgs A, int L, int b, int h, int vs) {
    constexpr int TB = 16;
    LAS float* sq = (LAS float*)(F.lds + RING_OFF); LAS float* sk = sq + TB * 256; LAS float* sv = sk + TB * 256; LAS float* sg = sv + TB * 64;
    LAS float* red = sg + 2 * TB; LAS float* redd = red + 2 * 8 * 64; LAS float* hb = redd + 16;
    const int tid = F.tid, w = tid >> 6, v = tid & 63;
    const bf16* MQ = (const bf16*)(F.ws + WS_PROJ); const bf16* MK = (const bf16*)(F.ws + WS_PROJ + pg8::SLAB); const bf16* MV = (const bf16*)(F.ws + WS_PROJ + 2 * pg8::SLAB);
    const float* SM = (const float*)(F.ws + WS_SMALL) + (size_t)b * SEQ * 64;
    bf16* YO = (bf16*)(F.ws + WS_YML); float* SSQ = (float*)(F.ws + WS_SSQM);
    const bool isk = tid >= 256; const int cc = h * 256 + (tid & 255), cidx = (isk ? 1024 : 0) + cc;
    const bf16* src = (isk ? MK : MQ) + (size_t)b * SEQ * D + cc;
    const float* cw = A->in[I_MCW] + (size_t)L * 4 * 2048 + cidx; const float cw0 = cw[0], cw1 = cw[2048], cw2 = cw[4096], cw3 = cw[6144], cb = A->in[I_MCB][L * 2048 + cidx];
    const float ib = A->in[I_MIB][L * 4 + h], fbias = A->in[I_MFB][L * 4 + h];
    const float ksc = isk ? 0.0625f : 1.0f;
    float C[32], n[32];
#pragma unroll
    for (int j = 0; j < 32; ++j) { C[j] = 0.f; n[j] = 0.f; }
    float m = 0.f, r0 = 0.f, r1 = 0.f, r2 = 0.f;
    for (int t0 = 0; t0 < SEQ; t0 += TB) {
#pragma unroll
        for (int s = 0; s < TB; ++s) { const float r3 = bf2f(src[(size_t)(t0 + s) * D]); const float y = cb + cw0 * r0 + cw1 * r1 + cw2 * r2 + cw3 * r3; (isk ? sk : sq)[s * 256 + (tid & 255)] = silu_f(y) * ksc; r0 = r1; r1 = r2; r2 = r3; }
        for (int i = tid; i < TB * 64; i += 512) { const int s = i >> 6, j = i & 63; sv[i] = bf2f(MV[((size_t)b * SEQ + t0 + s) * D + h * 256 + vs * 64 + j]); }
        if (tid < TB) { const float* r = SM + (size_t)(t0 + tid) * 64; sg[2 * tid] = r[32 + h] + ib; sg[2 * tid + 1] = logsigmoid_f(r[36 + h] + fbias); }
        __syncthreads();
        for (int s = 0; s < TB; ++s) {
            const float ig = sg[2 * s], lf = sg[2 * s + 1]; const float mn = fmaxf(lf + m, ig); const float fs = expf(lf + m - mn), is = expf(ig - mn); m = mn;
            const float vv = sv[s * 64 + v]; float nump = 0.f, denp = 0.f;
#pragma unroll
            for (int j = 0; j < 32; ++j) { const float kd = sk[s * 256 + w * 32 + j] * is, qd = sq[s * 256 + w * 32 + j]; C[j] = fs * C[j] + kd * vv; nump += qd * C[j]; n[j] = fs * n[j] + kd; denp += qd * n[j]; }
            const int par = s & 1;
            red[(par * 8 + w) * 64 + v] = nump; if (v == 0) redd[par * 8 + w] = denp;
            __syncthreads();
            if (w == 0) { float num = 0.f, den = 0.f;
#pragma unroll
                for (int ww = 0; ww < 8; ++ww) { num += red[(par * 8 + ww) * 64 + v]; den += redd[par * 8 + ww]; }
                hb[s * 64 + v] = num / fmaxf(fabsf(den), expf(-m)); }
        }
        __syncthreads();
        if (tid < TB) { float q = 0.f; for (int i = 0; i < 64; ++i) { const float y = hb[tid * 64 + i]; q += y * y; } SSQ[((size_t)b * SEQ + t0 + tid) * 16 + h * 4 + vs] = q; }
        for (int i = tid; i < TB * 64; i += 512) { const int s = i >> 6, j = i & 63; YO[((size_t)b * SEQ + t0 + s) * D + h * 256 + vs * 64 + j] = (bf16)f2bf(hb[i]); }
        __syncthreads();
    }
}
__device__ __forceinline__ void p_ml_simple(Frame& F, KArgs A, int L) {
    for (int u = F.bid; u < NB * 16; u += F.G) ml_simple_unit(F, A, L, u >> 4, (u >> 2) & 3, u & 3);
}

template <int ML>
__device__ __forceinline__ void p_fix(Frame& F, KArgs A, int L) {
    const int gw = F.bid * NWAVES + F.wave, NGW = F.G * NWAVES, lane = F.lane;
    bf16* Y = (bf16*)(F.ws + (ML ? WS_YML : WS_XSSD)); const float* SSQ = (const float*)(F.ws + (ML ? WS_SSQM : WS_SSQS));
    const bf16* MO = (const bf16*)(F.ws + WS_PROJ + 3 * pg8::SLAB);
    const float* nw = A->in[ML ? I_MNW : I_SNW] + (size_t)L * D;
    f32x4 wv[2][2];
#pragma unroll
    for (int j = 0; j < 2; ++j) { wv[j][0] = *(const f32x4*)(nw + 8 * (lane + 64 * j)); wv[j][1] = *(const f32x4*)(nw + 8 * (lane + 64 * j) + 4); }
    for (int m0 = gw * 4; m0 < NT; m0 += NGW * 4) {
        v4u y[4][2], o[4][2]; float rs[4][2];
#pragma unroll
        for (int r = 0; r < 4; ++r)
#pragma unroll
            for (int j = 0; j < 2; ++j) { y[r][j] = NT_LOAD((const v4u*)(Y + (size_t)(m0 + r) * D + 8 * (lane + 64 * j))); if (ML && !FIX_PURE) o[r][j] = *(const v4u*)(MO + (size_t)(m0 + r) * D + 8 * (lane + 64 * j));
                const f32x4 q = *(const f32x4*)(SSQ + (size_t)(m0 + r) * 16 + 4 * ((lane >> 5) + 2 * j)); rs[r][j] = ((q.x + q.y) + (q.z + q.w)) * (1.f / 256.f) + RMS_EPS; }
#pragma unroll
        for (int r = 0; r < 4; ++r)
#pragma unroll
            for (int j = 0; j < 2; ++j) { const float rstd = 1.0f / sqrtf(rs[r][j]); const unsigned yw[4] = {y[r][j].x, y[r][j].y, y[r][j].z, y[r][j].w}; unsigned ow[4] = {0u, 0u, 0u, 0u}; if (ML && !FIX_PURE) { ow[0] = o[r][j].x; ow[1] = o[r][j].y; ow[2] = o[r][j].z; ow[3] = o[r][j].w; }
                unsigned res[4];
#pragma unroll
                for (int e = 0; e < 4; ++e) { const float w0 = (e < 2) ? wv[j][0][2 * e] : wv[j][1][2 * e - 4], w1 = (e < 2) ? wv[j][0][2 * e + 1] : wv[j][1][2 * e - 3];
                    float a = blo(yw[e]) * rstd * (FIX_PURE ? 1.f : w0), b2 = bhi(yw[e]) * rstd * (FIX_PURE ? 1.f : w1);
                    if (ML && !FIX_PURE) { a *= sigmoid_f(blo(ow[e])); b2 *= sigmoid_f(bhi(ow[e])); }
                    res[e] = pk2(a, b2); }
                v4u w; w.x = res[0]; w.y = res[1]; w.z = res[2]; w.w = res[3]; NT_STORE(w, (v4u*)(Y + (size_t)(m0 + r) * D + 8 * (lane + 64 * j))); }
    }
}

__device__ __forceinline__ void p_probe_copy(Frame& F, int k) {
    const int gw = F.bid * NWAVES + F.wave, NGW = F.G * NWAVES, lane = F.lane;
    const bf16* Y = (const bf16*)(F.ws + WS_WGU + (size_t)k * 64 * MiB); bf16* O = (bf16*)(F.ws + WS_END + (size_t)k * 64 * MiB);
    for (int m0 = gw * 4; m0 < NT; m0 += NGW * 4) {
        v4u y[4][2];
#pragma unroll
        for (int r = 0; r < 4; ++r)
#pragma unroll
            for (int j = 0; j < 2; ++j) y[r][j] = *(const v4u*)(Y + (size_t)(m0 + r) * D + 8 * (lane + 64 * j));
#pragma unroll
        for (int r = 0; r < 4; ++r)
#pragma unroll
            for (int j = 0; j < 2; ++j) *(v4u*)(O + (size_t)(m0 + r) * D + 8 * (lane + 64 * j)) = y[r][j];
    }
}
template <int ML>
__device__ __forceinline__ void p_fix_row(Frame& F, KArgs A, int L, int m) {
    const int lane = F.lane;
    bf16* Y = (bf16*)(F.ws + (ML ? WS_YML : WS_XSSD)); const float* SSQ = (const float*)(F.ws + (ML ? WS_SSQM : WS_SSQS));
    const bf16* MO = (const bf16*)(F.ws + WS_PROJ + 3 * pg8::SLAB);
    const float* nw = A->in[ML ? I_MNW : I_SNW] + (size_t)L * D;
#pragma unroll
    for (int j = 0; j < 2; ++j) { const v4u y = *(const v4u*)(Y + (size_t)m * D + 8 * (lane + 64 * j)); v4u o = (v4u){0u, 0u, 0u, 0u}; if (ML && !FIX_PURE) o = *(const v4u*)(MO + (size_t)m * D + 8 * (lane + 64 * j));
        const f32x4 q = *(const f32x4*)(SSQ + (size_t)m * 16 + 4 * ((lane >> 5) + 2 * j)); const float rstd = 1.0f / sqrtf(((q.x + q.y) + (q.z + q.w)) * (1.f / 256.f) + RMS_EPS);
        const f32x4 w0 = *(const f32x4*)(nw + 8 * (lane + 64 * j)), w1 = *(const f32x4*)(nw + 8 * (lane + 64 * j) + 4);
        const float wv[8] = {w0.x, w0.y, w0.z, w0.w, w1.x, w1.y, w1.z, w1.w}; const unsigned yw[4] = {y.x, y.y, y.z, y.w}, ow[4] = {o.x, o.y, o.z, o.w}; unsigned res[4];
#pragma unroll
        for (int e = 0; e < 4; ++e) { float a = blo(yw[e]) * rstd * (FIX_PURE ? 1.f : wv[2 * e]), b2 = bhi(yw[e]) * rstd * (FIX_PURE ? 1.f : wv[2 * e + 1]);
            if (ML && !FIX_PURE) { a *= sigmoid_f(blo(ow[e])); b2 *= sigmoid_f(bhi(ow[e])); }
            res[e] = pk2(a, b2); }
        v4u w; w.x = res[0]; w.y = res[1]; w.z = res[2]; w.w = res[3]; *(v4u*)(Y + (size_t)m * D + 8 * (lane + 64 * j)) = w; }
}

__device__ __forceinline__ void p_router(Frame& F, KArgs A, int L) {
    typedef short bf16x8 __attribute__((ext_vector_type(8)));
    const int gw = F.bid * NWAVES + F.wave, NGW = F.G * NWAVES, lane = F.lane, r = lane & 15, g = lane >> 4;
    const float* X = F.out; bf16* H = (bf16*)(F.ws + WS_H);
    const float* nw = A->in[I_N2W] + (size_t)L * D; const bf16* wrh = (const bf16*)(F.ws + WS_WRT); const bf16* wrl = wrh + 80 * 1024;
    const float* bg = A->in[I_BG] + L * 8; const float* ber = A->in[I_BER] + L * 64;
    int* tok_e = (int*)(F.ws + WS_ROUTE); float* tok_w = (float*)(F.ws + WS_ROUTE + 262144); int* tok_rank = (int*)(F.ws + WS_ROUTE + 2 * 262144);
    unsigned* cnt = (unsigned*)F.ctl + CW_CNT + 64 * L;
    LAS float* LG = (LAS float*)(F.lds + RING_OFF) + F.wave * (16 * 80);
    LAS int* lc = (LAS int*)(F.lds + RING_OFF + 49152); LAS int* lb = lc + 64;
    const bool two = ROUTER_2LVL && ((NT / 16) % NGW == 0);
    const bool three = ROUTER_NOATOM && two && (NT / 16 == NGW);
    int* cw = (int*)F.ctl + CW_WG + 16384 * L;
    if (two) { if (F.tid < 64) lc[F.tid] = 0; __syncthreads(); }
    for (int task = gw; task < NT / 16; task += NGW) {
        const int m0 = task * 16; const float* xr = X + (size_t)(m0 + r) * D + 8 * g;
        float s = 0.f;
#if RESID_SSQ
        { const f32x4 q = *(const f32x4*)((const float*)(F.ws + WS_SSQS) + (size_t)(m0 + r) * 16 + 4 * g); s = (q.x + q.y) + (q.z + q.w); }
#else
#pragma unroll 8
        for (int ks = 0; ks < 32; ++ks) { const f32x4 a = *(const f32x4*)(xr + 32 * ks), b = *(const f32x4*)(xr + 32 * ks + 4); s += (a.x * a.x + a.y * a.y) + (a.z * a.z + a.w * a.w) + (b.x * b.x + b.y * b.y) + (b.z * b.z + b.w * b.w); }
#endif
        s += __shfl_xor(s, 16); s += __shfl_xor(s, 32);
        const float rstd = 1.0f / sqrtf(s * (1.f / D) + RMS_EPS);
        f32x4 acc[5];
#pragma unroll
        for (int j = 0; j < 5; ++j) acc[j] = (f32x4){0.f, 0.f, 0.f, 0.f};
        bf16* hr = H + (size_t)(m0 + r) * D + 8 * g;
#pragma unroll 4
        for (int ks = 0; ks < 32; ++ks) {
#if ROUTER_NT
            const f32x4 a = NT_LOAD((const f32x4*)(xr + 32 * ks)), b = NT_LOAD((const f32x4*)(xr + 32 * ks + 4));
#else
            const f32x4 a = *(const f32x4*)(xr + 32 * ks), b = *(const f32x4*)(xr + 32 * ks + 4);
#endif
            const f32x4 wa = *(const f32x4*)(nw + 32 * ks + 8 * g), wb = *(const f32x4*)(nw + 32 * ks + 8 * g + 4);
            float hv[8] = {a.x * rstd * wa.x, a.y * rstd * wa.y, a.z * rstd * wa.z, a.w * rstd * wa.w, b.x * rstd * wb.x, b.y * rstd * wb.y, b.z * rstd * wb.z, b.w * rstd * wb.w};
            bf16x8 ah, al;
#pragma unroll
            for (int e = 0; e < 8; ++e) { const unsigned hi = f2bf(hv[e]); ah[e] = (short)hi; al[e] = (short)f2bf(hv[e] - bf2f((unsigned short)hi)); }
            *(bf16x8*)(hr + 32 * ks) = ah;
#pragma unroll
            for (int j = 0; j < 5; ++j) { const size_t wo = (size_t)(16 * j + r) * 1024 + 32 * ks + 8 * g; const bf16x8 bh = *(const bf16x8*)(wrh + wo), bl = *(const bf16x8*)(wrl + wo);
                acc[j] = __builtin_amdgcn_mfma_f32_16x16x32_bf16(ah, bh, acc[j], 0, 0, 0); acc[j] = __builtin_amdgcn_mfma_f32_16x16x32_bf16(ah, bl, acc[j], 0, 0, 0); acc[j] = __builtin_amdgcn_mfma_f32_16x16x32_bf16(al, bh, acc[j], 0, 0, 0); }
        }
#pragma unroll
        for (int j = 0; j < 5; ++j)
#pragma unroll
            for (int i = 0; i < 4; ++i) LG[(4 * g + i) * 80 + 16 * j + r] = acc[j][i];
        LDS_WAIT(); asm volatile("" ::: "memory");
        int se1 = 0, se2 = 0, sk1 = 0, sk2 = 0;
        if (lane < 16) {
            const LAS float* lg = LG + lane * 80; const int m = m0 + lane;
            float gl[8], gmax; int gsel = 0;
#pragma unroll
            for (int j = 0; j < 8; ++j) gl[j] = lg[j] + bg[j];
            gmax = gl[0];
#pragma unroll
            for (int j = 1; j < 8; ++j) if (gl[j] > gmax) { gmax = gl[j]; gsel = j; }
            float den = 0.f;
#pragma unroll
            for (int j = 0; j < 8; ++j) den += expf(gl[j] - gmax);
            const float pg = 1.0f / den;
            float el[8];
#pragma unroll
            for (int j = 0; j < 8; ++j) el[j] = lg[8 + gsel * 8 + j] + ber[gsel * 8 + j];
            int i1 = 0; float v1 = el[0];
#pragma unroll
            for (int j = 1; j < 8; ++j) if (el[j] > v1) { v1 = el[j]; i1 = j; }
            int i2 = -1; float v2 = -INFINITY;
#pragma unroll
            for (int j = 0; j < 8; ++j) if (j != i1 && el[j] > v2) { v2 = el[j]; i2 = j; }
            const float ex = expf(v2 - v1); const float w1 = pg / (1.0f + ex), w2 = pg * ex / (1.0f + ex);
            const int e1 = gsel * 8 + i1, e2 = gsel * 8 + i2;
            tok_e[2 * m] = e1; tok_e[2 * m + 1] = e2; tok_w[2 * m] = w1; tok_w[2 * m + 1] = w2;
            if (two) { se1 = e1; se2 = e2; sk1 = __hip_atomic_fetch_add(lc + e1, 1, __ATOMIC_RELAXED, __HIP_MEMORY_SCOPE_WORKGROUP); sk2 = __hip_atomic_fetch_add(lc + e2, 1, __ATOMIC_RELAXED, __HIP_MEMORY_SCOPE_WORKGROUP); }
            else { const unsigned k1 = __hip_atomic_fetch_add(cnt + e1, 1u, RLX_AGENT), k2 = __hip_atomic_fetch_add(cnt + e2, 1u, RLX_AGENT); tok_rank[2 * m] = (int)k1; tok_rank[2 * m + 1] = (int)k2; }
        }
        LDS_WAIT(); asm volatile("" ::: "memory");
        if (two) {
            __syncthreads();
            if (F.tid < 64) { const int c = lc[F.tid]; if (three) { cw[(size_t)F.bid * 64 + F.tid] = c; lb[F.tid] = 0; } else lb[F.tid] = c ? (int)__hip_atomic_fetch_add(cnt + F.tid, (unsigned)c, RLX_AGENT) : 0; }
            __syncthreads();
            if (lane < 16) { const int m = m0 + lane; tok_rank[2 * m] = lb[se1] + sk1; tok_rank[2 * m + 1] = lb[se2] + sk2; }
            __syncthreads();
            if (F.tid < 64) lc[F.tid] = 0;
            __syncthreads();
        }
    }
}

__device__ __forceinline__ void moe_table(Frame& F, int L, const LAS int* totp = nullptr) {
    LAS int* tab = (LAS int*)(F.lds + TAB_OFF);
    if (F.wave == 0) {
        const unsigned* cnt = (const unsigned*)F.ctl + CW_CNT + 64 * L; const int lane = F.lane;
        const int n = totp ? totp[lane] : (int)__hip_atomic_load(cnt + lane, RLX_AGENT), tiles = (n + 255) >> 8, rem = n & 255;
        const int tail = (MOE_ROWSKIP == 1 && rem != 0 && rem <= 128) ? 1 : 0;
        int inc = tiles, ia = tiles - tail, ib = tail;
#pragma unroll
        for (int o = 1; o < 64; o <<= 1) { const int t = __shfl_up(inc, o), ta = __shfl_up(ia, o), tb = __shfl_up(ib, o); if (lane >= o) { inc += t; ia += ta; ib += tb; } }
        const int t0 = inc - tiles, a0 = ia - (tiles - tail), b0 = __shfl(ia, 63) + ib - tail;
        tab[lane] = t0; if (lane == 63) tab[64] = inc;
        for (int t = 0; t < tiles; ++t) { const bool is_tail = tail && t == tiles - 1; const int valid = (n - 256 * t) < 256 ? (n - 256 * t) : 256;
            tab[pg8::MOE_ORDER_OFF + (is_tail ? b0 : a0 + t)] = (t0 + t) | (lane << 9) | (valid << 15); }
    }
    __syncthreads();
}
__device__ __forceinline__ void p_gather(Frame& F, int L) {
    const int NGW = F.G * NWAVES; const bool three = ROUTER_NOATOM && ROUTER_2LVL && (NT / 16 == NGW);
    LAS int* part = (LAS int*)(F.lds + RING_OFF); LAS int* tot = part + 1024; LAS int* bs = tot + 64;
    unsigned* cnt = (unsigned*)F.ctl + CW_CNT + 64 * L;
    const int w0 = (2 * F.bid < 256) ? 2 * F.bid : 0;
    if (three) {
        const int* cw = (const int*)F.ctl + CW_WG + 16384 * L; const int lane = F.lane, v = F.wave;
        int all = 0, lt = 0;
#pragma unroll 8
        for (int i = 0; i < 32; ++i) { const int w = 32 * v + i; const int c = cw[w * 64 + lane]; all += c; lt += (w < w0) ? c : 0; }
        part[(v * 2 + 0) * 64 + lane] = all; part[(v * 2 + 1) * 64 + lane] = lt;
        __syncthreads();
        if (v == 0) { int t = 0, b = 0;
#pragma unroll
            for (int j = 0; j < 8; ++j) { t += part[(j * 2 + 0) * 64 + lane]; b += part[(j * 2 + 1) * 64 + lane]; }
            tot[lane] = t; bs[lane] = b; bs[64 + lane] = b + cw[w0 * 64 + lane];
            if (F.bid == 0) cnt[lane] = (unsigned)t; }
        __syncthreads();
    }
    moe_table(F, L, three ? (const LAS int*)tot : nullptr);
    const LAS int* tab = (const LAS int*)(F.lds + TAB_OFF);
    const int* tok_e = (const int*)(F.ws + WS_ROUTE); const int* tok_rank = (const int*)(F.ws + WS_ROUTE + 2 * 262144); int* tok_pos = (int*)(F.ws + WS_ROUTE + 3 * 262144);
    int* row_tok = (int*)(F.ws + WS_ROWTOK);
    for (int a = F.bid * 512 + F.tid; a < 2 * NT; a += F.G * 512) { const int e = tok_e[a]; int pos = tab[e] * 256 + tok_rank[a]; if (three) pos += bs[(((a >> 1) >> 7) - w0) * 64 + e]; tok_pos[a] = pos; row_tok[pos] = a >> 1; }
    for (int e = F.bid; e < 64; e += F.G) { const int c0 = tab[e] * 256 + (three ? tot[e] : (int)__hip_atomic_load(cnt + e, RLX_AGENT)), c1 = tab[e + 1] * 256;
        for (int r = c0 + F.tid; r < c1; r += 512) row_tok[r] = 0; }
}

__device__ __forceinline__ void p_conv2(Frame& F, const bf16* src0, int ld0, const bf16* src1, int ld1, bf16* dst0, bf16* dst1, const float* cw, const float* cb, float sc0, float sc1) {
    const int gw = F.bid * NWAVES + F.wave, NGW = F.G * NWAVES, lane = F.lane;
    for (int task = gw; task < 2048; task += NGW) {
        const int which = task >> 10, rem = task & 1023, chalf = rem & 1, rb = rem >> 1;
        const int c = chalf * 512 + lane * 8, cc = which * 1024 + c;
        const bf16* src = (which ? src1 : src0) + c; const int ld = which ? ld1 : ld0; bf16* dst = (which ? dst1 : dst0) + c; const float sc = which ? sc1 : sc0;
        float w[4][8], bb[8];
#pragma unroll
        for (int k = 0; k < 4; ++k) { const f32x4 a = *(const f32x4*)(cw + k * 2048 + cc), b2 = *(const f32x4*)(cw + k * 2048 + cc + 4); w[k][0] = a.x; w[k][1] = a.y; w[k][2] = a.z; w[k][3] = a.w; w[k][4] = b2.x; w[k][5] = b2.y; w[k][6] = b2.z; w[k][7] = b2.w; }
        { const f32x4 a = *(const f32x4*)(cb + cc), b2 = *(const f32x4*)(cb + cc + 4); bb[0] = a.x; bb[1] = a.y; bb[2] = a.z; bb[3] = a.w; bb[4] = b2.x; bb[5] = b2.y; bb[6] = b2.z; bb[7] = b2.w; }
        const int row0 = rb * 64; const bool first = (row0 & (SEQ - 1)) == 0;
        float r0[8], r1[8], r2[8];
#pragma unroll
        for (int e = 0; e < 8; ++e) { r0[e] = 0.f; r1[e] = 0.f; r2[e] = 0.f; }
        if (!first) {
            const v4u a = *(const v4u*)(src + (size_t)(row0 - 3) * ld), b2 = *(const v4u*)(src + (size_t)(row0 - 2) * ld), c2 = *(const v4u*)(src + (size_t)(row0 - 1) * ld);
            r0[0] = blo(a.x); r0[1] = bhi(a.x); r0[2] = blo(a.y); r0[3] = bhi(a.y); r0[4] = blo(a.z); r0[5] = bhi(a.z); r0[6] = blo(a.w); r0[7] = bhi(a.w);
            r1[0] = blo(b2.x); r1[1] = bhi(b2.x); r1[2] = blo(b2.y); r1[3] = bhi(b2.y); r1[4] = blo(b2.z); r1[5] = bhi(b2.z); r1[6] = blo(b2.w); r1[7] = bhi(b2.w);
            r2[0] = blo(c2.x); r2[1] = bhi(c2.x); r2[2] = blo(c2.y); r2[3] = bhi(c2.y); r2[4] = blo(c2.z); r2[5] = bhi(c2.z); r2[6] = blo(c2.w); r2[7] = bhi(c2.w);
        }
        for (int rr = 0; rr < 64; rr += 8) {
            v4u in[8];
#pragma unroll
            for (int i = 0; i < 8; ++i) in[i] = *(const v4u*)(src + (size_t)(row0 + rr + i) * ld);
#pragma unroll
            for (int i = 0; i < 8; ++i) {
                float r3[8]; r3[0] = blo(in[i].x); r3[1] = bhi(in[i].x); r3[2] = blo(in[i].y); r3[3] = bhi(in[i].y); r3[4] = blo(in[i].z); r3[5] = bhi(in[i].z); r3[6] = blo(in[i].w); r3[7] = bhi(in[i].w);
                float y[8];
#pragma unroll
                for (int e = 0; e < 8; ++e) { const float t = bb[e] + w[0][e] * r0[e] + w[1][e] * r1[e] + w[2][e] * r2[e] + w[3][e] * r3[e]; y[e] = t * __builtin_amdgcn_rcpf(1.0f + __expf(-t)) * sc; r0[e] = r1[e]; r1[e] = r2[e]; r2[e] = r3[e]; }
                v4u o; o.x = pk2(y[0], y[1]); o.y = pk2(y[2], y[3]); o.z = pk2(y[4], y[5]); o.w = pk2(y[6], y[7]);
                *(v4u*)(dst + (size_t)(row0 + rr + i) * 1024) = o;
            }
        }
    }
}

__device__ __forceinline__ void p_convfix(Frame& F, bf16* d0, bf16* d1, const float* cw, const float* cb, float sc1, size_t rawh_off) {
    const bf16* rawh = (const bf16*)(F.ws + rawh_off);
    for (int p = F.bid * 512 + F.tid; p < 512 * 256; p += F.G * 512) {
        const int cg = p & 255, B = p >> 8; const int ch = cg * 8; const bool seq0 = (B & 31) == 0;
        v4u sl[6];
#pragma unroll
        for (int k = 0; k < 6; ++k) { sl[k] = (v4u){0u, 0u, 0u, 0u}; if (!(seq0 && k < 3)) sl[k] = *(const v4u*)(rawh + ((size_t)B * 6 + k) * 2048 + ch); }
        float w[4][8], bb[8];
#pragma unroll
        for (int h = 0; h < 2; ++h) { const f32x4 a0 = *(const f32x4*)(cw + ch + 4 * h), a1 = *(const f32x4*)(cw + 2048 + ch + 4 * h), a2 = *(const f32x4*)(cw + 4096 + ch + 4 * h), a3 = *(const f32x4*)(cw + 6144 + ch + 4 * h), b4 = *(const f32x4*)(cb + ch + 4 * h);
#pragma unroll
            for (int e = 0; e < 4; ++e) { w[0][4 * h + e] = a0[e]; w[1][4 * h + e] = a1[e]; w[2][4 * h + e] = a2[e]; w[3][4 * h + e] = a3[e]; bb[4 * h + e] = b4[e]; } }
        float x[6][8];
#pragma unroll
        for (int k = 0; k < 6; ++k) { const v4u v = sl[k]; x[k][0] = blo(v.x); x[k][1] = bhi(v.x); x[k][2] = blo(v.y); x[k][3] = bhi(v.y); x[k][4] = blo(v.z); x[k][5] = bhi(v.z); x[k][6] = blo(v.w); x[k][7] = bhi(v.w); }
        const float sc = ch >= 1024 ? sc1 : 1.0f; bf16* dst = (ch >= 1024 ? d1 : d0) + (size_t)(B * 64) * 1024 + (ch & 1023);
#pragma unroll
        for (int r = 0; r < 3; ++r) { float y[8];
#pragma unroll
            for (int e = 0; e < 8; ++e) { const float t = bb[e] + w[0][e] * x[r][e] + w[1][e] * x[r + 1][e] + w[2][e] * x[r + 2][e] + w[3][e] * x[r + 3][e];
                y[e] = t * __builtin_amdgcn_rcpf(1.0f + __expf(-t)) * sc; }
            v4u o; o.x = pk2(y[0], y[1]); o.y = pk2(y[2], y[3]); o.z = pk2(y[4], y[5]); o.w = pk2(y[6], y[7]);
            *(v4u*)(dst + (size_t)r * 1024) = o; }
    }
}

namespace mixk {
typedef short bf16x8 __attribute__((ext_vector_type(8)));
typedef short s16x4 __attribute__((ext_vector_type(4)));
typedef float f32x16 __attribute__((ext_vector_type(16)));
__device__ __forceinline__ unsigned offb(unsigned row, unsigned ch) { return 2048u * (row >> 3) + 512u * (ch >> 2) + 64u * (row & 7u) + 16u * ((ch & 3u) ^ ((row >> 2) & 3u)); }
__device__ __forceinline__ s16x4 trrd(const LAS unsigned char* p) { return __builtin_bit_cast(s16x4, __builtin_amdgcn_ds_read_tr16_b64_v4i16((LAS s16x4*)p)); }
struct FragBase { unsigned re, t0, t1; };
struct FragBase16 { unsigned r16, u0, u1; };
__device__ __forceinline__ FragBase frag_base(int lane) {
    FragBase f; const unsigned l31 = lane & 31, h = lane >> 5, x = (l31 >> 2) & 3;
    f.re = 2048u * (l31 >> 3) + 64u * (l31 & 7) + 16u * (h ^ x);
    const unsigned blk = (lane >> 4) & 1, q = (lane & 15) >> 2, p = lane & 3, cc = 2 * blk + (p >> 1);
    f.t0 = 2048u * h + 64u * q + 16u * (cc ^ (2 * h)) + 8u * (p & 1); f.t1 = 2048u * h + 64u * (4 + q) + 16u * (cc ^ (2 * h + 1)) + 8u * (p & 1);
    return f;
}
__device__ __forceinline__ FragBase16 frag_base16(int lane, int c16  ) {
    FragBase16 f; const unsigned l15 = lane & 15, g = lane >> 4, q = (lane & 15) >> 2, p = lane & 3;
    f.r16 = 2048u * (l15 >> 3) + 64u * (l15 & 7) + 16u * (g ^ ((l15 >> 2) & 3));
    const unsigned c2 = 2 * (c16 & 1) + (p >> 1);
    f.u0 = 2048u * g + 512u * (c16 >> 1) + 64u * q + 16u * (c2 ^ ((2 * g) & 3)) + 8u * (p & 1); f.u1 = 2048u * g + 512u * (c16 >> 1) + 64u * (4 + q) + 16u * (c2 ^ ((2 * g + 1) & 3)) + 8u * (p & 1);
    return f;
}
__device__ __forceinline__ bf16x8 rowfrag(const LAS unsigned char* tile, const FragBase& f, int rb, int s) { return *(const LAS bf16x8*)(tile + rb * 8192 + (s >> 1) * 512 + (f.re ^ ((unsigned)(s & 1) << 5))); }
__device__ __forceinline__ bf16x8 trfrag(const LAS unsigned char* tile, const FragBase& f, int c, int ks) {
    const s16x4 lo = trrd(tile + 4096 * ks + 512 * c + f.t0), hi = trrd(tile + 4096 * ks + 512 * c + f.t1);
    return (bf16x8){lo[0], lo[1], lo[2], lo[3], hi[0], hi[1], hi[2], hi[3]};
}
__device__ __forceinline__ bf16x8 rowfrag16(const LAS unsigned char* tile, const FragBase16& f, int rb, int s) { return *(const LAS bf16x8*)(tile + rb * 4096 + s * 512 + f.r16); }
__device__ __forceinline__ bf16x8 trfrag16(const LAS unsigned char* tile, const FragBase16& f, int ks) {
    const s16x4 lo = trrd(tile + 8192 * ks + f.u0), hi = trrd(tile + 8192 * ks + f.u1);
    return (bf16x8){lo[0], lo[1], lo[2], lo[3], hi[0], hi[1], hi[2], hi[3]};
}
__device__ __forceinline__ float fast_logsigmoid(float x) { return fminf(x, 0.f) - __logf(1.0f + __expf(-fabsf(x))); }
__device__ __forceinline__ float fast_softplus(float x) { return fmaxf(x, 0.f) + __logf(1.0f + __expf(-fabsf(x))); }
constexpr int SC_A = 0, SC_M = 128, SC_INTER = 256, SC_EMT = 384, SC_WK = 512, SC_DEN1 = 640, SC_DEN2 = 1152, SC_N0 = 1280, SC_N1 = 1536, SC_MISC = 1792;

template <int CTRL, int RM> __device__ __forceinline__ float dpp_keep(float old, float v) { return __builtin_bit_cast(float, __builtin_amdgcn_update_dpp(__builtin_bit_cast(int, old), __builtin_bit_cast(int, v), CTRL, RM, 0xF, false)); }
__device__ __forceinline__ float scan_add(float v) {
    v += dpp_keep<0x111, 0xF>(0.f, v); v += dpp_keep<0x112, 0xF>(0.f, v); v += dpp_keep<0x114, 0xF>(0.f, v); v += dpp_keep<0x118, 0xF>(0.f, v);
    v += dpp_keep<0x142, 0xA>(0.f, v); v += dpp_keep<0x143, 0xC>(0.f, v); return v;
}
__device__ __forceinline__ float scan_max(float v) {
    v = fmaxf(v, dpp_keep<0x111, 0xF>(-INFINITY, v)); v = fmaxf(v, dpp_keep<0x112, 0xF>(-INFINITY, v)); v = fmaxf(v, dpp_keep<0x114, 0xF>(-INFINITY, v)); v = fmaxf(v, dpp_keep<0x118, 0xF>(-INFINITY, v));
    v = fmaxf(v, dpp_keep<0x142, 0xA>(-INFINITY, v)); v = fmaxf(v, dpp_keep<0x143, 0xC>(-INFINITY, v)); return v;
}
__device__ __forceinline__ float lane63(float v) { return __builtin_bit_cast(float, __builtin_amdgcn_readlane(__builtin_bit_cast(int, v), 63)); }
__device__ __forceinline__ void guest_piece(Frame& F, KArgs A, int L, int id, int lane, const float*& src, int& ld, bf16*& dst, int& dk) {
    const int kq = lane & 7, g = lane >> 3; const int e = id / 768, r = id - e * 768;
    if (r < 512) { const int m = r >> 8, rr = r & 255, kb = rr >> 4, nb = rr & 15;
        src = (m ? A->in[I_WUP] : A->in[I_WGATE]) + (size_t)(L * 64 + e) * 524288 + (size_t)(kb * 64 + 8 * kq) * 512 + nb * 32 + 4 * g; ld = 512;
        dst = (bf16*)(F.ws + WS_WGU) + (size_t)e * 1048576 + (size_t)(8 * (nb * 8 + g) + 4 * m) * 1024 + kb * 64 + 8 * kq; dk = 1024; }
    else { const int rr = r - 512, kb = rr >> 5, nb = rr & 31;
        src = A->in[I_WDOWN] + (size_t)(L * 64 + e) * 524288 + (size_t)(kb * 64 + 8 * kq) * 1024 + nb * 32 + 4 * g; ld = 1024;
        dst = (bf16*)(F.ws + WS_WDN) + (size_t)e * 524288 + (size_t)(nb * 32 + 4 * g) * 512 + kb * 64 + 8 * kq; dk = 512; }
}
template <int MODE>
__device__ __forceinline__ void chunk_unit(Frame& F, KArgs A, int L, int b, int h, int vs, const bool guest) {
    constexpr int NH = (MODE == 0) ? 2 : 1;
    LAS unsigned char* QH = F.lds + RING_OFF; LAS unsigned char* KH = QH + 32768; LAS unsigned char* VV = QH + 65536; LAS unsigned char* CS = QH + 98304;
    LAS float* SC = (LAS float*)(F.lds + LDSCTL_OFF + 2048);
    int tid0 = F.tid; asm volatile("" : "+v"(tid0)); const int w = F.wave;
    const size_t rowb = (size_t)b * SEQ;
    const bf16 *Qg, *Kg, *Vg; int vcol;
    if (MODE == 0) { Qg = (const bf16*)(F.ws + WS_YATT) + h * 256; Kg = (const bf16*)(F.ws + WS_YSSD) + h * 256; Vg = (const bf16*)(F.ws + WS_PROJ + 2 * pg8::SLAB) + h * 256 + vs * 64; vcol = h * 256 + vs * 64; }
    else { const int g = h >> 2; Qg = (const bf16*)(F.ws + WS_PROJ + 1 * pg8::SLAB) + 512 + g * 128; Kg = (const bf16*)(F.ws + WS_PROJ + 1 * pg8::SLAB) + g * 128; Vg = (const bf16*)(F.ws + WS_XSSD) + h * 64; vcol = h * 64; }
    bf16* Yg = (bf16*)(F.ws + (MODE == 0 ? WS_YML : WS_XSSD)) + vcol;
    float* SSQ = (float*)(F.ws + (MODE == 0 ? WS_SSQM : WS_SSQS));
    const float* SM = (const float*)(F.ws + WS_SMALL) + rowb * 64;
    v4u qpre[4], kpre[4], vpre[2];
#define MIX_LOADQK(c_, hh_) do { const int r7_ = (tid >> 2) & 7, x_ = (2 * (tid >> 7) + (r7_ >> 2)) & 3; \
        const size_t go = (rowb + (size_t)(c_) * 128 + 8 * (tid >> 7) + r7_) * 1024 + (hh_) * 128 + (4 * ((tid >> 5) & 3) + ((tid & 3) ^ x_)) * 8; \
        _Pragma("unroll") for (int i = 0; i < 4; ++i) { qpre[i] = *(const v4u*)(Qg + go + (size_t)i * 32768); kpre[i] = *(const v4u*)(Kg + go + (size_t)i * 32768); } } while (0)
#define MIX_LOADV(c_) do { const int r7_ = (tid >> 2) & 7, x_ = (2 * (tid >> 6) + (r7_ >> 2)) & 3; \
        const size_t go = (rowb + (size_t)(c_) * 128 + 8 * (tid >> 6) + r7_) * 1024 + (4 * ((tid >> 5) & 1) + ((tid & 3) ^ x_)) * 8; vpre[0] = NT_LOAD((const v4u*)(Vg + go)); vpre[1] = NT_LOAD((const v4u*)(Vg + go + 65536)); } while (0)
#define MIX_STOREQK() do { _Pragma("unroll") for (int i = 0; i < 4; ++i) { *(LAS v4u*)(QH + 16u * tid + 8192u * i) = qpre[i]; *(LAS v4u*)(KH + 16u * tid + 8192u * i) = kpre[i]; } } while (0)
    const int tid = tid0;
    f32x16 Cacc[NH];
#pragma unroll
    for (int hh = 0; hh < NH; ++hh)
#pragma unroll
        for (int r = 0; r < 16; ++r) Cacc[hh][r] = 0.f;
    for (int i = tid; i < 8192; i += 512) ((LAS unsigned*)CS)[i] = 0u;
    if (MODE == 0) { for (int i = tid; i < 512; i += 512) SC[SC_N0 + i] = 0.f; }
    float m_prev = 0.f;
    const float p_ib = (MODE == 0) ? A->in[I_MIB][L * 4 + h] : 0.f, p_fb = (MODE == 0) ? A->in[I_MFB][L * 4 + h] : 0.f;
    const float p_dtb = (MODE == 1) ? A->in[I_SDTB][L * 16 + h] : 0.f, p_A = (MODE == 1) ? -expf(A->in[I_SALOG][L * 16 + h]) : 0.f, p_D = (MODE == 1) ? A->in[I_SD][L * 16 + h] : 0.f;
    float gq0 = 0.f, gq1 = 0.f, gr0 = 0.f, gr1 = 0.f;
#define MIX_LOADG(c_) do { const float* sm_ = SM + (size_t)((c_) * 128 + 2 * (tid & 63)) * 64; if (MODE == 0) { gq0 = sm_[36 + h]; gq1 = sm_[64 + 36 + h]; gr0 = sm_[32 + h]; gr1 = sm_[64 + 32 + h]; } else { gq0 = sm_[16 + h]; gq1 = sm_[64 + 16 + h]; } } while (0)
    if (w == 0) MIX_LOADG(0);
    MIX_LOADQK(0, 0); MIX_LOADV(0);
    __syncthreads();

    for (int c = 0; c < SEQ / 128; ++c) {
        int tid = F.tid; asm volatile("" : "+v"(tid)); int lane = tid & 63;
        const int hl = lane >> 5, l31 = lane & 31; const FragBase fb = frag_base(lane);
        LAS float* nOld = SC + ((c & 1) ? SC_N1 : SC_N0); LAS float* nNew = SC + ((c & 1) ? SC_N0 : SC_N1);
        if (w == 0) {
            float x0, x1, y0, y1;
            if (MODE == 0) { x0 = fast_logsigmoid(gq0 + p_fb); x1 = fast_logsigmoid(gq1 + p_fb); y0 = gr0 + p_ib; y1 = gr1 + p_ib; }
            else { const float d0 = fast_softplus(gq0 + p_dtb), d1 = fast_softplus(gq1 + p_dtb); x0 = d0 * p_A; x1 = d1 * p_A; y0 = __logf(d0); y1 = __logf(d1); }
            if (c + 1 < SEQ / 128) MIX_LOADG(c + 1);
            const float ps = x0 + x1, inc = scan_add(ps);
            const float b0 = inc - ps + x0, b1 = inc;
            const float a0 = y0 - b0, a1 = y1 - b1;
            float M0, M1, Mlast, inter0, inter1, emt0 = 0.f, emt1 = 0.f, wk0, wk1, cs;
            if (MODE == 0) {
                const float im = scan_max(fmaxf(a0, a1));
                const float ex = dpp_keep<0x138, 0xF>(-INFINITY, im);
                const float c0 = fmaxf(ex, a0), c1 = fmaxf(c0, a1);
                M0 = fmaxf(m_prev, c0); M1 = fmaxf(m_prev, c1); Mlast = lane63(M1);
                inter0 = __expf(m_prev - M0); inter1 = __expf(m_prev - M1); emt0 = __expf(-b0 - M0); emt1 = __expf(-b1 - M1);
                wk0 = __expf(a0 - Mlast); wk1 = __expf(a1 - Mlast); cs = __expf(m_prev - Mlast);
                m_prev = lane63(b1) + Mlast;
            } else {
                M0 = -b0; M1 = -b1; const float bl = lane63(b1); inter0 = __expf(b0); inter1 = __expf(b1);
                wk0 = __expf(bl + a0); wk1 = __expf(bl + a1); cs = __expf(bl);
            }
            SC[SC_A + 2 * lane] = a0; SC[SC_A + 2 * lane + 1] = a1; SC[SC_M + 2 * lane] = M0; SC[SC_M + 2 * lane + 1] = M1;
            SC[SC_INTER + 2 * lane] = inter0; SC[SC_INTER + 2 * lane + 1] = inter1; SC[SC_EMT + 2 * lane] = emt0; SC[SC_EMT + 2 * lane + 1] = emt1;
            SC[SC_WK + 2 * lane] = wk0; SC[SC_WK + 2 * lane + 1] = wk1; if (lane == 0) SC[SC_MISC] = cs;
        }
        MIX_STOREQK();
        __syncthreads();
#pragma unroll
        for (int i = 0; i < 2; ++i) { const int rg = (tid >> 6) + 8 * i, row = 8 * rg + ((tid >> 2) & 7); const float wk = SC[SC_WK + row]; const v4u v = vpre[i];
            const unsigned va = 2048u * rg + 512u * ((tid >> 5) & 1) + 64u * ((tid >> 2) & 7) + 16u * (tid & 3);
            *(LAS v4u*)(VV + va) = v; v4u o; o.x = pk2(blo(v.x) * wk, bhi(v.x) * wk); o.y = pk2(blo(v.y) * wk, bhi(v.y) * wk); o.z = pk2(blo(v.z) * wk, bhi(v.z) * wk); o.w = pk2(blo(v.w) * wk, bhi(v.w) * wk);
            *(LAS v4u*)(VV + va + 1024u) = o; }
        if (NH == 2) MIX_LOADQK(c, 1);
        const float cs = SC[SC_MISC];
#pragma unroll
        for (int hh = 0; hh < NH; ++hh)
#pragma unroll
            for (int r = 0; r < 16; ++r) Cacc[hh][r] *= cs;
        __syncthreads();
        const int tau = w >> 1, nu = w & 1;
        f32x16 X0, X1, N2; f32x4 d2 = (f32x4){0.f, 0.f, 0.f, 0.f}; unsigned ppk[2][8];
#pragma unroll
        for (int r = 0; r < 16; ++r) { X0[r] = 0.f; X1[r] = 0.f; N2[r] = 0.f; }
        const bool x0on = (2 * nu) <= tau, x1on = (2 * nu + 1) <= tau;
#pragma unroll
        for (int hh = 0; hh < NH; ++hh) {
            if (hh == 1) { __syncthreads(); MIX_STOREQK(); __syncthreads(); }
#define MIX_SB() __builtin_amdgcn_sched_barrier(0)
            {
                bf16x8 qf = rowfrag(QH, fb, tau, 0), cf = trfrag(CS, fb, 2 * hh + nu, 0), k0 = rowfrag(KH, fb, 2 * nu, 0), k1 = rowfrag(KH, fb, 2 * nu + 1, 0);
#pragma unroll
                for (int ks = 0; ks < 8; ++ks) { const int kn = (ks + 1) & 7;
                    const bf16x8 qn = rowfrag(QH, fb, tau, kn), cn = trfrag(CS, fb, 2 * hh + nu, kn), k0n = rowfrag(KH, fb, 2 * nu, kn), k1n = rowfrag(KH, fb, 2 * nu + 1, kn);
                    N2 = __builtin_amdgcn_mfma_f32_32x32x16_bf16(qf, cf, N2, 0, 0, 0);
                    if (x0on) X0 = __builtin_amdgcn_mfma_f32_32x32x16_bf16(k0, qf, X0, 0, 0, 0);
                    if (x1on) X1 = __builtin_amdgcn_mfma_f32_32x32x16_bf16(k1, qf, X1, 0, 0, 0);
                    MIX_SB(); qf = qn; cf = cn; k0 = k0n; k1 = k1n; }
            }
            MIX_SB();
            if (hh == NH - 1) {
                const int t = 32 * tau + l31; const float Mt = SC[SC_M + t];
#pragma unroll
                for (int xi = 0; xi < 2; ++xi) {
                    const int sig = 2 * nu + xi; const f32x16& X = xi ? X1 : X0; float cs1 = 0.f;
#pragma unroll
                    for (int g = 0; g < 4; ++g) { const int s0 = 32 * sig + 8 * g + 4 * hl; const f32x4 av = *(const LAS f32x4*)(SC + SC_A + s0); float p[4];
#pragma unroll
                        for (int i = 0; i < 4; ++i) { const float e = __expf(av[i] - Mt); p[i] = (s0 + i <= t) ? X[4 * g + i] * e : 0.f; cs1 += p[i]; }
                        ppk[xi][2 * g] = pk2(p[0], p[1]); ppk[xi][2 * g + 1] = pk2(p[2], p[3]); }
                    if (MODE == 0 && sig <= tau) { cs1 += __shfl_xor(cs1, 32); if (hl == 0) SC[SC_DEN1 + sig * 128 + t] = cs1; }
                }
                MIX_SB();
            }
            {
                bf16x8 kf = trfrag(KH, fb, tau, 0), vf = trfrag(VV, fb, 2 + nu, 0);
#pragma unroll
                for (int ks = 0; ks < 8; ++ks) { const int kn = (ks + 1) & 7; const bf16x8 kfn = trfrag(KH, fb, tau, kn), vfn = trfrag(VV, fb, 2 + nu, kn);
                    Cacc[hh] = __builtin_amdgcn_mfma_f32_32x32x16_bf16(kf, vf, Cacc[hh], 0, 0, 0); MIX_SB(); kf = kfn; vf = vfn; }
            }
            MIX_SB();
            if (MODE == 0) {
                f32x4 nacc = (f32x4){0.f, 0.f, 0.f, 0.f}; int lane16 = lane; asm volatile("" : "+v"(lane16)); const FragBase16 fb16 = frag_base16(lane16, w);
#pragma unroll
                for (int ks = 0; ks < 4; ++ks) {
                    bf16x8 nb = (bf16x8){0, 0, 0, 0, 0, 0, 0, 0}, wb = nb;
                    if ((lane & 15) == 0) { const LAS float* np = nOld + hh * 128 + 32 * ks + 8 * (lane >> 4); const LAS float* wp = SC + SC_WK + 32 * ks + 8 * (lane >> 4);
#pragma unroll
                        for (int j = 0; j < 8; ++j) { nb[j] = (short)f2bf(np[j]); wb[j] = (short)f2bf(wp[j]); } }
                    const bf16x8 qa = rowfrag16(QH, fb16, w, ks); d2 = __builtin_amdgcn_mfma_f32_16x16x32_bf16(qa, nb, d2, 0, 0, 0);
                    const bf16x8 ka = trfrag16(KH, fb16, ks); nacc = __builtin_amdgcn_mfma_f32_16x16x32_bf16(ka, wb, nacc, 0, 0, 0); MIX_SB();
                }
                if ((lane & 15) == 0) {
#pragma unroll
                    for (int r = 0; r < 4; ++r) { const int d = hh * 128 + 16 * w + 4 * (lane >> 4) + r; nNew[d] = cs * nOld[d] + nacc[r]; }
                }
            }
        }
        if (MODE == 0) { if ((lane & 15) == 0) {
#pragma unroll
            for (int r = 0; r < 4; ++r) SC[SC_DEN2 + 16 * w + 4 * (lane >> 4) + r] = d2[r]; } }
        __syncthreads();
#if USE_GUEST_CVT
        f32x4 gv[8]; bf16* gdst = nullptr; int gdk = 0;
        const bool gon = guest && (MODE == 0 || (c & 1) == 0);
        if (gon) { const int gid = (MODE == 0) ? (c * 256 + F.bid) * 8 + w : 32768 + ((c >> 1) * 256 + F.bid) * 8 + w; const float* gsrc; int gld; guest_piece(F, A, L, gid, lane, gsrc, gld, gdst, gdk);
#pragma unroll
            for (int j = 0; j < 8; ++j) gv[j] = NT_LOAD((const f32x4*)(gsrc + (size_t)j * gld)); }
        MIX_SB();
#endif
        if (c + 1 < SEQ / 128) { MIX_LOADQK(c + 1, 0); if (MODE == 0) MIX_LOADV(c + 1); }
        v4u og0 = (v4u){0u, 0u, 0u, 0u}, og1 = og0;
        if (MODE == 1 && SSD_ZPRE) { const bf16* zp = (const bf16*)(F.ws + WS_PROJ) + (rowb + (size_t)c * 128 + (tid >> 2)) * 1024 + h * 64 + (tid & 3) * 16; og0 = NT_LOAD((const v4u*)zp); og1 = NT_LOAD((const v4u*)(zp + 8)); }
        if (MODE == 0 && FIX_PURE) { const bf16* op = (const bf16*)(F.ws + WS_PROJ + 3 * pg8::SLAB) + (rowb + (size_t)c * 128 + (tid >> 2)) * 1024 + vcol + (tid & 3) * 16; og0 = NT_LOAD((const v4u*)op); og1 = NT_LOAD((const v4u*)(op + 8)); }
        if (MODE == 0 && tid < 128) {
            float den = SC[SC_INTER + tid] * SC[SC_DEN2 + tid];
#pragma unroll
            for (int sg = 0; sg < 4; ++sg) if (sg <= (tid >> 5)) den += SC[SC_DEN1 + sg * 128 + tid];
            SC[SC_EMT + tid] = 1.0f / fmaxf(fabsf(den), SC[SC_EMT + tid]);
        }
        {
            const unsigned pb = 2048u * (4 * tau + (l31 >> 3)) + 64u * (l31 & 7) + 16u * ((l31 >> 2) & 3) + 8u * hl;
#pragma unroll
            for (int xi = 0; xi < 2; ++xi) {
                const int sig = 2 * nu + xi; if (sig > tau) continue;
#pragma unroll
                for (int g = 0; g < 4; ++g) { v2u o; o.x = ppk[xi][2 * g]; o.y = ppk[xi][2 * g + 1]; *(LAS v2u*)(QH + (pb ^ (16u * g)) + 512u * sig) = o; }
            }
            MIX_SB();
            const unsigned cb = 8192u * tau + 512u * nu + 256u * hl + 2u * (l31 & 7), e0 = 16u * ((l31 >> 3) ^ hl);
#pragma unroll
            for (int hh = 0; hh < NH; ++hh)
#pragma unroll
                for (int r = 0; r < 16; ++r) { const int g = r >> 2, i = r & 3;
                    *(LAS unsigned short*)(CS + cb + 1024u * hh + 2048u * g + 64u * i + (e0 ^ (32u * (g & 1)))) = (unsigned short)f2bf(Cacc[hh][r]); }
            MIX_SB();
        }
        __syncthreads();
        {
            f32x16 N1;
#pragma unroll
            for (int r = 0; r < 16; ++r) N1[r] = 0.f;
            for (int ks = 0; ks < 2 * (tau + 1); ++ks) { const bf16x8 pf = rowfrag(QH, fb, tau, ks); const bf16x8 vf = trfrag(VV, fb, nu, ks); N1 = __builtin_amdgcn_mfma_f32_32x32x16_bf16(pf, vf, N1, 0, 0, 0); MIX_SB(); }
            LAS float* HT = (LAS float*)KH;
            MIX_SB();
#pragma unroll
            for (int g = 0; g < 4; ++g) { const int t0 = 32 * tau + 8 * g + 4 * hl; const f32x4 iv = *(const LAS f32x4*)(SC + SC_INTER + t0); f32x4 rv = (f32x4){1.f, 1.f, 1.f, 1.f}; if (MODE == 0) rv = *(const LAS f32x4*)(SC + SC_EMT + t0);
#pragma unroll
                for (int i = 0; i < 4; ++i) HT[(t0 + i) * 64 + 32 * nu + l31] = (N1[4 * g + i] + iv[i] * N2[4 * g + i]) * rv[i];
                MIX_SB(); }
        }
        __syncthreads();
        if (MODE == 1 && SSD_VEARLY && c + 1 < SEQ / 128) MIX_LOADV(c + 1);
        {
            const int t = tid >> 2, q4 = tid & 3; const LAS float* hp = (const LAS float*)KH + t * 64 + q4 * 16; float y[16];
#pragma unroll
            for (int i = 0; i < 4; ++i) { const f32x4 v = *(const LAS f32x4*)(hp + 4 * i); y[4 * i] = v.x; y[4 * i + 1] = v.y; y[4 * i + 2] = v.z; y[4 * i + 3] = v.w; }
            const size_t grow = rowb + (size_t)c * 128 + t;
            if (MODE == 1) {
                const bf16* zp = (const bf16*)(F.ws + WS_PROJ) + grow * 1024 + h * 64 + q4 * 16; v4u z0, z1; if (SSD_ZPRE) { z0 = og0; z1 = og1; } else { z0 = NT_LOAD((const v4u*)zp); z1 = NT_LOAD((const v4u*)(zp + 8)); }
                const v4u x0 = *(const LAS v4u*)(VV + offb(t, 2 * q4)), x1 = *(const LAS v4u*)(VV + offb(t, 2 * q4 + 1));
                const unsigned zz[8] = {z0.x, z0.y, z0.z, z0.w, z1.x, z1.y, z1.z, z1.w}, xx[8] = {x0.x, x0.y, x0.z, x0.w, x1.x, x1.y, x1.z, x1.w};
#pragma unroll
                for (int i = 0; i < 8; ++i) { const float za = blo(zz[i]), zb = bhi(zz[i]); y[2 * i] = (y[2 * i] + p_D * blo(xx[i])) * (za * __builtin_amdgcn_rcpf(1.0f + __expf(-za))); y[2 * i + 1] = (y[2 * i + 1] + p_D * bhi(xx[i])) * (zb * __builtin_amdgcn_rcpf(1.0f + __expf(-zb))); }
            }
            float q = 0.f;
#pragma unroll
            for (int i = 0; i < 16; ++i) q += y[i] * y[i];
            q += __shfl_xor(q, 1); q += __shfl_xor(q, 2);
            if (q4 == 0) SSQ[grow * 16 + (MODE == 0 ? h * 4 + vs : h)] = q;
            if (MODE == 0 && FIX_PURE) { const unsigned gg[8] = {og0.x, og0.y, og0.z, og0.w, og1.x, og1.y, og1.z, og1.w};
#pragma unroll
                for (int i = 0; i < 8; ++i) { y[2 * i] *= __builtin_amdgcn_rcpf(1.0f + __expf(-blo(gg[i]))); y[2 * i + 1] *= __builtin_amdgcn_rcpf(1.0f + __expf(-bhi(gg[i]))); } }
            v4u o0, o1; o0.x = pk2(y[0], y[1]); o0.y = pk2(y[2], y[3]); o0.z = pk2(y[4], y[5]); o0.w = pk2(y[6], y[7]); o1.x = pk2(y[8], y[9]); o1.y = pk2(y[10], y[11]); o1.z = pk2(y[12], y[13]); o1.w = pk2(y[14], y[15]);
            bf16* yp = Yg + grow * 1024 + q4 * 16; *(v4u*)yp = o0; *(v4u*)(yp + 8) = o1;
        }
        if (MODE == 1 && !SSD_VEARLY && c + 1 < SEQ / 128) MIX_LOADV(c + 1);
#if USE_GUEST_CVT
        MIX_SB();
        if (gon) {
#pragma unroll
            for (int i = 0; i < 4; ++i) { v4u o; o.x = pk2(gv[0][i], gv[1][i]); o.y = pk2(gv[2][i], gv[3][i]); o.z = pk2(gv[4][i], gv[5][i]); o.w = pk2(gv[6][i], gv[7][i]); NT_STORE(o, (v4u*)(gdst + (size_t)i * gdk)); } }
#endif
        __syncthreads();
    }
#undef MIX_LOADQK
#undef MIX_LOADV
#undef MIX_LOADG
#undef MIX_STOREQK
#undef MIX_SB
}
}
__device__ __forceinline__ void p_ml_chunk(Frame& F, KArgs A, int L) { const bool guest = USE_GUEST_CVT && F.G == 256; for (int u = F.bid; u < NB * 16; u += F.G) mixk::chunk_unit<0>(F, A, L, u >> 4, (u >> 2) & 3, u & 3, guest); }
__device__ __forceinline__ void p_ssd_chunk(Frame& F, KArgs A, int L) { const bool guest = USE_GUEST_CVT && F.G == 256; for (int u = F.bid; u < NB * 16; u += F.G) mixk::chunk_unit<1>(F, A, L, u >> 4, u & 15, 0, guest); }


#define MAKE_FRAME(F, A) KArgs A = kargs(); Frame F; \
        { extern __shared__ __attribute__((aligned(16))) unsigned char lds_[]; int t_ = threadIdx.x, b_ = blockIdx.x, g_ = gridDim.x; asm volatile("" : "+v"(t_)); asm volatile("" : "+s"(b_), "+s"(g_)); \
          F.lds = (LAS unsigned char*)lds_; F.MISC = (volatile LAS unsigned*)(F.lds + MISC_OFF); F.tid = t_; F.lane = t_ & 63; F.wave = __builtin_amdgcn_readfirstlane(t_ >> 6); \
          F.G = g_; F.bid = b_; F.ws = A->ws; F.out = A->out; F.ctl = (gu32*)(F.ws + WS_CTL); }
static_assert(FIX_PURE == 1 && USE_EPI_CONV == 1 && !USE_SIMPLE_ML && !USE_SIMPLE_SSD, "the phase order (SSD before attention) needs the mLSTM output gate consumed in the chunk phase and the fused conv epilogue");
template <unsigned MASK>
__global__ void __launch_bounds__(NWAVES * 64, 2) mk_fwd(Args) {
    extern __shared__ __attribute__((aligned(16))) unsigned char lds[];
    { const int t0 = threadIdx.x; for (int u = t0; u < (LDS_BYTES - LDSCTL_OFF) / 4; u += NWAVES * 64) ((LAS unsigned*)((LAS unsigned char*)lds + LDSCTL_OFF))[u] = 0u; }
    __syncthreads();
    XcdBarrier bar = xcd_barrier_post((unsigned*)(kargs()->ws + WS_CTL) + CW_BAR, (volatile LAS unsigned*)((LAS unsigned char*)lds + MISC_OFF) + 8);
    int pid = 0;
#define PH_BEGIN(k) if constexpr ((MASK >> (k)) & 1u) if (kargs()->ph_lo <= pid && pid < kargs()->ph_hi) { \
        for (int rep_ = 0; rep_ < (((((unsigned)(REPEAT_MASK)) >> (k)) & 1u) && L == 0 ? 2 : 1); ++rep_) { MAKE_FRAME(F, A) unsigned char* const ws = F.ws; (void)ws; (void)A;
#define PH_END   } if (pid + 1 < kargs()->ph_hi) { bar.bar = (unsigned*)(kargs()->ws + WS_CTL) + CW_BAR; xcd_barrier(bar); if (PROBE_BAR2) xcd_barrier(bar); } } ++pid;
#define GEMM_IN(EPI, E, pn0, npn) GEMM_IN_GAP(EPI, E, pn0, npn, 1 << 30, 0)
#define GEMM_IN_GAP(EPI, E, pn0, npn, gap_at, gap_len) do { pg8::Gemm g{(const pg8::bf16_t*)(ws + WS_H), (const pg8::bf16_t*)(ws + WS_WIN), NT, NPN_IN * 256, 1024}; \
        pg8::RangeOrder S; S.init(NT, (npn), (pn0), F.G, F.bid, (gap_at), (gap_len)); \
        pg8::gemm_phase<EPI, pg8::RangeOrder, GEMM_ALIGN, GEMM_SP2>(F.lds + RING_OFF, g, S, E); } while (0)

    { constexpr int L = 0;
        PH_BEGIN(0)
            p_convert(F, A, L);
            if (L == 0) p_norm<0, 0>(F, A->in[I_X], F.out, A->in[I_N1W], (bf16*)(ws + WS_H));
            else p_norm<1, 0>(F, nullptr, F.out, A->in[I_N1W] + (size_t)L * D, (bf16*)(ws + WS_H));
        PH_END
        PH_BEGIN(1) { pg8::EpiProjConv E{ws + WS_PROJ, (pg8::bf16_t*)(ws + WS_YATT), (pg8::bf16_t*)(ws + WS_YSSD), A->in[I_MCW] + (size_t)L * 4 * 2048, A->in[I_MCB] + (size_t)L * 2048, (pg8::bf16_t*)(ws + WS_RAWH), 0.0625f,
                                            (pg8::bf16_t*)(ws + WS_XSSD), (pg8::bf16_t*)(ws + WS_PROJ + 1 * pg8::SLAB), A->in[I_SCW] + (size_t)L * 4 * 2048, A->in[I_SCB] + (size_t)L * 2048, (pg8::bf16_t*)(ws + WS_RAWH2)};
                      if (PROBE_EPINULL && rep_ == 1) { pg8::EpiNull EN;
                          if (PROBE_EPINULL == 2) { pg8::Gemm g{(const pg8::bf16_t*)(ws + WS_H), (const pg8::bf16_t*)(ws + WS_WIN), NT, NPN_IN * 256, 1024}; pg8::ConstOrder S{nullptr, nullptr, 14};
                                                    pg8::gemm_phase<pg8::EpiNull, pg8::ConstOrder, GEMM_ALIGN, GEMM_SP2>(F.lds + RING_OFF, g, S, EN); }
                          else GEMM_IN_GAP(pg8::EpiNull, EN, 0, 28, 16, 12); } else { GEMM_IN_GAP(pg8::EpiProjConv, E, 0, 28, 16, 12); } } if (!(PROBE_EPINULL && rep_ == 1)) p_small(F); PH_END
        PH_BEGIN(2) p_convfix(F, (bf16*)(ws + WS_YATT), (bf16*)(ws + WS_YSSD), A->in[I_MCW] + (size_t)L * 4 * 2048, A->in[I_MCB] + (size_t)L * 2048, 0.0625f, WS_RAWH);
                    p_convfix(F, (bf16*)(ws + WS_XSSD), (bf16*)(ws + WS_PROJ + 1 * pg8::SLAB), A->in[I_SCW] + (size_t)L * 4 * 2048, A->in[I_SCB] + (size_t)L * 2048, 1.0f, WS_RAWH2); p_fcum(F, A, L); PH_END
        PH_BEGIN(3) p_ml_chunk(F, A, L); if (PROBE_ML2 && L == 0) p_ml_chunk(F, A, L); p_ssd_chunk(F, A, L); PH_END
#if ATT_GUEST && !USE_SIMPLE_ATT
        PH_BEGIN(4) { pg8::EpiProj E{ws + WS_PROJ}; GEMM_IN(pg8::EpiProj, E, 16, 12); } PH_END
#else
#if PHASE_SPLIT
        PH_BEGIN(4) for (int pass = 0; pass < 2; ++pass) { if ((pass == 0) == ((F.bid & 8) == 0)) { p_fix<1>(F, A, L); p_fix<0>(F, A, L); } else { pg8::EpiProj E{ws + WS_PROJ}; GEMM_IN(pg8::EpiProj, E, 16, 12); } } PH_END
#else
        PH_BEGIN(4) if (PROBE_COPY && L == 0) { for (int pc = 0; pc < PROBE_COPY; ++pc) p_probe_copy(F, pc); } p_fix<1>(F, A, L); p_fix<0>(F, A, L); { pg8::EpiProj E{ws + WS_PROJ}; GEMM_IN(pg8::EpiProj, E, 16, 12); } PH_END
#endif
#endif
        PH_BEGIN(5)
#if USE_SIMPLE_ATT
            p_att_simple(F);
#else
            const attn_body::AttnTensors AT{(const attn_body::bf16*)(ws + WS_PROJ), (const attn_body::bf16*)(ws + WS_PROJ + pg8::SLAB), (const attn_body::bf16*)(ws + WS_PROJ + 2 * pg8::SLAB), (attn_body::bf16*)(ws + WS_YATT), (const float*)(ws + WS_FB)};
            const attn_body::StaticOrder S((int)F.G, (int)F.bid);
            const int g_n = (NT + (int)F.G * NWAVES - 1) / ((int)F.G * NWAVES);
            attn_body::Guest GU{(attn_body::bf16*)(ws + WS_YML), (attn_body::bf16*)(ws + WS_XSSD), (const float*)(ws + WS_SSQM), (const float*)(ws + WS_SSQS), ((int)F.bid * NWAVES + (int)F.wave) * g_n, ATT_GUEST ? 0 : g_n, g_n};
            attn_body::attn_phase<attn_body::StaticOrder, ATT_THRL>((char*)F.lds + RING_OFF, AT, S, GU);
#if ATT_GUEST
            for (; GU.k < GU.n; ++GU.k) { const int row = GU.row0 + GU.k; if (row < NT) { p_fix_row<1>(F, A, L, row); p_fix_row<0>(F, A, L, row); } }
#endif
#endif
        PH_END
#if GATE_FUSE
        PH_BEGIN(9)
            pg8::RangeOrder S0; S0.init(NT, 4, 0, F.G, F.bid); pg8::Unit u0; const bool any0 = S0.next(0, u0);
            const size_t TSTEP = (size_t)256 * 1024 * 2;
            const char* const hA0 = (const char*)(ws + WS_H) + (size_t)u0.pm * TSTEP;
            const pg8::EpiGate EG{ws + WS_PROJ, A->in[I_GB] + (size_t)L * 3072};
#define P9_GATE(b, CIN) do { pg8::Gemm g{(const pg8::bf16_t*)(ws + WS_H), (const pg8::bf16_t*)(ws + WS_WIN), NT, NPN_IN * 256, 1024}; pg8::RangeOrder S; S.init(NT, 4, 40 + 4 * (b), F.G, F.bid); \
                const size_t yoff_ = ((b) == 0) ? WS_YATT : ((b) == 1) ? WS_XSSD : WS_YML; \
                pg8::gemm_phase<pg8::EpiGate, pg8::RangeOrder, true, true, (CIN) && GEMM_CHAIN, GEMM_CHAIN>(F.lds + RING_OFF, g, S, EG, (const char*)(ws + yoff_) + (size_t)u0.pm * TSTEP, (const char*)(ws + WS_WBR) + (size_t)(b) * 2097152 + (size_t)u0.pn * TSTEP); \
                if (!GEMM_CHAIN) { asm volatile("s_waitcnt vmcnt(0)" ::: "memory"); __syncthreads(); } } while (0)
#define P9_MIX(b, COUT) do { const size_t yoff_ = ((b) == 0) ? WS_YATT : ((b) == 1) ? WS_XSSD : WS_YML; \
                pg8::Gemm g{(const pg8::bf16_t*)(ws + yoff_), (const pg8::bf16_t*)(ws + WS_WBR) + (size_t)(b) * 1048576, NT, 1024, 1024}; pg8::RangeOrder S; S.init(NT, 4, 0, F.G, F.bid); \
                pg8::EpiBranch E{(pg8::bf16_t*)(ws + WS_PROJ + 3 * pg8::SLAB), (const pg8::bf16_t*)(ws + WS_PROJ + (size_t)(b) * pg8::SLAB), (b) == 0 ? 1 : 0}; \
                pg8::gemm_phase<pg8::EpiBranch, pg8::RangeOrder, true, true, GEMM_CHAIN, (COUT) && GEMM_CHAIN>(F.lds + RING_OFF, g, S, E, hA0, (const char*)(ws + WS_WIN) + (size_t)(u0.pn + 40 + 4 * ((b) + 1)) * TSTEP); \
                if (!(GEMM_CHAIN && (COUT))) { asm volatile("s_waitcnt vmcnt(0)" ::: "memory"); __syncthreads(); } } while (0)
            if (any0) { P9_GATE(0, false); P9_MIX(0, true); P9_GATE(1, true); P9_MIX(1, true); P9_GATE(2, true); P9_MIX(2, false); }
#undef P9_GATE
#undef P9_MIX
        PH_END
#else
        PH_BEGIN(9) { pg8::EpiGate E{ws + WS_PROJ, A->in[I_GB] + (size_t)L * 3072}; GEMM_IN(pg8::EpiGate, E, 40, 12); } PH_END
        PH_BEGIN(10)
            for (int b = 0; b < 3; ++b) {
                const size_t yoff = (b == 0) ? WS_YATT : (b == 1) ? WS_XSSD : WS_YML;
                pg8::Gemm g{(const pg8::bf16_t*)(ws + yoff), (const pg8::bf16_t*)(ws + WS_WBR) + (size_t)b * 1048576, NT, 1024, 1024};
                pg8::RangeOrder S; S.init(NT, 4, 0, F.G, F.bid);
                pg8::EpiBranch E{(pg8::bf16_t*)(ws + WS_H), (const pg8::bf16_t*)(ws + WS_PROJ + (size_t)b * pg8::SLAB), b == 0 ? 1 : 0};
                pg8::gemm_phase<pg8::EpiBranch, pg8::RangeOrder, true, true>(F.lds + RING_OFF, g, S, E);
                asm volatile("s_waitcnt vmcnt(0)" ::: "memory"); __syncthreads();
            }
        PH_END
#endif
        PH_BEGIN(11)
            pg8::Gemm g{(const pg8::bf16_t*)(ws + (GATE_FUSE ? WS_PROJ + 3 * pg8::SLAB : WS_H)), (const pg8::bf16_t*)(ws + WS_WOUT), NT, 1024, 1024};
            pg8::RangeOrder S; S.init(NT, 4, 0, F.G, F.bid);
            pg8::EpiResid E{L == 0 ? A->in[I_X] : (const float*)F.out, F.out, (float*)(ws + WS_SSQS)};
            pg8::gemm_phase<pg8::EpiResid, pg8::RangeOrder, true, true>(F.lds + RING_OFF, g, S, E);
        PH_END
        PH_BEGIN(12) p_router(F, A, L); PH_END
        PH_BEGIN(13) p_gather(F, L); PH_END
        PH_BEGIN(14)
            if (!MOE_TABLE_ONCE) moe_table(F, L);
            pg8::Gemm g{(const pg8::bf16_t*)(ws + WS_H), (const pg8::bf16_t*)(ws + WS_WGU), NT, 65536, 1024};
            pg8::MoeOrderG S{(const PG8_LAS int*)(F.lds + TAB_OFF), F.G, F.bid, (const int*)(ws + WS_ROWTOK), (const PG8_LAS int*)(F.lds + LDSCTL_OFF + 2048)};
            pg8::EpiGU E{(pg8::bf16_t*)(ws + WS_ACT)};
            pg8::gemm_phase<pg8::EpiGU, pg8::MoeOrderG, true, true>(F.lds + RING_OFF, g, S, E);
        PH_END
        PH_BEGIN(15)
            if (!MOE_TABLE_ONCE) moe_table(F, L);
            pg8::Gemm g{(const pg8::bf16_t*)(ws + WS_ACT), (const pg8::bf16_t*)(ws + WS_WDN), PROWS, 65536, 512};
            pg8::MoeOrder S{(const PG8_LAS int*)(F.lds + TAB_OFF), F.G, F.bid, nullptr, nullptr};
            pg8::EpiRows E{(pg8::bf16_t*)(ws + WS_HG)};
            pg8::gemm_phase<pg8::EpiRows, pg8::MoeOrder, true, true>(F.lds + RING_OFF, g, S, E);
        PH_END
    }
    { constexpr int L = 1;
        PH_BEGIN(0)
            p_convert(F, A, L);
            if (L == 0) p_norm<0, 0>(F, A->in[I_X], F.out, A->in[I_N1W], (bf16*)(ws + WS_H));
            else p_norm<1, 0>(F, nullptr, F.out, A->in[I_N1W] + (size_t)L * D, (bf16*)(ws + WS_H));
        PH_END
        PH_BEGIN(1) { pg8::EpiProjConv E{ws + WS_PROJ, (pg8::bf16_t*)(ws + WS_YATT), (pg8::bf16_t*)(ws + WS_YSSD), A->in[I_MCW] + (size_t)L * 4 * 2048, A->in[I_MCB] + (size_t)L * 2048, (pg8::bf16_t*)(ws + WS_RAWH), 0.0625f,
                                            (pg8::bf16_t*)(ws + WS_XSSD), (pg8::bf16_t*)(ws + WS_PROJ + 1 * pg8::SLAB), A->in[I_SCW] + (size_t)L * 4 * 2048, A->in[I_SCB] + (size_t)L * 2048, (pg8::bf16_t*)(ws + WS_RAWH2)};
                      if (PROBE_EPINULL && rep_ == 1) { pg8::EpiNull EN;
                          if (PROBE_EPINULL == 2) { pg8::Gemm g{(const pg8::bf16_t*)(ws + WS_H), (const pg8::bf16_t*)(ws + WS_WIN), NT, NPN_IN * 256, 1024}; pg8::ConstOrder S{nullptr, nullptr, 14};
                                                    pg8::gemm_phase<pg8::EpiNull, pg8::ConstOrder, GEMM_ALIGN, GEMM_SP2>(F.lds + RING_OFF, g, S, EN); }
                          else GEMM_IN_GAP(pg8::EpiNull, EN, 0, 28, 16, 12); } else { GEMM_IN_GAP(pg8::EpiProjConv, E, 0, 28, 16, 12); } } if (!(PROBE_EPINULL && rep_ == 1)) p_small(F); PH_END
        PH_BEGIN(2) p_convfix(F, (bf16*)(ws + WS_YATT), (bf16*)(ws + WS_YSSD), A->in[I_MCW] + (size_t)L * 4 * 2048, A->in[I_MCB] + (size_t)L * 2048, 0.0625f, WS_RAWH);
                    p_convfix(F, (bf16*)(ws + WS_XSSD), (bf16*)(ws + WS_PROJ + 1 * pg8::SLAB), A->in[I_SCW] + (size_t)L * 4 * 2048, A->in[I_SCB] + (size_t)L * 2048, 1.0f, WS_RAWH2); p_fcum(F, A, L); PH_END
        PH_BEGIN(3) p_ml_chunk(F, A, L); if (PROBE_ML2 && L == 0) p_ml_chunk(F, A, L); p_ssd_chunk(F, A, L); PH_END
#if ATT_GUEST && !USE_SIMPLE_ATT
        PH_BEGIN(4) { pg8::EpiProj E{ws + WS_PROJ}; GEMM_IN(pg8::EpiProj, E, 16, 12); } PH_END
#else
#if PHASE_SPLIT
        PH_BEGIN(4) for (int pass = 0; pass < 2; ++pass) { if ((pass == 0) == ((F.bid & 8) == 0)) { p_fix<1>(F, A, L); p_fix<0>(F, A, L); } else { pg8::EpiProj E{ws + WS_PROJ}; GEMM_IN(pg8::EpiProj, E, 16, 12); } } PH_END
#else
        PH_BEGIN(4) if (PROBE_COPY && L == 0) { for (int pc = 0; pc < PROBE_COPY; ++pc) p_probe_copy(F, pc); } p_fix<1>(F, A, L); p_fix<0>(F, A, L); { pg8::EpiProj E{ws + WS_PROJ}; GEMM_IN(pg8::EpiProj, E, 16, 12); } PH_END
#endif
#endif
        PH_BEGIN(5)
#if USE_SIMPLE_ATT
            p_att_simple(F);
#else
            const attn_body::AttnTensors AT{(const attn_body::bf16*)(ws + WS_PROJ), (const attn_body::bf16*)(ws + WS_PROJ + pg8::SLAB), (const attn_body::bf16*)(ws + WS_PROJ + 2 * pg8::SLAB), (attn_body::bf16*)(ws + WS_YATT), (const float*)(ws + WS_FB)};
            const attn_body::StaticOrder S((int)F.G, (int)F.bid);
            const int g_n = (NT + (int)F.G * NWAVES - 1) / ((int)F.G * NWAVES);
            attn_body::Guest GU{(attn_body::bf16*)(ws + WS_YML), (attn_body::bf16*)(ws + WS_XSSD), (const float*)(ws + WS_SSQM), (const float*)(ws + WS_SSQS), ((int)F.bid * NWAVES + (int)F.wave) * g_n, ATT_GUEST ? 0 : g_n, g_n};
            attn_body::attn_phase<attn_body::StaticOrder, ATT_THRL>((char*)F.lds + RING_OFF, AT, S, GU);
#if ATT_GUEST
            for (; GU.k < GU.n; ++GU.k) { const int row = GU.row0 + GU.k; if (row < NT) { p_fix_row<1>(F, A, L, row); p_fix_row<0>(F, A, L, row); } }
#endif
#endif
        PH_END
#if GATE_FUSE
        PH_BEGIN(9)
            pg8::RangeOrder S0; S0.init(NT, 4, 0, F.G, F.bid); pg8::Unit u0; const bool any0 = S0.next(0, u0);
            const size_t TSTEP = (size_t)256 * 1024 * 2;
            const char* const hA0 = (const char*)(ws + WS_H) + (size_t)u0.pm * TSTEP;
            const pg8::EpiGate EG{ws + WS_PROJ, A->in[I_GB] + (size_t)L * 3072};
#define P9_GATE(b, CIN) do { pg8::Gemm g{(const pg8::bf16_t*)(ws + WS_H), (const pg8::bf16_t*)(ws + WS_WIN), NT, NPN_IN * 256, 1024}; pg8::RangeOrder S; S.init(NT, 4, 40 + 4 * (b), F.G, F.bid); \
                const size_t yoff_ = ((b) == 0) ? WS_YATT : ((b) == 1) ? WS_XSSD : WS_YML; \
                pg8::gemm_phase<pg8::EpiGate, pg8::RangeOrder, true, true, (CIN) && GEMM_CHAIN, GEMM_CHAIN>(F.lds + RING_OFF, g, S, EG, (const char*)(ws + yoff_) + (size_t)u0.pm * TSTEP, (const char*)(ws + WS_WBR) + (size_t)(b) * 2097152 + (size_t)u0.pn * TSTEP); \
                if (!GEMM_CHAIN) { asm volatile("s_waitcnt vmcnt(0)" ::: "memory"); __syncthreads(); } } while (0)
#define P9_MIX(b, COUT) do { const size_t yoff_ = ((b) == 0) ? WS_YATT : ((b) == 1) ? WS_XSSD : WS_YML; \
                pg8::Gemm g{(const pg8::bf16_t*)(ws + yoff_), (const pg8::bf16_t*)(ws + WS_WBR) + (size_t)(b) * 1048576, NT, 1024, 1024}; pg8::RangeOrder S; S.init(NT, 4, 0, F.G, F.bid); \
                pg8::EpiBranch E{(pg8::bf16_t*)(ws + WS_PROJ + 3 * pg8::SLAB), (const pg8::bf16_t*)(ws + WS_PROJ + (size_t)(b) * pg8::SLAB), (b) == 0 ? 1 : 0}; \
                pg8::gemm_phase<pg8::EpiBranch, pg8::RangeOrder, true, true, GEMM_CHAIN, (COUT) && GEMM_CHAIN>(F.lds + RING_OFF, g, S, E, hA0, (const char*)(ws + WS_WIN) + (size_t)(u0.pn + 40 + 4 * ((b) + 1)) * TSTEP); \
                if (!(GEMM_CHAIN && (COUT))) { asm volatile("s_waitcnt vmcnt(0)" ::: "memory"); __syncthreads(); } } while (0)
            if (any0) { P9_GATE(0, false); P9_MIX(0, true); P9_GATE(1, true); P9_MIX(1, true); P9_GATE(2, true); P9_MIX(2, false); }
#undef P9_GATE
#undef P9_MIX
        PH_END
#else
        PH_BEGIN(9) { pg8::EpiGate E{ws + WS_PROJ, A->in[I_GB] + (size_t)L * 3072}; GEMM_IN(pg8::EpiGate, E, 40, 12); } PH_END
        PH_BEGIN(10)
            for (int b = 0; b < 3; ++b) {
                const size_t yoff = (b == 0) ? WS_YATT : (b == 1) ? WS_XSSD : WS_YML;
                pg8::Gemm g{(const pg8::bf16_t*)(ws + yoff), (const pg8::bf16_t*)(ws + WS_WBR) + (size_t)b * 1048576, NT, 1024, 1024};
                pg8::RangeOrder S; S.init(NT, 4, 0, F.G, F.bid);
                pg8::EpiBranch E{(pg8::bf16_t*)(ws + WS_H), (const pg8::bf16_t*)(ws + WS_PROJ + (size_t)b * pg8::SLAB), b == 0 ? 1 : 0};
                pg8::gemm_phase<pg8::EpiBranch, pg8::RangeOrder, true, true>(F.lds + RING_OFF, g, S, E);
                asm volatile("s_waitcnt vmcnt(0)" ::: "memory"); __syncthreads();
            }
        PH_END
#endif
        PH_BEGIN(11)
            pg8::Gemm g{(const pg8::bf16_t*)(ws + (GATE_FUSE ? WS_PROJ + 3 * pg8::SLAB : WS_H)), (const pg8::bf16_t*)(ws + WS_WOUT), NT, 1024, 1024};
            pg8::RangeOrder S; S.init(NT, 4, 0, F.G, F.bid);
            pg8::EpiResid E{L == 0 ? A->in[I_X] : (const float*)F.out, F.out, (float*)(ws + WS_SSQS)};
            pg8::gemm_phase<pg8::EpiResid, pg8::RangeOrder, true, true>(F.lds + RING_OFF, g, S, E);
        PH_END
        PH_BEGIN(12) p_router(F, A, L); PH_END
        PH_BEGIN(13) p_gather(F, L); PH_END
        PH_BEGIN(14)
            if (!MOE_TABLE_ONCE) moe_table(F, L);
            pg8::Gemm g{(const pg8::bf16_t*)(ws + WS_H), (const pg8::bf16_t*)(ws + WS_WGU), NT, 65536, 1024};
            pg8::MoeOrderG S{(const PG8_LAS int*)(F.lds + TAB_OFF), F.G, F.bid, (const int*)(ws + WS_ROWTOK), (const PG8_LAS int*)(F.lds + LDSCTL_OFF + 2048)};
            pg8::EpiGU E{(pg8::bf16_t*)(ws + WS_ACT)};
            pg8::gemm_phase<pg8::EpiGU, pg8::MoeOrderG, true, true>(F.lds + RING_OFF, g, S, E);
        PH_END
        PH_BEGIN(15)
            if (!MOE_TABLE_ONCE) moe_table(F, L);
            pg8::Gemm g{(const pg8::bf16_t*)(ws + WS_ACT), (const pg8::bf16_t*)(ws + WS_WDN), PROWS, 65536, 512};
            pg8::MoeOrder S{(const PG8_LAS int*)(F.lds + TAB_OFF), F.G, F.bid, nullptr, nullptr};
            pg8::EpiRows E{(pg8::bf16_t*)(ws + WS_HG)};
            pg8::gemm_phase<pg8::EpiRows, pg8::MoeOrder, true, true>(F.lds + RING_OFF, g, S, E);
        PH_END
    }
    constexpr int L = -1;
    PH_BEGIN(16) p_norm<1, 1>(F, nullptr, F.out, A->in[I_FNW], nullptr); PH_END
#ifdef DBG_STOP
    if constexpr ((MASK >> 17) & 1u) {
        KArgs A = kargs(); unsigned char* ws = A->ws; float* out = A->out; const size_t offs[4] = {DBG_D0, DBG_D1, DBG_D2, DBG_D3};
        for (size_t i = (size_t)blockIdx.x * 512 + threadIdx.x; i < (size_t)NT * D; i += (size_t)gridDim.x * 512) { float v = 0.f;
            for (int k = 0; k < 4; ++k) if (offs[k]) v += bf2f(((const bf16*)(ws + offs[k]))[i]);
            out[i] = v; }
    }
#endif
#undef PH_BEGIN
#undef PH_END
#undef GEMM_IN
}
constexpr int PIDS_PER_LAYER = 13 - (GATE_FUSE ? 1 : 0);

typedef void (*kern_t)(Args);
extern "C" void kernel_launch(void* const* d_in, const int* in_sizes, int n_in, void* d_out, int out_size, void* d_ws, size_t ws_size, hipStream_t stream) {
    static int grid = 0;
#if defined(ONLY_KIND)
    static const kern_t kerns[1] = { mk_fwd<1u << ONLY_KIND> };
    constexpr int NK = 1;
#elif MK_N_LAUNCHES == 1
    static const kern_t kerns[1] = { mk_fwd<0xffffffffu> };
    constexpr int NK = 1;
#else
    static const kern_t kerns[18] = { mk_fwd<1u << 0>, mk_fwd<1u << 1>, mk_fwd<1u << 2>, mk_fwd<1u << 3>, mk_fwd<1u << 4>, mk_fwd<1u << 5>, mk_fwd<1u << 6>, mk_fwd<1u << 7>, mk_fwd<1u << 8>, mk_fwd<1u << 9>,
                                      mk_fwd<1u << 10>, mk_fwd<1u << 11>, mk_fwd<1u << 12>, mk_fwd<1u << 13>, mk_fwd<1u << 14>, mk_fwd<1u << 15>, mk_fwd<1u << 16>, mk_fwd<1u << 17> };
    constexpr int NK = 18;
#endif
    if (grid == 0) {
        if (n_in != 27 || in_sizes[0] != NT * D || out_size != NT * D || ws_size < WS_END) { fprintf(stderr, "kernel_launch: unexpected shapes (n_in %d, in0 %d, out %d, ws %zu < %zu); nothing launched\n", n_in, n_in > 0 ? in_sizes[0] : -1, out_size, ws_size, (size_t)WS_END); grid = -1; return; }
        int dev = 0, cus = 0, per_cu = 0;
        if (hipGetDevice(&dev) != hipSuccess || hipDeviceGetAttribute(&cus, hipDeviceAttributeMultiprocessorCount, dev) != hipSuccess) { grid = -1; return; }
        for (int k = 0; k < NK; ++k)
            if (hipFuncSetAttribute((const void*)kerns[k], hipFuncAttributeMaxDynamicSharedMemorySize, LDS_BYTES) != hipSuccess) { fprintf(stderr, "kernel_launch: hipFuncSetAttribute failed\n"); grid = -1; return; }
        if (hipOccupancyMaxActiveBlocksPerMultiprocessor(&per_cu, (const void*)kerns[0], NWAVES * 64, LDS_BYTES) != hipSuccess || per_cu < 1) { fprintf(stderr, "kernel_launch: occupancy query says %d\n", per_cu); }
        (void)hipGetLastError();
        grid = cus;
    }
    if (grid < 0) return;
    if (hipMemsetAsync((char*)d_ws + WS_CTL, 0, CTL_ZERO_BYTES, stream) != hipSuccess) return;
    Args a{};
    for (int i = 0; i < 27; ++i) a.in[i] = (const float*)d_in[i];
    a.out = (float*)d_out; a.ws = (unsigned char*)d_ws;
    constexpr int NPH = DEPTH * PIDS_PER_LAYER + 1;
#if MK_N_LAUNCHES == 1
    a.ph_lo = 0; a.ph_hi = NPH;
    hipLaunchKernelGGL(kerns[0], dim3(grid), dim3(NWAVES * 64), LDS_BYTES, stream, a);
#else
    int kind_of[PIDS_PER_LAYER]; { int n = 0; for (int k = 0; k < 16; ++k) { if (k >= 6 && k <= 8) continue; kind_of[n++] = k; } }
#ifdef DBG_STOP
    constexpr int NPH_RUN = DBG_STOP;
#else
    constexpr int NPH_RUN = NPH;
#endif
    for (int p = 0; p < NPH_RUN; ++p) { a.ph_lo = p; a.ph_hi = p + 1; const int k = (p == NPH - 1) ? 16 : kind_of[p % PIDS_PER_LAYER];
        hipLaunchKernelGGL(kerns[k], dim3(grid), dim3(NWAVES * 64), LDS_BYTES, stream, a); }
#ifdef DBG_STOP
    if (DBG_D0) { a.ph_lo = 1000; a.ph_hi = 1000; hipLaunchKernelGGL(kerns[17], dim3(grid), dim3(NWAVES * 64), LDS_BYTES, stream, a); }
#endif
#endif
    const hipError_t le = hipPeekAtLastError();
    if (le != hipSuccess) fprintf(stderr, "kernel_launch: launch failed: %s\n", hipGetErrorName(le));
}
```

```cpp
#define MK_N_LAUNCHES 1
#define ATT_THRL 32
#include <hip/hip_runtime.h>
#include <cstdio>
#include <cstdint>
#ifndef MK_N_LAUNCHES
#define MK_N_LAUNCHES 1
#endif
#ifndef PHMASK
#define PHMASK 0xffffffffffffffffull
#endif
#ifndef USE_SIMPLE_ML
#define USE_SIMPLE_ML 0
#endif
#ifndef USE_SIMPLE_SSD
#define USE_SIMPLE_SSD 0
#endif
#ifndef USE_SIMPLE_ATT
#define USE_SIMPLE_ATT 0
#endif
#ifndef REPEAT_MASK
#define REPEAT_MASK 0
#endif
#ifndef ATT_THRL
#define ATT_THRL 24
#endif
#ifndef GEMM_ALIGN
#define GEMM_ALIGN true
#endif
#ifndef GEMM_SP2
#define GEMM_SP2 true
#endif
#ifndef PROBE_BAR2
#define PROBE_BAR2 0
#endif
#ifndef PROBE_CHUNK_BAR
#define PROBE_CHUNK_BAR 0
#endif
#ifndef PROBE_DUP_X
#define PROBE_DUP_X 0
#endif
#ifndef PROBE_SEC
#define PROBE_SEC 0
#endif
#ifndef PG8_WGM
#define PG8_WGM 8
#endif
#ifndef USE_EPI_CONV
#define USE_EPI_CONV 1
#endif
#ifndef USE_GUEST_CVT
#define USE_GUEST_CVT 1
#endif
#ifndef ATT_GUEST
#define ATT_GUEST 0
#endif
#ifndef FIX_PURE
#define FIX_PURE 1
#endif
#ifndef MOE_ROWSKIP
#define MOE_ROWSKIP 2
#endif
#ifndef PROBE_ML2
#define PROBE_ML2 0
#endif
#ifndef PROBE_COPY
#define PROBE_COPY 0
#endif
#ifndef USE_NT
#define USE_NT 1
#endif
#if USE_NT
#define NT_LOAD(p) __builtin_nontemporal_load(p)
#define NT_STORE(v, p) __builtin_nontemporal_store((v), (p))
#else
#define NT_LOAD(p) (*(p))
#define NT_STORE(v, p) (*(p) = (v))
#endif
#ifndef NT_EPI
#define NT_EPI 0
#endif
#if NT_EPI
#define EPI_STORE(v, p) __builtin_nontemporal_store((v), (p))
#else
#define EPI_STORE(v, p) (*(p) = (v))
#endif
#ifndef MOE_B_NT
#define MOE_B_NT 0
#endif
#ifndef ROUTER_NT
#define ROUTER_NT 0
#endif
#ifndef SSD_ZPRE
#define SSD_ZPRE 1
#endif
#ifndef SSD_VEARLY
#define SSD_VEARLY 0
#endif
#ifndef RESID_SSQ
#define RESID_SSQ 1
#endif
#ifndef GATE_FUSE
#define GATE_FUSE 1
#endif
#ifndef MOE_XCD
#define MOE_XCD 1
#endif
#ifndef ATT_PK
#define ATT_PK 1
#endif
#ifndef ATT_KBPRE
#define ATT_KBPRE 0
#endif
#ifndef PROBE_EPINULL
#define PROBE_EPINULL 0
#endif
#ifndef ATT_PRE
#define ATT_PRE 1
#endif
#ifndef GEMM_CHAIN
#define GEMM_CHAIN 0
#endif
#ifndef PHASE_SPLIT
#define PHASE_SPLIT 0
#endif
#ifndef ROUTER_2LVL
#define ROUTER_2LVL 1
#endif
#ifndef ROUTER_NOATOM
#define ROUTER_NOATOM 0
#endif
#ifndef MOE_TABLE_ONCE
#define MOE_TABLE_ONCE 0
#endif
namespace pg8 {
#define PG8_LAS __attribute__((address_space(3)))
typedef unsigned short bf16_t;
typedef short bf16x8 __attribute__((ext_vector_type(8)));
typedef float f32x4 __attribute__((ext_vector_type(4)));
typedef unsigned u32x4 __attribute__((ext_vector_type(4)));
typedef unsigned u32x2 __attribute__((ext_vector_type(2)));
constexpr int BM = 256, BK = 64, HALF = 128, HTB = HALF * BK * 2  , STAGE_BYTES = 8 * HTB, NXCD = 8, WGM = PG8_WGM;

__host__ __device__ __forceinline__ int lds_byte(int r, int c) { const int st = (r >> 4) * 2 + (c >> 5), rr = r & 15, cc = c & 31, ob = rr * 64 + cc * 2; return st * 1024 + (ob ^ (((ob >> 9) & 1) << 5)); }
__host__ __device__ __forceinline__ void stage_rc(int b, int& R, int& C) { const int st = b / 1024, sb = b % 1024, swz = sb ^ (((sb >> 9) & 1) << 5); R = (st >> 1) * 16 + swz / 64; C = (st & 1) * 32 + (swz % 64) / 2; }
__host__ __device__ __forceinline__ int perm32(int rho) { const int n = rho >> 4, i = rho & 15; return 8 * (i >> 2) + 4 * n + (i & 3); }

constexpr int MOE_ORDER_OFF = 768;
struct Unit { int pm, pn; int rows; };
struct Gemm { const bf16_t* A; const bf16_t* Bt; int M, N, K; };

struct StaticOrder {
    static constexpr bool ROWSKIP = false, B_NT = false;
    int nM, nN, nwg, G, c;
    __host__ __device__ void init(int M, int N, int G_, int c_) { nM = M / BM; nN = N / BM; nwg = nM * nN; G = G_; c = c_; }
    __host__ __device__ bool next(int i, Unit& u) const {
        const long L = (long)i * G + c; if (L >= nwg) return false;
        int wgid = (int)L; { const int q = nwg / NXCD, r = nwg % NXCD, xcd = wgid % NXCD, off = wgid / NXCD; wgid = (xcd < r ? xcd * (q + 1) : r * (q + 1) + (xcd - r) * q) + off; }
        const int nig = WGM * nN, gid = wgid / nig, fm = gid * WGM, gsz = (nM - fm) < WGM ? (nM - fm) : WGM;
        u.pm = fm + ((wgid % nig) % gsz); u.pn = (wgid % nig) / gsz; return true;
    }
    __device__ __forceinline__ void a_ready(const Unit&) const {}
    __device__ __forceinline__ void done(const Unit&) const {}
};

typedef float cvt_f32x2 __attribute__((ext_vector_type(2))); typedef __bf16 cvt_bf16x2 __attribute__((ext_vector_type(2)));
__device__ __forceinline__ unsigned cvt_pk_bf16(float lo, float hi) { const cvt_f32x2 v = {lo, hi}; const cvt_bf16x2 b = __builtin_convertvector(v, cvt_bf16x2); return __builtin_bit_cast(unsigned, b); }
typedef float f32x2 __attribute__((ext_vector_type(2)));
__device__ __forceinline__ f32x2 gelu_pk(f32x2 v) {
    const f32x2 av = __builtin_elementwise_abs(v), d = av * 0.2316418882f + 1.0f;
    f32x2 t; t.x = __builtin_amdgcn_rcpf(d.x); t.y = __builtin_amdgcn_rcpf(d.y);
    f32x2 q = t * 0.5307027145f + (-0.7265760135f); q = q * t + 0.7107068705f; q = q * t + (-0.142248368f); q = q * t + 0.127414796f; q = q * t;
    const f32x2 s = (v * v) * (-0.72134752044f);
    f32x2 e; e.x = __builtin_amdgcn_exp2f(s.x); e.y = __builtin_amdgcn_exp2f(s.y);
    const f32x2 m = v * (q * e), r = v - m;
    f32x2 o; o.x = v.x < 0.f ? m.x : r.x; o.y = v.y < 0.f ? m.y : r.y; return o;
}

__device__ __forceinline__ float fast_sigmoid(float x) { return __builtin_amdgcn_rcpf(1.0f + __expf(-x)); }
__device__ __forceinline__ float bf_lo(unsigned w) { return __builtin_bit_cast(float, w << 16); }
__device__ __forceinline__ float bf_hi(unsigned w) { return __builtin_bit_cast(float, w & 0xffff0000u); }
constexpr size_t SLAB = (size_t)64 << 20;

struct EpiProj {
    static constexpr bool PERM = true, AFTER_DRAIN = false;
    unsigned char* proj;
    __device__ __forceinline__ void operator()(const f32x4 (&acc)[2][2][4][2], const Unit& u, int wr, int wc, int fr, int fq) const {
        const int pn = u.pn; const int row0 = u.pm * BM + wr * 64 + fr;
        int ldc = 1024, colt; size_t boff;
        if (pn < 16) { boff = (size_t)(pn >> 2) * SLAB; colt = (pn & 3) * 256; }
        else if (pn < 28) { const int q = pn - 16; boff = (size_t)(q >> 2) * SLAB; colt = (q & 3) * 256; }
        else if (pn < 32) { boff = 0; colt = (pn - 28) * 256; }
        else { boff = SLAB; ldc = 2048; colt = (pn - 32) * 256; }
        bf16_t* base = (bf16_t*)(proj + boff) + colt + wc * 32 + 8 * fq;
        const float sc = (!USE_SIMPLE_ATT && pn >= 16 && pn < 20) ? 0.125f * 1.4426950408889634f : 1.0f;
#pragma unroll
        for (int ai = 0; ai < 2; ++ai)
#pragma unroll
            for (int m = 0; m < 4; ++m) { bf16_t* rowp = base + (size_t)(row0 + ai * HALF + m * 16) * ldc;
#pragma unroll
                for (int bj = 0; bj < 2; ++bj) { const f32x4 v0 = acc[ai][bj][m][0] * sc, v1 = acc[ai][bj][m][1] * sc;
                    u32x4 w; w.x = cvt_pk_bf16(v0[0], v0[1]); w.y = cvt_pk_bf16(v0[2], v0[3]); w.z = cvt_pk_bf16(v1[0], v1[1]); w.w = cvt_pk_bf16(v1[2], v1[3]);
                    EPI_STORE(w, (u32x4*)(rowp + bj * HALF)); } }
    }
};
template <int CTRL> __device__ __forceinline__ float dppf(float v) { return __builtin_bit_cast(float, __builtin_amdgcn_update_dpp(0, __builtin_bit_cast(int, v), CTRL, 0xF, 0xF, true)); }
struct EpiProjConv {
    static constexpr bool PERM = true, AFTER_DRAIN = false;
    unsigned char* proj; bf16_t* d0a; bf16_t* d1a; const float* cwa; const float* cba; bf16_t* rawha; float sc1a;
    bf16_t* d0b; bf16_t* d1b; const float* cwb; const float* cbb; bf16_t* rawhb;
    __device__ __forceinline__ void operator()(const f32x4 (&acc)[2][2][4][2], const Unit& u, int wr, int wc, int fr, int fq) const {
        const int pn = u.pn; const int row0 = u.pm * BM + wr * 64 + fr;
        const int mode = pn >= 28 ? 1 : 0;
        bf16_t* const d0 = mode ? d0b : d0a; bf16_t* const d1 = mode ? d1b : d1a; const float* const cw = mode ? cwb : cwa; const float* const cb = mode ? cbb : cba; bf16_t* const rawh = mode ? rawhb : rawha; const float sc1 = mode ? 1.0f : sc1a;
        int q, which; bool conv;
        if (mode == 0) { q = pn; conv = q < 8; which = q >> 2; } else { q = pn - 28; conv = q >= 4; which = (q - 4) >> 2; }
        if (!conv) {
            bf16_t* base = (bf16_t*)(proj + (mode == 0 ? (size_t)(q >> 2) * SLAB : (size_t)0)) + (q & 3) * 256 + wc * 32 + 8 * fq;
#pragma unroll
            for (int ai = 0; ai < 2; ++ai)
#pragma unroll
                for (int m = 0; m < 4; ++m) { bf16_t* rowp = base + (size_t)(row0 + ai * HALF + m * 16) * 1024;
#pragma unroll
                    for (int bj = 0; bj < 2; ++bj) { const f32x4 v0 = acc[ai][bj][m][0], v1 = acc[ai][bj][m][1];
                        u32x4 w; w.x = cvt_pk_bf16(v0[0], v0[1]); w.y = cvt_pk_bf16(v0[2], v0[3]); w.z = cvt_pk_bf16(v1[0], v1[1]); w.w = cvt_pk_bf16(v1[2], v1[3]);
                        EPI_STORE(w, (u32x4*)(rowp + bj * HALF)); } }
            return;
        }
        bf16_t* dst = (which ? d1 : d0) + (q & 3) * 256 + wc * 32 + 8 * fq; const float sc = which ? sc1 : 1.0f;
        const int cc0 = which * 1024 + (q & 3) * 256 + wc * 32 + 8 * fq;
        const int blk0 = u.pm * 4 + wr;
#pragma unroll
        for (int bj = 0; bj < 2; ++bj)
#pragma unroll
        for (int h = 0; h < 2; ++h) {
            const int cc = cc0 + bj * HALF + 4 * h;
            const f32x4 w0 = *(const f32x4*)(cw + cc), w1 = *(const f32x4*)(cw + 2048 + cc), w2 = *(const f32x4*)(cw + 4096 + cc), w3 = *(const f32x4*)(cw + 6144 + cc), bb = *(const f32x4*)(cb + cc);
#pragma unroll
            for (int ai = 0; ai < 2; ++ai) {
                f32x4 xp = {0.f, 0.f, 0.f, 0.f};
#pragma unroll
                for (int m = 0; m < 4; ++m) {
                    const f32x4 x = acc[ai][bj][m][h]; float y[4];
#pragma unroll
                    for (int e = 0; e < 4; ++e) {
                        const float h1 = dppf<0x111>(x[e]) + dppf<0x10F>(xp[e]);
                        const float h2 = dppf<0x112>(x[e]) + dppf<0x10E>(xp[e]);
                        const float h3 = dppf<0x113>(x[e]) + dppf<0x10D>(xp[e]);
                        const float t = bb[e] + w3[e] * x[e] + w2[e] * h1 + w1[e] * h2 + w0[e] * h3;
                        y[e] = t * fast_sigmoid(t) * sc; }
                    const size_t r = (size_t)(row0 + ai * HALF + m * 16);
                    u32x2 o; o.x = cvt_pk_bf16(y[0], y[1]); o.y = cvt_pk_bf16(y[2], y[3]);
                    EPI_STORE(o, (u32x2*)(dst + r * 1024 + bj * HALF + 4 * h));
                    if (m == 0 || m == 3) {
                        const bool lo3 = (m == 0) && fr < 3, hi3 = (m == 3) && fr >= 13;
                        if (lo3 || hi3) { const int blk = blk0 + 2 * ai + (hi3 ? 1 : 0), slot = hi3 ? fr - 13 : 3 + fr;
                            u32x2 rw; rw.x = cvt_pk_bf16(x[0], x[1]); rw.y = cvt_pk_bf16(x[2], x[3]);
                            *(u32x2*)(rawh + ((size_t)blk * 6 + slot) * 2048 + cc) = rw; } }
                    xp = x;
                }
            }
        }
    }
};

struct EpiNull {
    static constexpr bool PERM = true, AFTER_DRAIN = false;
    __device__ __forceinline__ void operator()(const f32x4 (&acc)[2][2][4][2], const Unit&, int, int, int, int) const {
#pragma unroll
        for (int ai = 0; ai < 2; ++ai)
#pragma unroll
            for (int bj = 0; bj < 2; ++bj)
#pragma unroll
                for (int m = 0; m < 4; ++m) asm volatile("" :: "v"(acc[ai][bj][m][0]), "v"(acc[ai][bj][m][1]));
    }
};
struct EpiGate {
    static constexpr bool PERM = true, AFTER_DRAIN = false;
    unsigned char* proj; const float* gate_bias;
    __device__ __forceinline__ void operator()(const f32x4 (&acc)[2][2][4][2], const Unit& u, int wr, int wc, int fr, int fq) const {
        const int q = u.pn - 40; const int row0 = u.pm * BM + wr * 64 + fr;
        bf16_t* base = (bf16_t*)(proj + (size_t)(q >> 2) * SLAB) + (q & 3) * 256 + wc * 32 + 8 * fq;
        const float* bp = gate_bias + q * 256 + wc * 32 + 8 * fq;
#pragma unroll
        for (int bj = 0; bj < 2; ++bj) { const f32x4 b0 = *(const f32x4*)(bp + bj * HALF), b1 = *(const f32x4*)(bp + bj * HALF + 4);
#pragma unroll
            for (int ai = 0; ai < 2; ++ai)
#pragma unroll
                for (int m = 0; m < 4; ++m) { f32x4 v0 = acc[ai][bj][m][0] + b0, v1 = acc[ai][bj][m][1] + b1;
#pragma unroll
                    for (int e = 0; e < 4; ++e) { v0[e] = fast_sigmoid(v0[e]); v1[e] = fast_sigmoid(v1[e]); }
                    u32x4 w; w.x = cvt_pk_bf16(v0[0], v0[1]); w.y = cvt_pk_bf16(v0[2], v0[3]); w.z = cvt_pk_bf16(v1[0], v1[1]); w.w = cvt_pk_bf16(v1[2], v1[3]);
                    EPI_STORE(w, (u32x4*)(base + (size_t)(row0 + ai * HALF + m * 16) * 1024 + bj * HALF)); } }
    }
};

struct EpiBranch {
    static constexpr bool PERM = true, AFTER_DRAIN = false;
    bf16_t* U; const bf16_t* G; int first;
    __device__ __forceinline__ void operator()(const f32x4 (&acc)[2][2][4][2], const Unit& u, int wr, int wc, int fr, int fq) const {
        const int row0 = u.pm * BM + wr * 64 + fr, col0 = u.pn * BM + wc * 32 + 8 * fq;
#pragma unroll
        for (int ai = 0; ai < 2; ++ai)
#pragma unroll
            for (int mh = 0; mh < 2; ++mh) {
                u32x4 g[2][2], o[2][2];
#pragma unroll
                for (int mm = 0; mm < 2; ++mm)
#pragma unroll
                    for (int bj = 0; bj < 2; ++bj) { const size_t ro = (size_t)(row0 + ai * HALF + (2 * mh + mm) * 16) * 1024 + col0 + bj * HALF;
                        g[mm][bj] = NT_LOAD((const u32x4*)(G + ro)); o[mm][bj] = (u32x4){0u, 0u, 0u, 0u}; if (!first) o[mm][bj] = *(const u32x4*)(U + ro); }
#pragma unroll
                for (int mm = 0; mm < 2; ++mm)
#pragma unroll
                    for (int bj = 0; bj < 2; ++bj) { const int m = 2 * mh + mm; const size_t ro = (size_t)(row0 + ai * HALF + m * 16) * 1024 + col0 + bj * HALF;
                        const f32x4 a0 = acc[ai][bj][m][0], a1 = acc[ai][bj][m][1]; const u32x4 gg = g[mm][bj], oo = o[mm][bj]; u32x4 w;
                        w.x = cvt_pk_bf16(bf_lo(oo.x) + bf_lo(gg.x) * a0[0], bf_hi(oo.x) + bf_hi(gg.x) * a0[1]);
                        w.y = cvt_pk_bf16(bf_lo(oo.y) + bf_lo(gg.y) * a0[2], bf_hi(oo.y) + bf_hi(gg.y) * a0[3]);
                        w.z = cvt_pk_bf16(bf_lo(oo.z) + bf_lo(gg.z) * a1[0], bf_hi(oo.z) + bf_hi(gg.z) * a1[1]);
                        w.w = cvt_pk_bf16(bf_lo(oo.w) + bf_lo(gg.w) * a1[2], bf_hi(oo.w) + bf_hi(gg.w) * a1[3]);
                        *(u32x4*)(U + ro) = w; }
            }
    }
};

struct EpiResid {
    static constexpr bool PERM = true, AFTER_DRAIN = false;
    const float* src; float* dst; float* ssq;
    __device__ __forceinline__ void operator()(const f32x4 (&acc)[2][2][4][2], const Unit& u, int wr, int wc, int fr, int fq) const {
        const int row0 = u.pm * BM + wr * 64 + fr, col0 = u.pn * BM + wc * 32 + 8 * fq;
#pragma unroll
        for (int ai = 0; ai < 2; ++ai)
#pragma unroll
            for (int mh = 0; mh < 2; ++mh) {
                f32x4 s0[2][2], s1[2][2];
#pragma unroll
                for (int mm = 0; mm < 2; ++mm)
#pragma unroll
                    for (int bj = 0; bj < 2; ++bj) { const size_t ro = (size_t)(row0 + ai * HALF + (2 * mh + mm) * 16) * 1024 + col0 + bj * HALF; s0[mm][bj] = NT_LOAD((const f32x4*)(src + ro)); s1[mm][bj] = NT_LOAD((const f32x4*)(src + ro + 4)); }
#pragma unroll
                for (int mm = 0; mm < 2; ++mm) { const int m = 2 * mh + mm; float q = 0.f;
#pragma unroll
                    for (int bj = 0; bj < 2; ++bj) { const size_t ro = (size_t)(row0 + ai * HALF + m * 16) * 1024 + col0 + bj * HALF;
                        const f32x4 o0 = s0[mm][bj] + acc[ai][bj][m][0], o1 = s1[mm][bj] + acc[ai][bj][m][1];
                        *(f32x4*)(dst + ro) = o0; *(f32x4*)(dst + ro + 4) = o1;
                        if (RESID_SSQ) q += ((o0[0] * o0[0] + o0[1] * o0[1]) + (o0[2] * o0[2] + o0[3] * o0[3])) + ((o1[0] * o1[0] + o1[1] * o1[1]) + (o1[2] * o1[2] + o1[3] * o1[3])); }
                    if (RESID_SSQ) { q += __shfl_xor(q, 16); q += __shfl_xor(q, 32); if (fq == 0) ssq[(size_t)(row0 + ai * HALF + m * 16) * 16 + u.pn * 4 + wc] = q; } }
            }
    }
};

struct EpiGU {
    static constexpr bool PERM = true, AFTER_DRAIN = false;
    bf16_t* ACT;
    __device__ __forceinline__ void operator()(const f32x4 (&acc)[2][2][4][2], const Unit& u, int wr, int wc, int fr, int fq) const {
        const int row0 = u.pm * BM + wr * 64 + fr, col0 = (u.pn & 3) * 128 + wc * 16 + 4 * fq;
#pragma unroll
        for (int ai = 0; ai < 2; ++ai)
#pragma unroll
            for (int m = 0; m < 4; ++m) { bf16_t* rowp = ACT + (size_t)(row0 + ai * HALF + m * 16) * 512 + col0;
#pragma unroll
                for (int bj = 0; bj < 2; ++bj) { const f32x4 g = acc[ai][bj][m][0], v = acc[ai][bj][m][1]; float r[4];
#pragma unroll
                    for (int e = 0; e < 4; ++e) r[e] = g[e] * fast_sigmoid(g[e]) * v[e];
                    uint2 w; w.x = cvt_pk_bf16(r[0], r[1]); w.y = cvt_pk_bf16(r[2], r[3]);
                    *(uint2*)(rowp + bj * 64) = w; } }
    }
};

struct EpiRows {
    static constexpr bool PERM = true, AFTER_DRAIN = false;
    bf16_t* Y;
    __device__ __forceinline__ void operator()(const f32x4 (&acc)[2][2][4][2], const Unit& u, int wr, int wc, int fr, int fq) const {
        const int row0 = u.pm * BM + wr * 64 + fr, col0 = (u.pn & 3) * BM + wc * 32 + 8 * fq;
#pragma unroll
        for (int ai = 0; ai < 2; ++ai)
#pragma unroll
            for (int m = 0; m < 4; ++m) { bf16_t* rowp = Y + (size_t)(row0 + ai * HALF + m * 16) * 1024 + col0;
#pragma unroll
                for (int bj = 0; bj < 2; ++bj) { const f32x4 v0 = acc[ai][bj][m][0], v1 = acc[ai][bj][m][1];
                    u32x4 w; w.x = cvt_pk_bf16(v0[0], v0[1]); w.y = cvt_pk_bf16(v0[2], v0[3]); w.z = cvt_pk_bf16(v1[0], v1[1]); w.w = cvt_pk_bf16(v1[2], v1[3]);
                    *(u32x4*)(rowp + bj * HALF) = w; } }
    }
};

struct RangeOrder {
    static constexpr bool GATHER = false, ROWSKIP = false, B_NT = false; const int* row_tok; const PG8_LAS int* tok_lds;
    StaticOrder S; int pn0, gap_at, gap_len;
    __device__ void init(int M, int npn, int pn0_, int G, int c, int gap_at_ = 1 << 30, int gap_len_ = 0) { S.init(M, npn * BM, G, c); pn0 = pn0_; gap_at = gap_at_; gap_len = gap_len_; }
    __device__ __forceinline__ bool next(int i, Unit& u) const { if (!S.next(i, u)) return false; u.pn += pn0; if (u.pn >= gap_at) u.pn += gap_len; return true; }
    __device__ __forceinline__ void a_ready(const Unit&) const {}
    __device__ __forceinline__ void done(const Unit&) const {}
};
struct ConstOrder {
    static constexpr bool GATHER = false, ROWSKIP = false, B_NT = false; const int* row_tok; const PG8_LAS int* tok_lds;
    int n;
    __device__ __forceinline__ bool next(int i, Unit& u) const { if (i >= n) return false; u.pm = 0; u.pn = 0; u.rows = 256; return true; }
    __device__ __forceinline__ void a_ready(const Unit&) const {}
    __device__ __forceinline__ void done(const Unit&) const {}
};
template <bool G_>
struct MoeOrderT {
    static constexpr bool GATHER = G_, ROWSKIP = (MOE_ROWSKIP != 0), B_NT = MOE_B_NT;
    const PG8_LAS int* tile_start;
    int G, c; const int* row_tok; const PG8_LAS int* tok_lds;
    __device__ __forceinline__ bool next(int i, Unit& u) const {
        const int q = (MOE_XCD && (G & 7) == 0) ? (c & 7) * (G >> 3) + (c >> 3) : c;
        const int L = i * G + q, j = L >> 2; if (j >= tile_start[64]) return false;
        const int ent = tile_start[MOE_ORDER_OFF + j];
        u.pm = ent & 511; u.pn = ((ent >> 9) & 63) * 4 + (L & 3); u.rows = ent >> 15; return true;
    }
    __device__ __forceinline__ void a_ready(const Unit&) const {}
    __device__ __forceinline__ void done(const Unit&) const {}
};
typedef MoeOrderT<false> MoeOrder; typedef MoeOrderT<true> MoeOrderG;
template <class Epi, class Sched, bool ALIGN_EPI = false, bool SP2 = false, bool CH_IN = false, bool CH_OUT = false>
__device__ __forceinline__ void gemm_phase(PG8_LAS unsigned char* lds, const Gemm g, const Sched& S, const Epi& E, const char* chA = nullptr, const char* chB = nullptr) {
    static_assert(!(CH_IN || CH_OUT) || (ALIGN_EPI && SP2 && !Epi::AFTER_DRAIN && !Sched::GATHER), "chained calls: aligned epilogues, SP2 loop, plain A");
    static_assert(SP2 || !Sched::GATHER, "the gathered-A form exists only in the SP2 loop");
    int tid_ = threadIdx.x; asm volatile("" : "+v"(tid_));
    const int tid = tid_, wid = __builtin_amdgcn_readfirstlane(tid >> 6), lane = tid & 63, wr = wid >> 2, wc = wid & 3, fr = lane & 15, fq = lane >> 4;
    const int K = g.K, nt = K / BK;
    constexpr bool GATH = Sched::GATHER;
    unsigned voffA[2], voffB[2], voffG[2][2];
#pragma unroll
    for (int i = 0; i < 2; ++i) { int R, C; stage_rc(tid * 16 + i * 8192, R, C); const int Rb = Epi::PERM ? ((R & ~31) + perm32(R & 31)) : R;
        voffA[i] = (unsigned)(R * K + C) * 2u; voffB[i] = (unsigned)(Rb * K + C) * 2u; }
    const size_t kstep = (size_t)(BK * 2);
    const size_t hstep = (size_t)HALF * K * 2;
    const size_t tstep = 2 * hstep;
    const unsigned ldsw = (unsigned)wid * 1024u;
    const int aoff = lds_byte(wr * 64 + fr, fq * 8), boff = lds_byte(wc * 32 + fr, fq * 8);
#define PG8_SA(b, h) (((b) * 2 + (h)) * HTB)
#define PG8_SB(b, h) ((4 + (b) * 2 + (h)) * HTB)
#define PG8_STAGE(bufoff, gbase, voff) do { _Pragma("unroll") for (int _i = 0; _i < 2; ++_i) \
        __builtin_amdgcn_global_load_lds((const unsigned*)((const char*)(gbase) + (voff)[_i]), (PG8_LAS unsigned*)(lds + (bufoff) + ldsw + _i * 8192), 16, 0, 0); } while (0)
#define PG8_STAGE_B(bufoff, gbase, voff) do { _Pragma("unroll") for (int _i = 0; _i < 2; ++_i) \
        __builtin_amdgcn_global_load_lds((const unsigned*)((const char*)(gbase) + (voff)[_i]), (PG8_LAS unsigned*)(lds + (bufoff) + ldsw + _i * 8192), 16, 0, Sched::B_NT ? 2 : 0); } while (0)
#define PG8_STAGE_A(bufoff, gptr, hf) do { if constexpr (GATH) { PG8_STAGE(bufoff, gptr, voffG[hf]); } else { PG8_STAGE(bufoff, (gptr) + (hf) * hstep, voffA); } } while (0)
#define PG8_TOKDMA(u_, slot) do { if (wid < 4) __builtin_amdgcn_global_load_lds((const unsigned*)(S.row_tok + (u_).pm * BM + wid * 64 + lane), (PG8_LAS unsigned*)(S.tok_lds + (slot) * 256 + wid * 64), 4, 0, 0); } while (0)
#define PG8_GOFF(slot) do { _Pragma("unroll") for (int h_ = 0; h_ < 2; ++h_) _Pragma("unroll") for (int i_ = 0; i_ < 2; ++i_) { int R_, C_; stage_rc(tid * 16 + i_ * 8192, R_, C_); voffG[h_][i_] = ((unsigned)S.tok_lds[(slot) * 256 + h_ * HALF + R_] * (unsigned)K + (unsigned)C_) * 2u; } } while (0)
#define PG8_LDA(dst, b, h) do { _Pragma("unroll") for (int m = 0; m < 4; ++m) _Pragma("unroll") for (int k = 0; k < 2; ++k) dst[m][k] = *(const PG8_LAS bf16x8*)(lds + PG8_SA(b, h) + aoff + m * 2048 + k * 1024); } while (0)
#define PG8_LDB(dst, b, h) do { _Pragma("unroll") for (int n = 0; n < 2; ++n) _Pragma("unroll") for (int k = 0; k < 2; ++k) dst[n][k] = *(const PG8_LAS bf16x8*)(lds + PG8_SB(b, h) + boff + n * 2048 + k * 1024); } while (0)
#define PG8_MMA(ai, bj, At, Bt) do { __builtin_amdgcn_s_setprio(1); _Pragma("unroll") for (int m = 0; m < 4; ++m) _Pragma("unroll") for (int n = 0; n < 2; ++n) _Pragma("unroll") for (int k = 0; k < 2; ++k) \
        acc[ai][bj][m][n] = __builtin_amdgcn_mfma_f32_16x16x32_bf16(Bt[n][k], At[m][k], acc[ai][bj][m][n], 0, 0, 0); __builtin_amdgcn_s_setprio(0); } while (0)
#define PG8_WAIT_V(n) asm volatile("s_waitcnt vmcnt(" #n ")" ::: "memory")
#define PG8_WAIT_L(n) asm volatile("s_waitcnt lgkmcnt(" #n ")" ::: "memory")
#define PG8_BAR __builtin_amdgcn_s_barrier()
#define PG8_SCHED __builtin_amdgcn_sched_barrier(0)
    Unit cur, nxt; int ui = 0;
    if (!S.next(0, cur)) return;
    constexpr bool RS = Sched::ROWSKIP;
    bool do0 = true, do1 = true; if constexpr (RS) { do0 = cur.rows > wr * 64; do1 = cur.rows > 128 + wr * 64; }
#define PG8_IF0 if (!RS || do0)
#define PG8_IF1 if (!RS || do1)
#define PG8_IFB if (!RS || do0 || do1)
    f32x4 acc[2][2][4][2];
#pragma unroll
    for (int a = 0; a < 2; ++a)
#pragma unroll
        for (int b = 0; b < 2; ++b)
#pragma unroll
            for (int m = 0; m < 4; ++m)
#pragma unroll
                for (int n = 0; n < 2; ++n) acc[a][b][m][n] = (f32x4){0.f, 0.f, 0.f, 0.f};
    bf16x8 At[4][2], B0[2][2], B1[2][2];
    const char* cA = GATH ? (const char*)g.A : (const char*)g.A + (size_t)cur.pm * tstep; const char* cB = (const char*)g.Bt + (size_t)cur.pn * tstep;
    if constexpr (GATH) { PG8_TOKDMA(cur, 0); PG8_WAIT_V(0); PG8_BAR; PG8_GOFF(0); }
    if constexpr (!CH_IN) {
    S.a_ready(cur);
    if constexpr (SP2) {
        PG8_STAGE_B(PG8_SB(0, 0), cB, voffB); PG8_STAGE_B(PG8_SB(0, 1), cB + hstep, voffB); PG8_STAGE_A(PG8_SA(0, 0), cA, 0); PG8_STAGE_A(PG8_SA(0, 1), cA, 1);
        if (wr == 1) PG8_BAR;
        PG8_WAIT_V(2); PG8_BAR;
        PG8_STAGE_B(PG8_SB(1, 0), cB + kstep, voffB); PG8_STAGE_A(PG8_SA(1, 0), cA + kstep, 0); PG8_STAGE_B(PG8_SB(1, 1), cB + hstep + kstep, voffB);
        PG8_WAIT_V(6); PG8_BAR;
    } else {
        PG8_STAGE_B(PG8_SB(0, 0), cB, voffB); PG8_STAGE(PG8_SA(0, 0), cA, voffA); PG8_STAGE_B(PG8_SB(0, 1), cB + hstep, voffB); PG8_STAGE(PG8_SA(0, 1), cA + hstep, voffA);
        if (wr == 1) PG8_BAR;
        PG8_WAIT_V(4); PG8_BAR;
        PG8_STAGE_B(PG8_SB(1, 0), cB + kstep, voffB); PG8_STAGE(PG8_SA(1, 0), cA + kstep, voffA); PG8_STAGE_B(PG8_SB(1, 1), cB + hstep + kstep, voffB);
        PG8_WAIT_V(6); PG8_BAR;
    }
    }
    for (;;) {
        const bool has_next = S.next(ui + 1, nxt);
        const char* nA = has_next ? (GATH ? (const char*)g.A : (const char*)g.A + (size_t)nxt.pm * tstep) : (CH_OUT ? chA : cA);
        if constexpr (GATH) { if (has_next) PG8_TOKDMA(nxt, (ui + 1) & 1); }
        const char* nB = has_next ? (const char*)g.Bt + (size_t)nxt.pn * tstep : (CH_OUT ? chB : cB);
        for (int t = 0; t < nt; t += 2) {
            const bool last = (t == nt - 2);
            const char* a1 = cA + (size_t)(t + 1) * kstep;
            const char* a2 = last ? nA : cA + (size_t)(t + 2) * kstep; const char* b2 = last ? nB : cB + (size_t)(t + 2) * kstep;
            const char* a3 = a2 + kstep; const char* b3 = b2 + kstep;
            if (last && has_next) S.a_ready(nxt);
            if constexpr (SP2) {
            PG8_IFB { PG8_LDB(B0, 0, 0); PG8_LDB(B1, 0, 1); } PG8_SCHED; PG8_IF0 { PG8_LDA(At, 0, 0); } PG8_STAGE_A(PG8_SA(1, 1), a1, 1);
            if constexpr (GATH) { if (last && has_next) PG8_GOFF((ui + 1) & 1); }
            PG8_WAIT_V(8); PG8_WAIT_L(0); PG8_BAR; PG8_IF0 { PG8_MMA(0, 0, At, B0); PG8_MMA(0, 1, At, B1); } PG8_BAR; PG8_SCHED;
            PG8_IF1 { PG8_LDA(At, 0, 1); } PG8_STAGE_B(PG8_SB(0, 0), b2, voffB); PG8_STAGE_B(PG8_SB(0, 1), b2 + hstep, voffB); PG8_STAGE_A(PG8_SA(0, 0), a2, 0);
            PG8_WAIT_V(8); PG8_WAIT_L(0); PG8_BAR; PG8_IF1 { PG8_MMA(1, 0, At, B0); PG8_MMA(1, 1, At, B1); } PG8_BAR; PG8_SCHED;
            PG8_IFB { PG8_LDB(B0, 1, 0); PG8_LDB(B1, 1, 1); } PG8_SCHED; PG8_IF0 { PG8_LDA(At, 1, 0); } PG8_STAGE_A(PG8_SA(0, 1), a2, 1);
            PG8_WAIT_V(8); PG8_WAIT_L(0); PG8_BAR; PG8_IF0 { PG8_MMA(0, 0, At, B0); PG8_MMA(0, 1, At, B1); } PG8_BAR; PG8_SCHED;
            PG8_IF1 { PG8_LDA(At, 1, 1); } PG8_STAGE_B(PG8_SB(1, 0), b3, voffB); PG8_STAGE_B(PG8_SB(1, 1), b3 + hstep, voffB); PG8_STAGE_A(PG8_SA(1, 0), a3, 0);
            PG8_WAIT_V(8); PG8_WAIT_L(0); PG8_BAR; PG8_IF1 { PG8_MMA(1, 0, At, B0); PG8_MMA(1, 1, At, B1); } PG8_BAR; PG8_SCHED;
            } else {
            PG8_LDB(B0, 0, 0); PG8_SCHED; PG8_LDA(At, 0, 0); PG8_STAGE(PG8_SA(1, 1), a1 + hstep, voffA);
            PG8_WAIT_L(8); PG8_BAR; PG8_WAIT_L(0); PG8_MMA(0, 0, At, B0); PG8_BAR; PG8_SCHED;
            PG8_LDB(B1, 0, 1); PG8_STAGE_B(PG8_SB(0, 0), b2, voffB);
            PG8_BAR; PG8_WAIT_L(0); PG8_MMA(0, 1, At, B1); PG8_BAR;
            PG8_LDA(At, 0, 1); PG8_STAGE(PG8_SA(0, 0), a2, voffA);
            PG8_BAR; PG8_WAIT_L(0); PG8_MMA(1, 0, At, B0); PG8_BAR; PG8_SCHED;
            PG8_STAGE_B(PG8_SB(0, 1), b2 + hstep, voffB);
            PG8_WAIT_V(6); PG8_BAR; PG8_MMA(1, 1, At, B1); PG8_BAR;
            PG8_LDB(B0, 1, 0); PG8_SCHED; PG8_LDA(At, 1, 0); PG8_STAGE(PG8_SA(0, 1), a2 + hstep, voffA);
            PG8_WAIT_L(8); PG8_BAR; PG8_WAIT_L(0); PG8_MMA(0, 0, At, B0); PG8_BAR; PG8_SCHED;
            PG8_LDB(B1, 1, 1); PG8_STAGE_B(PG8_SB(1, 0), b3, voffB);
            PG8_BAR; PG8_WAIT_L(0); PG8_MMA(0, 1, At, B1); PG8_BAR;
            PG8_LDA(At, 1, 1); PG8_STAGE(PG8_SA(1, 0), a3, voffA);
            PG8_BAR; PG8_WAIT_L(0); PG8_MMA(1, 0, At, B0); PG8_BAR; PG8_SCHED;
            PG8_STAGE_B(PG8_SB(1, 1), b3 + hstep, voffB);
            PG8_WAIT_V(6); PG8_BAR; PG8_MMA(1, 1, At, B1); PG8_BAR;
            }
        }
        if constexpr (ALIGN_EPI) { if (wr == 0) PG8_BAR; }
        if constexpr (!Epi::AFTER_DRAIN) { E(acc, cur, wr, wc, fr, fq); S.done(cur); }
        if (!has_next) { if constexpr (CH_OUT) { if (wr == 1) PG8_BAR; } break; }
#pragma unroll
        for (int a = 0; a < 2; ++a)
#pragma unroll
            for (int b = 0; b < 2; ++b)
#pragma unroll
                for (int m = 0; m < 4; ++m)
#pragma unroll
                    for (int n = 0; n < 2; ++n) acc[a][b][m][n] = (f32x4){0.f, 0.f, 0.f, 0.f};
        cur = nxt; cA = nA; cB = nB; ++ui; if constexpr (RS) { do0 = cur.rows > wr * 64; do1 = cur.rows > 128 + wr * 64; }
        if constexpr (ALIGN_EPI) { if (wr == 1) PG8_BAR; }
    }
    if constexpr (!CH_OUT) {
    PG8_WAIT_V(0);
    if constexpr (!ALIGN_EPI) { if (wr == 0) PG8_BAR; }
    PG8_BAR;
    if constexpr (Epi::AFTER_DRAIN) { E.fused(acc, cur, wr, wc, fr, fq, lds, wid, lane); S.done(cur); }
    }
#undef PG8_SA
#undef PG8_IF0
#undef PG8_IF1
#undef PG8_IFB
#undef PG8_SB
#undef PG8_STAGE
#undef PG8_STAGE_B
#undef PG8_LDA
#undef PG8_STAGE_A
#undef PG8_GOFF
#undef PG8_TOKDMA
#undef PG8_LDB
#undef PG8_MMA
#undef PG8_WAIT_V
#undef PG8_WAIT_L
#undef PG8_BAR
#undef PG8_SCHED
}
}
#include <hip/hip_bf16.h>
#include <cmath>
namespace attn_body {
using bf16=__hip_bfloat16;
using bf16x8=__attribute__((ext_vector_type(8)))short;
using s16x4=__attribute__((ext_vector_type(4)))short;
using f32x16=__attribute__((ext_vector_type(16)))float;
using u32x4=__attribute__((ext_vector_type(4)))unsigned;
constexpr int BATCH=16,NHEAD=16,SEQ=2048,D=64,DM=NHEAD*D;
constexpr int NW=8,QBLK=32,QB=QBLK*NW,KVBLK=64,NQB=SEQ/QB;
constexpr int ATTN_PITCH=DM, ATTN_UNIT_ROWS=QB;
__device__ __forceinline__ int crow(int r,int hi){return (r&3)+8*(r>>2)+4*hi;}
#define SBAR() __builtin_amdgcn_sched_barrier(0)
__device__ __forceinline__ void cmask(f32x16&p0,f32x16&p1,int jb,int qrel,int hi){
  const float NEG=-INFINITY; int kb=64*jb+4*hi;
  #pragma unroll
  for(int r=0;r<16;++r){int kv=kb+(r&3)+8*(r>>2); if(kv>qrel)p0[r]=NEG; if(kv+32>qrel)p1[r]=NEG;}
}

constexpr int NSLOT=3, SLOTB=8192;
constexpr int LDS_K=0, LDS_V=NSLOT*SLOTB, LDS_WS=2*NSLOT*SLOTB, LDS_OST=LDS_WS+NW*64*4, LDS_KB=LDS_OST+NW*4096, LDS_BYTES=LDS_KB+SEQ*4;
constexpr int GW_STRIDE=4608, LDS_GW=LDS_BYTES, LDS_BYTES_G=LDS_GW+NW*GW_STRIDE;
struct Guest { bf16* Y0; bf16* Y1; const float* S0; const float* S1; int row0; int k; int n; };
constexpr float C2=0.125f*1.4426950408889634f;
__device__ __forceinline__ void glds16(const void*gsrc,unsigned lds_dst){unsigned keep;
  asm volatile("s_mov_b32 %0, m0\n\ts_mov_b32 m0, %2\n\ts_nop 0\n\tglobal_load_lds_dwordx4 %1, off\n\ts_mov_b32 m0, %0":"=&s"(keep):"v"(gsrc),"s"(lds_dst):"memory");}
__device__ __forceinline__ void glds4(const void*gsrc,unsigned lds_dst){unsigned keep;
  asm volatile("s_mov_b32 %0, m0\n\ts_mov_b32 m0, %2\n\ts_nop 0\n\tglobal_load_lds_dword %1, off\n\ts_mov_b32 m0, %0":"=&s"(keep):"v"(gsrc),"s"(lds_dst):"memory");}
__device__ __forceinline__ float max3f(float a,float b,float c){float r;asm("v_max3_f32 %0, %1, %2, %3":"=v"(r):"v"(a),"v"(b),"v"(c));return r;}
__device__ __forceinline__ float max2f(float a,float b){float r;asm("v_max_f32_e32 %0, %1, %2":"=v"(r):"v"(a),"v"(b));return r;}
__device__ __forceinline__ float fadd_s(float a,float b){float r;asm("v_add_f32_e32 %0, %1, %2":"=v"(r):"v"(a),"v"(b));return r;}
__device__ __forceinline__ float fsub_s(float a,float b){float r;asm("v_sub_f32_e32 %0, %1, %2":"=v"(r):"v"(a),"v"(b));return r;}
typedef float f32x2_t __attribute__((ext_vector_type(2))); typedef __bf16 bf16x2_t __attribute__((ext_vector_type(2)));
__device__ __forceinline__ unsigned cvtpk_s(float lo,float hi){f32x2_t v={lo,hi};bf16x2_t b=__builtin_convertvector(v,bf16x2_t);return __builtin_bit_cast(unsigned,b);}
__device__ __forceinline__ void guest_issue(const Guest&G,int row,unsigned gdst,int lane){
  const bf16*y0=G.Y0+(long)row*1024+8*lane; const bf16*y1=G.Y1+(long)row*1024+8*lane;
  glds16(y0,gdst); glds16(y0+512,gdst+1024); glds16(y1,gdst+2048); glds16(y1+512,gdst+3072); glds4(G.S0+(long)row*16+(lane&15),gdst+4096); glds4(G.S1+(long)row*16+(lane&15),gdst+4352);
}
__device__ __forceinline__ void guest_finish(const Guest&G,int row,const char*shm,int wid,int lane){
  const char*gb=shm+LDS_GW+wid*GW_STRIDE;
  #pragma unroll
  for(int t=0;t<2;++t){ bf16*Y=t?G.Y1:G.Y0;
    #pragma unroll
    for(int j=0;j<2;++j){
      const u32x4 y=*(const u32x4*)(gb+t*2048+j*1024+lane*16);
      const float4 q=*(const float4*)(gb+4096+t*256+16*((lane>>5)+2*j)); const float rstd=__builtin_amdgcn_rsqf(((q.x+q.y)+(q.z+q.w))*(1.f/256.f)+1e-6f);
      u32x4 r;
      #pragma unroll
      for(int e=0;e<4;++e) r[e]=cvtpk_s(__uint_as_float(y[e]<<16)*rstd,__uint_as_float(y[e]&0xffff0000u)*rstd);
      *(u32x4*)(Y+(long)row*1024+8*(lane+64*j))=r;
    } }
}
#define WAIT_BAR(N) asm volatile("s_waitcnt vmcnt(" #N ") lgkmcnt(0)\n\ts_barrier":::"memory")

__device__ __forceinline__ void qkt(f32x16&p0,f32x16&p1,const char*Kslot,const bf16x8*qr,int r32,int hi){
  const char*kb=Kslot+hi*1024+r32*16;
  #pragma unroll
  for(int d0=0;d0<4;++d0){
    const bf16x8 b0=*reinterpret_cast<const bf16x8*>(kb+d0*2048);
    const bf16x8 b1=*reinterpret_cast<const bf16x8*>(kb+d0*2048+512);
    p0=__builtin_amdgcn_mfma_f32_32x32x16_bf16(b0,qr[d0],p0,0,0,0);p1=__builtin_amdgcn_mfma_f32_32x32x16_bf16(b1,qr[d0],p1,0,0,0);}
}
typedef __attribute__((address_space(3))) const char* lds_cptr;
typedef short v4i16_t __attribute__((ext_vector_type(4)));
__device__ __forceinline__ void kload8(bf16x8*kf,lds_cptr kp){
  kf[0]=*(const __attribute__((address_space(3))) bf16x8*)(kp);      kf[1]=*(const __attribute__((address_space(3))) bf16x8*)(kp+512);
  kf[2]=*(const __attribute__((address_space(3))) bf16x8*)(kp+2048); kf[3]=*(const __attribute__((address_space(3))) bf16x8*)(kp+2560);
  kf[4]=*(const __attribute__((address_space(3))) bf16x8*)(kp+4096); kf[5]=*(const __attribute__((address_space(3))) bf16x8*)(kp+4608);
  kf[6]=*(const __attribute__((address_space(3))) bf16x8*)(kp+6144); kf[7]=*(const __attribute__((address_space(3))) bf16x8*)(kp+6656);
}
__device__ __forceinline__ void kload2(bf16x8*kf,lds_cptr kp,int j){ kf[2*j]=*(const __attribute__((address_space(3))) bf16x8*)(kp+j*2048); kf[2*j+1]=*(const __attribute__((address_space(3))) bf16x8*)(kp+j*2048+512); }
__device__ __forceinline__ s16x4 vtr(lds_cptr p){ return __builtin_bit_cast(s16x4,__builtin_amdgcn_ds_read_tr16_b64_v4i16((__attribute__((address_space(3))) v4i16_t*)p)); }
__device__ __forceinline__ float rowmax(const f32x16&p0,const f32x16&p1){
  float a=max3f(p0[0],p0[1],p1[0]),b=max3f(p0[2],p0[3],p1[1]);a=max3f(a,p1[2],p1[3]);
  #pragma unroll
  for(int r=4;r<16;r+=4){a=max3f(a,p0[r],p0[r+1]);b=max3f(b,p0[r+2],p0[r+3]);a=max3f(a,p1[r],p1[r+1]);b=max3f(b,p1[r+2],p1[r+3]);}
  const float m=max2f(a,b);
  auto rr=__builtin_amdgcn_permlane32_swap(__float_as_uint(m),__float_as_uint(m),false,false);
  return max2f(__uint_as_float(rr[0]),__uint_as_float(rr[1]));
}
__device__ __forceinline__ void pv(f32x16*o,int vb,bf16x8 pa0,bf16x8 pa1,bf16x8 pa2,bf16x8 pa3){
  #pragma unroll
  for(int d0=0;d0<2;++d0){s16x4 lo[4],hi[4];
    #pragma unroll
    for(int ks=0;ks<4;++ks){
      asm volatile("ds_read_b64_tr_b16 %0,%1 offset:%c2":"=&v"(lo[ks]):"v"(vb),"i"(d0*4096+ks*1024):"memory");
      asm volatile("ds_read_b64_tr_b16 %0,%1 offset:%c2":"=&v"(hi[ks]):"v"(vb),"i"(d0*4096+ks*1024+512):"memory");}
    asm volatile("s_waitcnt lgkmcnt(0)":::"memory");SBAR();
    #define PK(k) (bf16x8){lo[k][0],lo[k][1],lo[k][2],lo[k][3],hi[k][0],hi[k][1],hi[k][2],hi[k][3]}
    o[d0]=__builtin_amdgcn_mfma_f32_32x32x16_bf16(pa0,PK(0),o[d0],0,0,0);
    o[d0]=__builtin_amdgcn_mfma_f32_32x32x16_bf16(pa1,PK(1),o[d0],0,0,0);
    o[d0]=__builtin_amdgcn_mfma_f32_32x32x16_bf16(pa2,PK(2),o[d0],0,0,0);
    o[d0]=__builtin_amdgcn_mfma_f32_32x32x16_bf16(pa3,PK(3),o[d0],0,0,0);
    #undef PK
  }
}

#ifndef ATTN_STORE16
#define ATTN_STORE16(p,v) NT_STORE((v),(u32x4*)(p))
#endif
template<int THRL> __device__ __forceinline__ void attn_unit(int b,int h,int qb,const bf16*Q,const bf16*__restrict__ K,const bf16*__restrict__ V,bf16*O,const float*__restrict__ Fg,bool stage_kb,char*shm,Guest&G,bool pre_cur,bool pre_next,int qb_next,bf16x8(&qr)[4]){
  int tid_=threadIdx.x; asm volatile("":"+v"(tid_)); const int tid=tid_,lane=tid&63,r32=lane&31,hi=lane>>5; const int wid=__builtin_amdgcn_readfirstlane(tid>>6);
  const long rowbase=(long)b*SEQ; const int q0=qb*QB;
  if(stage_kb){ float*kbw=(float*)(shm+LDS_KB); for(int j=4*tid;j<SEQ;j+=4*NW*64){ const float4 f=*reinterpret_cast<const float4*>(Fg+j); *reinterpret_cast<float4*>(kbw+j)=make_float4(f.x*-1.4426950408889634f,f.y*-1.4426950408889634f,f.z*-1.4426950408889634f,f.w*-1.4426950408889634f);} }
  const float*kb=(const float*)(shm+LDS_KB)+4*hi;
  const bf16*Qw=Q+(rowbase+q0+wid*QBLK)*DM+h*D;
  const bf16*Kh=K+rowbase*DM+h*D,*Vh=V+rowbase*DM+h*D;
  const unsigned lds0=(unsigned)(uintptr_t)shm;
  float*wsf=(float*)(shm+LDS_WS)+wid*64;
  const bf16*ksrc=Kh+(long)lane*DM+wid*8;
  const bf16*vsrc=Vh+(long)(16*(wid&3)+(lane>>2))*DM+(wid>>2)*32+(lane&3)*8;
  const unsigned kdst=lds0+LDS_K+wid*1024, vdst=lds0+LDS_V+wid*1024;
  #define DMA_K(t,slot) glds16(ksrc+(long)(t)*KVBLK*DM,(unsigned)__builtin_amdgcn_readfirstlane(kdst+(slot)))
  #define DMA_V(t,slot) glds16(vsrc+(long)(t)*KVBLK*DM,(unsigned)__builtin_amdgcn_readfirstlane(vdst+(slot)))
  const int vb0=(int)(lds0+LDS_V)+((lane>>4)&1)*32+(lane&3)*8+(4*hi+((lane&15)>>2))*64;
  const char*Kbase=shm+LDS_K; bf16x8 kf[8];
  const lds_cptr shm3=(lds_cptr)shm; const lds_cptr kp0=shm3+LDS_K+hi*1024+r32*16; const lds_cptr vp0=shm3+LDS_V+((lane>>4)&1)*32+(lane&3)*8+(4*hi+((lane&15)>>2))*64;
  const int NT=(q0+QB)/KVBLK;
  if(!(ATT_PRE&&pre_cur)){DMA_K(0,0);DMA_V(0,0);DMA_K(1,SLOTB);}
  if(!(ATT_PRE&&pre_cur)){
  #pragma unroll
  for(int d0=0;d0<4;++d0)qr[d0]=*reinterpret_cast<const bf16x8*>(&Qw[(long)r32*DM+d0*16+hi*8]); }
  float mhat=0.f,l_reg=0.f;f32x16 o[2];o[0]=f32x16{};o[1]=f32x16{};
  const int qrel=wid*QBLK+r32;
  #define CMASK(P0,P1,t) do{int jb_=(t)-(NT-4); if(jb_>=0)cmask(P0,P1,jb_,qrel,hi);}while(0)
  bool resc=false;
#if ATT_PK
  typedef float f32x4v __attribute__((ext_vector_type(4))); typedef float f32x8v __attribute__((ext_vector_type(8)));
  #define KB4(p_) (*reinterpret_cast<const f32x4v*>(p_))
  #define CAT8(x_,y_) __builtin_shufflevector(x_,y_,0,1,2,3,4,5,6,7)
  #define CAT16(x_,y_) __builtin_shufflevector(x_,y_,0,1,2,3,4,5,6,7,8,9,10,11,12,13,14,15)
  #define KBINIT(C0,C1,t) do{ const float*kp_=kb+64*(t); f32x16 mh_; { const float nm_=-mhat; _Pragma("unroll") for(int i_=0;i_<16;++i_)mh_[i_]=nm_; } \
      C0=CAT16(CAT8(KB4(kp_),KB4(kp_+8)),CAT8(KB4(kp_+16),KB4(kp_+24)))+mh_; C1=CAT16(CAT8(KB4(kp_+32),KB4(kp_+40)),CAT8(KB4(kp_+48),KB4(kp_+56)))+mh_; }while(0)
#else
  #define KBINIT(C0,C1,t) do{ const float*kp_=kb+64*(t); _Pragma("unroll") for(int g_=0;g_<4;++g_){ const float4 a_=*reinterpret_cast<const float4*>(kp_+8*g_), b_=*reinterpret_cast<const float4*>(kp_+32+8*g_); \
      C0[4*g_]=a_.x-mhat;C0[4*g_+1]=a_.y-mhat;C0[4*g_+2]=a_.z-mhat;C0[4*g_+3]=a_.w-mhat; C1[4*g_]=b_.x-mhat;C1[4*g_+1]=b_.y-mhat;C1[4*g_+2]=b_.z-mhat;C1[4*g_+3]=b_.w-mhat; } }while(0)
#endif
#if ATT_KBPRE
  #define KBINIT_AT_START(C0,C1,t) do{}while(0)
  #define KBNEXT_LOAD(G,t) f32x4v ka0_,ka1_,ka2_,ka3_,kb0_,kb1_,kb2_,kb3_; if(G){ const float*kn_=kb+64*((t)+1); ka0_=KB4(kn_);ka1_=KB4(kn_+8);ka2_=KB4(kn_+16);ka3_=KB4(kn_+24);kb0_=KB4(kn_+32);kb1_=KB4(kn_+40);kb2_=KB4(kn_+48);kb3_=KB4(kn_+56); }
  #define KBNEXT_ADD(G,N0,N1) if(G){ f32x16 mh_; { const float nm_=-mhat; _Pragma("unroll") for(int i_=0;i_<16;++i_)mh_[i_]=nm_; } N0=CAT16(CAT8(ka0_,ka1_),CAT8(ka2_,ka3_))+mh_; N1=CAT16(CAT8(kb0_,kb1_),CAT8(kb2_,kb3_))+mh_; }
#else
  #define KBINIT_AT_START(C0,C1,t) KBINIT(C0,C1,t)
  #define KBNEXT_LOAD(G,t) do{}while(0)
  #define KBNEXT_ADD(G,N0,N1) do{}while(0)
#endif
  #define START(P0,P1) do{ const float rm=rowmax(P0,P1); resc=false; \
    { const float dl=rm; mhat=fadd_s(mhat,dl); \
      _Pragma("unroll") for(int r=0;r<16;++r){P0[r]=fsub_s(P0[r],dl);P1[r]=fsub_s(P1[r],dl);} \
      } \
    _Pragma("unroll") for(int r=0;r<16;++r)P0[r]=__builtin_amdgcn_exp2f(P0[r]); }while(0)
  #define RESC() do{ if(resc){ asm volatile("s_waitcnt lgkmcnt(0)":::"memory"); \
      _Pragma("unroll") for(int d_=0;d_<2;++d_) _Pragma("unroll") for(int r=0;r<16;++r)o[d_][r]*=wsf[crow(r,hi)]; } }while(0)
  f32x16 pA0,pA1,pB0,pB1;
  int sl_prev=0,sl_cur=0,sl_next=SLOTB;
  #define ROT() do{sl_prev=sl_cur;sl_cur=sl_next;sl_next=(sl_next==(NSLOT-1)*SLOTB)?0:sl_next+SLOTB;}while(0)
  DMA_K(2,2*SLOTB);
  WAIT_BAR(3);
  KBINIT(pA0,pA1,0); qkt(pA0,pA1,Kbase,qr,r32,hi);asm volatile("s_nop 15\n\ts_nop 7":"+v"(pA0),"+v"(pA1));CMASK(pA0,pA1,0);
  START(pA0,pA1);
  _Pragma("unroll") for(int r=0;r<16;++r)pA1[r]=__builtin_amdgcn_exp2f(pA1[r]);
  WAIT_BAR(0);
  DMA_K(3,0);DMA_V(1,SLOTB);
  ROT();
  kload8(kf,kp0+sl_cur);
#if ATT_KBPRE
  KBINIT(pB0,pB1,1);
#endif
  WAIT_BAR(2);
  s16x4 vlo[8],vhi[8]; u32x4 pw0,pw1,pw2,pw3;
  #define PKW(P,B) cvtpk_s(P[B],P[B+1])
  #define PAF(k) __builtin_bit_cast(bf16x8,pw##k)
  #define VFR(i) (bf16x8){vlo[i][0],vlo[i][1],vlo[i][2],vlo[i][3],vhi[i][0],vhi[i][1],vhi[i][2],vhi[i][3]}
  #define PIN(x) asm volatile("":"+v"(x))
  #define MX3(a,b,c) __builtin_fmaxf(__builtin_fmaxf((a),(b)),(c))
#if ATT_PK
  #define GAPA(MF,A0,A1,A2,A3,W0,W1,PW) do{ MF; { const f32x2_t u_={A0,A1}, w_={A2,A3}; asm volatile("v_pk_add_f32 %0, %0, %1\n\tv_pk_add_f32 %0, %0, %2":"+v"(sacc):"v"(u_),"v"(w_)); } W0; W1; PIN(PW); SBAR(); }while(0)
  #define SACC_T f32x2_t
  #define SACC_INIT(P) (f32x2_t){P[0],P[1]}
  #define SACC_SUM(s) ((s).x+(s).y)
#else
  #define GAPA(MF,A0,A1,A2,A3,W0,W1,PW) do{ MF; sacc+=A0; sacc+=A1; sacc+=A2; sacc+=A3; PIN(sacc); W0; W1; PIN(PW); SBAR(); }while(0)
  #define SACC_T float
  #define SACC_INIT(P) (P[0]+P[1])
  #define SACC_SUM(s) (s)
#endif
  #define EX(v) __builtin_amdgcn_exp2f(v)
  #define GAPB(MF,X,B) do{ MF; X[B]=EX(X[B]); X[B+1]=EX(X[B+1]); X[B+2]=EX(X[B+2]); X[B+3]=EX(X[B+3]); PIN(X); SBAR(); }while(0)
  #define VRD(i) do{ vlo[i]=vtr(vp_+(((i)>>2)*4096+((i)&3)*1024)); vhi[i]=vtr(vp_+(((i)>>2)*4096+((i)&3)*1024+512)); }while(0)
  #define KRD(G,j) do{ if(G){ kload2(kf,kp0+sl_next,j); SBAR(); } }while(0)
  #define STEP(C0,C1,P0,P1,t,GK,GV,GL) do{ SBAR(); \
    const lds_cptr vp_=vp0+sl_prev; \
    KBINIT_AT_START(C0,C1,t); SBAR(); VRD(0); SBAR(); SACC_T sacc=SACC_INIT(P0); \
    GAPA(C0=__builtin_amdgcn_mfma_f32_32x32x16_bf16(kf[0],qr[0],C0,0,0,0), P0[2],P0[3],P0[4],P0[5],     pw0[0]=PKW(P0,0), pw0[1]=PKW(P0,2), pw0); \
    VRD(4); SBAR(); GAPA(C1=__builtin_amdgcn_mfma_f32_32x32x16_bf16(kf[1],qr[0],C1,0,0,0), P0[6],P0[7],P0[8],P0[9],     pw0[2]=PKW(P0,4), pw0[3]=PKW(P0,6), pw0); \
    VRD(1); SBAR(); GAPA(C0=__builtin_amdgcn_mfma_f32_32x32x16_bf16(kf[2],qr[1],C0,0,0,0),   P0[10],P0[11],P0[12],P0[13], pw1[0]=PKW(P0,8), pw1[1]=PKW(P0,10), pw1); \
    VRD(5); SBAR(); GAPA(C1=__builtin_amdgcn_mfma_f32_32x32x16_bf16(kf[3],qr[1],C1,0,0,0),   P0[14],P0[15],P1[0],P1[1],   pw1[2]=PKW(P0,12),pw1[3]=PKW(P0,14), pw1); \
    VRD(2); SBAR(); GAPA(C0=__builtin_amdgcn_mfma_f32_32x32x16_bf16(kf[4],qr[2],C0,0,0,0),   P1[2],P1[3],P1[4],P1[5],     pw2[0]=PKW(P1,0), pw2[1]=PKW(P1,2), pw2); \
    VRD(6); SBAR(); GAPA(C1=__builtin_amdgcn_mfma_f32_32x32x16_bf16(kf[5],qr[2],C1,0,0,0),   P1[6],P1[7],P1[8],P1[9],     pw2[2]=PKW(P1,4), pw2[3]=PKW(P1,6), pw2); \
    VRD(3); SBAR(); GAPA(C0=__builtin_amdgcn_mfma_f32_32x32x16_bf16(kf[6],qr[3],C0,0,0,0),   P1[10],P1[11],P1[12],P1[13], pw3[0]=PKW(P1,8), pw3[1]=PKW(P1,10), pw3); \
    VRD(7); SBAR(); GAPA(C1=__builtin_amdgcn_mfma_f32_32x32x16_bf16(kf[7],qr[3],C1,0,0,0),   P1[14],P1[15],0.f,0.f,       pw3[2]=PKW(P1,12),pw3[3]=PKW(P1,14), pw3); \
    l_reg+=SACC_SUM(sacc); \
    if(GK){DMA_K((t)+3,sl_cur);} if(GV){DMA_V((t)+1,sl_next);} \
    CMASK(C0,C1,t); \
    { float a=MX3(C0[0],C0[1],C1[0]),b=MX3(C0[2],C0[3],C1[1]); a=MX3(a,C1[2],C1[3]); \
      _Pragma("unroll") for(int r=4;r<16;r+=4){a=MX3(a,C0[r],C0[r+1]);b=MX3(b,C0[r+2],C0[r+3]);a=MX3(a,C1[r],C1[r+1]);b=MX3(b,C1[r+2],C1[r+3]);} \
      float rm=__builtin_fmaxf(a,b); { auto rr=__builtin_amdgcn_permlane32_swap(__float_as_uint(rm),__float_as_uint(rm),false,false); rm=__builtin_fmaxf(__uint_as_float(rr[0]),__uint_as_float(rr[1])); } \
      resc=false; \
      if(__builtin_expect(__any(rm>(float)THRL),0)){ const float dl=__builtin_fmaxf(rm,0.f); mhat+=dl; \
        _Pragma("unroll") for(int r=0;r<16;++r){C0[r]-=dl;C1[r]-=dl;} \
        const float f=__builtin_amdgcn_exp2f(-dl); l_reg*=f; if(hi==0)wsf[r32]=f; resc=true; } } \
    SBAR(); \
    KBNEXT_LOAD(GL,t); \
    GAPB(o[0]=__builtin_amdgcn_mfma_f32_32x32x16_bf16(PAF(0),VFR(0),o[0],0,0,0), C0,0); \
    GAPB(o[1]=__builtin_amdgcn_mfma_f32_32x32x16_bf16(PAF(0),VFR(4),o[1],0,0,0), C0,4); \
    KRD(GL,0); GAPB(o[0]=__builtin_amdgcn_mfma_f32_32x32x16_bf16(PAF(1),VFR(1),o[0],0,0,0), C0,8); \
    KRD(GL,1); GAPB(o[1]=__builtin_amdgcn_mfma_f32_32x32x16_bf16(PAF(1),VFR(5),o[1],0,0,0), C0,12); \
    KRD(GL,2); GAPB(o[0]=__builtin_amdgcn_mfma_f32_32x32x16_bf16(PAF(2),VFR(2),o[0],0,0,0), C1,0); \
    KRD(GL,3); GAPB(o[1]=__builtin_amdgcn_mfma_f32_32x32x16_bf16(PAF(2),VFR(6),o[1],0,0,0), C1,4); \
    GAPB(o[0]=__builtin_amdgcn_mfma_f32_32x32x16_bf16(PAF(3),VFR(3),o[0],0,0,0), C1,8); \
    GAPB(o[1]=__builtin_amdgcn_mfma_f32_32x32x16_bf16(PAF(3),VFR(7),o[1],0,0,0), C1,12); \
    KBNEXT_ADD(GL,P0,P1); \
    }while(0)
  int t=1;
  #undef CMASK
  #define CMASK(P0,P1,t) do{}while(0)
#if ATT_GUEST
  bool gpend=false; int grow=0; const unsigned gdst=(unsigned)__builtin_amdgcn_readfirstlane(lds0+LDS_GW+wid*GW_STRIDE);
#endif
  for(;t+5<NT;t+=2){
#if ATT_GUEST
    if(gpend){ guest_finish(G,grow,shm,wid,lane); gpend=false; SBAR(); }
    if(G.k<G.n){ grow=G.row0+G.k; ++G.k; if(grow<BATCH*SEQ){ asm volatile("s_waitcnt lgkmcnt(0)":::"memory"); guest_issue(G,grow,gdst,lane); gpend=true; } SBAR(); }
#endif
    STEP(pB0,pB1,pA0,pA1,t,true,true,true);     WAIT_BAR(2); RESC(); ROT();
    STEP(pA0,pA1,pB0,pB1,t+1,true,true,true);   WAIT_BAR(2); RESC(); ROT();
  }
#if ATT_GUEST
  if(gpend){ guest_finish(G,grow,shm,wid,lane); gpend=false; SBAR(); }
#endif
  #undef CMASK
  #define CMASK(P0,P1,t) do{int jb_=(t)-(NT-4); if(jb_>=0)cmask(P0,P1,jb_,qrel,hi);}while(0)
  #define ENDW(tt) do{ if((tt)+3<NT){WAIT_BAR(2);} else if((tt)+2<NT){WAIT_BAR(1);} else {WAIT_BAR(0);} }while(0)
  for(;t+1<NT;t+=2){
    STEP(pB0,pB1,pA0,pA1,t,(t+3<NT),(t+1<NT),(t+1<NT));       ENDW(t);   RESC(); ROT();
    STEP(pA0,pA1,pB0,pB1,t+1,(t+4<NT),(t+2<NT),(t+2<NT));     ENDW(t+1); RESC(); ROT();
  }
  STEP(pB0,pB1,pA0,pA1,NT-1,false,false,false); RESC();
  { float sacc=pB0[0]+pB0[1]; _Pragma("unroll") for(int r=2;r<16;++r)sacc+=pB0[r]; _Pragma("unroll") for(int r=0;r<16;++r)sacc+=pB1[r]; l_reg+=sacc;
    pw0=(u32x4){PKW(pB0,0),PKW(pB0,2),PKW(pB0,4),PKW(pB0,6)};pw1=(u32x4){PKW(pB0,8),PKW(pB0,10),PKW(pB0,12),PKW(pB0,14)};pw2=(u32x4){PKW(pB1,0),PKW(pB1,2),PKW(pB1,4),PKW(pB1,6)};pw3=(u32x4){PKW(pB1,8),PKW(pB1,10),PKW(pB1,12),PKW(pB1,14)};
    SBAR(); pv(o,vb0+sl_cur,PAF(0),PAF(1),PAF(2),PAF(3)); }
#if ATT_PRE
  asm volatile("s_waitcnt lgkmcnt(0)\n\ts_barrier":::"memory");
  if(pre_next){DMA_K(0,0);DMA_V(0,0);DMA_K(1,SLOTB);
    const bf16*Qn=Q+(rowbase+(long)qb_next*QB+wid*QBLK)*DM+h*D;
    #pragma unroll
    for(int d0=0;d0<4;++d0)qr[d0]=*reinterpret_cast<const bf16x8*>(&Qn[(long)r32*DM+d0*16+hi*8]); }
#endif
  #undef PKW
  #undef PAF
  #undef VFR
  #undef PIN
  #undef MX3
  #undef GAPA
  #undef GAPB
  #undef EX
  #undef VRD
  #undef KRD
  #undef STEP
  #undef ENDW
  {auto rr=__builtin_amdgcn_permlane32_swap(__float_as_uint(l_reg),__float_as_uint(l_reg),false,false);l_reg=__uint_as_float(rr[0])+__uint_as_float(rr[1]);}
  if(hi==0)wsf[32+r32]=l_reg;asm volatile("s_waitcnt lgkmcnt(0)":::"memory");
  float rli[16];
  #pragma unroll
  for(int r=0;r<16;++r)rli[r]=__builtin_amdgcn_rcpf(wsf[32+crow(r,hi)]);
  bf16*Ow=O+(rowbase+q0+wid*QBLK)*DM+h*D;
  { bf16*stg=(bf16*)(shm+LDS_OST)+wid*2048;
    #pragma unroll
    for(int r=0;r<16;++r){const int orow=crow(r,hi);
      #pragma unroll
      for(int d0=0;d0<2;++d0)stg[orow*64+d0*32+r32]=__float2bfloat16(o[d0][r]*rli[r]);}
    asm volatile("s_waitcnt lgkmcnt(0)":::"memory");
    #pragma unroll
    for(int i=0;i<4;++i){const int row=i*8+(lane>>3),ch=lane&7; const u32x4 v=*(const u32x4*)(stg+row*64+ch*8); ATTN_STORE16(Ow+(long)row*DM+ch*8,v);} }
#if ATT_PRE
  asm volatile("s_waitcnt lgkmcnt(0)":::"memory");
#else
  asm volatile("s_waitcnt lgkmcnt(0)\n\ts_barrier":::"memory");
#endif
  #undef DMA_K
  #undef DMA_V
  #undef CMASK
  #undef START
  #undef KBINIT
  #undef RESC
  #undef ROT
}
constexpr int ATTN_LDS_BYTES=LDS_BYTES_G; static_assert(LDS_BYTES_G<=131072,"attention scratch + guest buffers must fit the phase ring");
struct AttnTensors { const bf16* Q; const bf16* K; const bf16* V; bf16* O; const float* F; };
struct AttnUnit { int bh; int qb; };
struct StaticOrder {
  int v,G;
  __device__ __forceinline__ explicit StaticOrder(int grid,int block):v(block),G(grid){}
  __device__ __forceinline__ bool next(int i,AttnUnit&u)const{ const int L=(i>>3)*G+v; if(L>=BATCH*NHEAD)return false; u.bh=L; u.qb=7-(i&7); return true; }
  __device__ __forceinline__ void a_ready(const AttnUnit&)const{}
  __device__ __forceinline__ void done(const AttnUnit&)const{}
};
template<class Sched,int THRL=8> __device__ __forceinline__ void attn_phase(char*lds,const AttnTensors&T,const Sched&S,Guest&G){
  AttnUnit u;
  int bh_prev=-1;
  bool pre=false; bf16x8 qr[4];
  for(int i=0;S.next(i,u);++i){ AttnUnit un; un.qb=0; const bool pn=ATT_PRE&&S.next(i+1,un)&&un.bh==u.bh;
    S.a_ready(u); attn_unit<THRL>(u.bh/NHEAD,u.bh%NHEAD,u.qb,T.Q,T.K,T.V,T.O,T.F+(long)u.bh*SEQ,u.bh!=bh_prev,lds,G,pre,pn,un.qb,qr); bh_prev=u.bh; pre=pn; S.done(u); }
}
#undef SBAR
#undef WAIT_BAR
}

constexpr int NWAVES = 8;
constexpr int NB = 16, SEQ = 2048, NT = NB * SEQ, D = 1024, DEPTH = 2, INW = 13352;
constexpr int NPN_IN = 52, NIN_ROWS = 52 * 256 + 64;
constexpr float RMS_EPS = 1e-6f;
constexpr int MAXTILES = 320;
constexpr int PROWS = MAXTILES * 256;

constexpr size_t MiB = (size_t)1 << 20;
constexpr size_t WS_CTL = 0, CTL_ZERO_BYTES = 1 * MiB;
constexpr size_t WS_WIN = 1 * MiB;
constexpr size_t WS_WBR = 28 * MiB;
constexpr size_t WS_WOUT = 34 * MiB;
constexpr size_t WS_WRT = 36 * MiB;
constexpr size_t WS_ROUTE = 37 * MiB;
constexpr size_t WS_ROWTOK = 36 * MiB + 512 * 1024;
constexpr size_t WS_FB = 38 * MiB;
constexpr size_t WS_SSQS = 40 * MiB;
constexpr size_t WS_SSQM = 42 * MiB;
constexpr size_t WS_SMALL = 44 * MiB;
constexpr size_t WS_WGU = 52 * MiB;
constexpr size_t WS_WDN = 180 * MiB;
constexpr size_t WS_H = 244 * MiB;
constexpr size_t WS_YATT = 308 * MiB, WS_YSSD = 372 * MiB, WS_YML = 436 * MiB;
constexpr size_t WS_PROJ = 500 * MiB;
constexpr size_t WS_RAWH = 756 * MiB;
constexpr size_t WS_XSSD = 772 * MiB;
constexpr size_t WS_RAWH2 = 836 * MiB;
constexpr size_t WS_END = 852 * MiB;
constexpr size_t WS_HG = WS_PROJ, WS_ACT = WS_PROJ + 160 * MiB;
static_assert((size_t)PROWS * 1024 * 2 == 160 * MiB && WS_ACT + (size_t)PROWS * 512 * 2 <= WS_END, "moe overlay");
constexpr int CW_TMO = 0, CW_CODE = 1, CW_BAR = 4096, CW_CNT = 16384, CW_WG = 65536;

constexpr int RING_OFF = 0, RING_BYTES = 131072;
constexpr int LDSCTL_OFF = RING_BYTES, MISC_OFF = LDSCTL_OFF + 320, TAB_OFF = LDSCTL_OFF + 1024;
constexpr int LDS_BYTES = 147456;

#define GAS __attribute__((address_space(1)))
#define LAS __attribute__((address_space(3)))
typedef unsigned short bf16;
typedef unsigned v4u __attribute__((ext_vector_type(4)));
typedef unsigned v2u __attribute__((ext_vector_type(2)));
typedef float f32x4 __attribute__((ext_vector_type(4)));
typedef GAS unsigned gu32;
#define RLX_AGENT __ATOMIC_RELAXED, __HIP_MEMORY_SCOPE_AGENT
#define LDS_WAIT() asm volatile("s_waitcnt lgkmcnt(0)" ::: "memory")
__device__ __forceinline__ unsigned pk2(float lo, float hi) { return pg8::cvt_pk_bf16(lo, hi); }
__device__ __forceinline__ unsigned f2bf(float f) { return pg8::cvt_pk_bf16(f, f) & 0xffffu; }
__device__ __forceinline__ float bf2f(unsigned short u) { return __builtin_bit_cast(float, (unsigned)u << 16); }
__device__ __forceinline__ float blo(unsigned w) { return __builtin_bit_cast(float, w << 16); }
__device__ __forceinline__ float bhi(unsigned w) { return __builtin_bit_cast(float, w & 0xffff0000u); }
__device__ __forceinline__ float sigmoid_f(float x) { return 1.0f / (1.0f + expf(-x)); }
__device__ __forceinline__ float silu_f(float x) { return x / (1.0f + expf(-x)); }
__device__ __forceinline__ float logsigmoid_f(float x) { return fminf(x, 0.f) - log1pf(expf(-fabsf(x))); }
__device__ __forceinline__ float softplus_f(float x) { return fmaxf(x, 0.f) + log1pf(expf(-fabsf(x))); }
__device__ __forceinline__ float wave_sum(float v) {
#pragma unroll
    for (int o = 1; o < 64; o <<= 1) v += __shfl_xor(v, o);
    return v;
}
#define XB_TMO      128
#define XB_XCNT(j)  (256  + 64 * (j))
#define XB_XSUB(j)  (1280 + 64 * (j))
#define XB_XGEN(j)  (2304 + 64 * (j))
#define XB_TOP      3328
#define XB_TOPGEN   3392
#define XCD_BAR_WORDS 3456
#define XB_SPIN_CAP (1u << 20)

__device__ __forceinline__ unsigned xb_ld(unsigned* p)              { return __hip_atomic_load(p, __ATOMIC_RELAXED, __HIP_MEMORY_SCOPE_AGENT); }
__device__ __forceinline__ unsigned xb_add(unsigned* p, unsigned v) { return __hip_atomic_fetch_add(p, v, __ATOMIC_RELAXED, __HIP_MEMORY_SCOPE_AGENT); }
__device__ __forceinline__ unsigned xb_xcc_id() { return (unsigned)__builtin_amdgcn_s_getreg((3 << 11) | 20) & 0xFu; }
#define XB_SPIN(cond, bar) do { unsigned _sp = 0; while (cond) { __builtin_amdgcn_s_sleep(1); \
    if ((++_sp & 255u) == 0u) { if (xb_ld(&(bar)[XB_TMO])) break; if (_sp > XB_SPIN_CAP) { atomicAdd(&(bar)[XB_TMO], 1u); break; } } } } while (0)

struct XcdBarrier {
    unsigned* bar; unsigned x;
    volatile LAS unsigned* st;
};

__device__ __forceinline__ XcdBarrier xcd_barrier_post(unsigned* bar, volatile LAS unsigned* st) {
    XcdBarrier b; b.bar = bar; b.x = xb_xcc_id(); b.st = st;
    if (threadIdx.x == 0) (void)xb_add(&bar[XB_XCNT(b.x)], 1u);
    return b;
}
__device__ __forceinline__ void xcd_barrier_complete(unsigned* bar, unsigned x, unsigned& nloc, unsigned& nx) {
    const unsigned G = gridDim.x * gridDim.y * gridDim.z;
    unsigned sum, cnt, mine, sp = 0u;
    for (;;) {
        sum = 0u; cnt = 0u; mine = 0u;
#pragma nounroll
        for (unsigned j = 0; j < 16; ++j) { const unsigned c = xb_ld(&bar[XB_XCNT(j)]); sum += c; cnt += (c > 0u) ? 1u : 0u; mine = (j == x) ? c : mine; }
        if (sum == G) break;
        __builtin_amdgcn_s_sleep(1);
        if ((++sp & 255u) == 0u) { if (xb_ld(&bar[XB_TMO])) break; if (sp > XB_SPIN_CAP) { atomicAdd(&bar[XB_TMO], 1u); break; } }
    }
    nloc = mine > 0u ? mine : 1u; nx = cnt > 0u ? cnt : 1u;
}

__device__ __forceinline__ void xcd_barrier(const XcdBarrier& b) {
    asm volatile("s_waitcnt vmcnt(0)" ::: "memory");
    __syncthreads();
    if (threadIdx.x == 0) {
        unsigned* bar = b.bar;
        __builtin_amdgcn_s_waitcnt(0);
        unsigned nloc = b.st[0], nx = b.st[1];
        if (nloc == 0u) { xcd_barrier_complete(bar, b.x, nloc, nx); b.st[0] = nloc; b.st[1] = nx; }
        const unsigned old = xb_add(&bar[XB_XSUB(b.x)], 1u);
        const unsigned gen = old / nloc;
        if (old + 1u == (gen + 1u) * nloc) {
            __builtin_amdgcn_fence(__ATOMIC_RELEASE, "agent");
            asm volatile("s_waitcnt vmcnt(0)" ::: "memory");
            const unsigned og = xb_add(&bar[XB_TOP], 1u);
            const unsigned tg = og / nx;
            if (og + 1u == (tg + 1u) * nx) xb_add(&bar[XB_TOPGEN], 1u);
            else XB_SPIN(xb_ld(&bar[XB_TOPGEN]) == tg, bar);
            __builtin_amdgcn_fence(__ATOMIC_ACQUIRE, "agent");
            xb_add(&bar[XB_XGEN(b.x)], 1u);
            asm volatile("s_waitcnt vmcnt(0)" ::: "memory");
        } else {
            XB_SPIN(xb_ld(&bar[XB_XGEN(b.x)]) == gen, bar);
            __builtin_amdgcn_fence(__ATOMIC_ACQUIRE, "agent");
            asm volatile("s_waitcnt vmcnt(0)" ::: "memory");
        }
    }
    __syncthreads();
}


struct Args { const float* in[27]; float* out; unsigned char* ws; int ph_lo, ph_hi; };
typedef const __attribute__((address_space(4))) Args* KArgs;
__device__ __forceinline__ KArgs kargs() { KArgs p = (KArgs)__builtin_amdgcn_kernarg_segment_ptr(); asm volatile("" : "+s"(p)); return p; }
struct Frame {
    LAS unsigned char* lds;
    volatile LAS unsigned* MISC;
    gu32* ctl;
    int tid, lane, wave, G, bid;
    unsigned char* ws; float* out;
};
enum { I_X = 0, I_N1W, I_WIN, I_AFB, I_SCW, I_SCB, I_SDTB, I_SALOG, I_SD, I_SNW, I_MCW, I_MCB, I_MIB, I_MFB, I_MNW, I_GB, I_WBR, I_WOUT, I_N2W, I_WG, I_BG, I_WER, I_BER, I_WGATE, I_WUP, I_WDOWN, I_FNW };

__device__ __forceinline__ int incol(int n) {
    if (n < 1024) return 6176 + n;
    if (n < 2048) return 7200 + (n - 1024);
    if (n < 3072) return 8224 + (n - 2048);
    if (n < 4096) return 9256 + (n - 3072);
    if (n < 7168) return n - 4096;
    if (n < 10240) return 3088 + (n - 7168);
    if (n < 13312) return 10280 + (n - 10240);
    const int j = n - 13312;
    if (j < 16) return 3072 + j; if (j < 32) return 6160 + (j - 16); if (j < 36) return 9248 + (j - 32); if (j < 40) return 9252 + (j - 36); return -1;
}
__device__ __forceinline__ void tr_item(const float* cp, int ld, int K, bf16* WT, int n0, int k0, LAS float* scr, int lane, const float* ksc = nullptr) {
    float tv[32];
#pragma unroll
    for (int i = 0; i < 32; ++i) { const int kk = 2 * i + (lane >> 5); tv[i] = cp ? NT_LOAD(cp + (size_t)(k0 + kk) * ld) : 0.f; if (ksc) tv[i] *= ksc[k0 + kk]; }
#pragma unroll
    for (int i = 0; i < 32; ++i) { const int kk = 2 * i + (lane >> 5); scr[kk * 33 + (lane & 31)] = tv[i]; }
    LDS_WAIT(); asm volatile("" ::: "memory");
    const int c = lane & 7;
#pragma unroll
    for (int j = 0; j < 4; ++j) { const int n = (lane >> 3) + 8 * j; const LAS float* s = scr + (8 * c) * 33 + n;
        v4u o; o.x = pk2(s[0 * 33], s[1 * 33]); o.y = pk2(s[2 * 33], s[3 * 33]); o.z = pk2(s[4 * 33], s[5 * 33]); o.w = pk2(s[6 * 33], s[7 * 33]);
        *(GAS v4u*)(WT + (size_t)(n0 + n) * K + k0 + 8 * c) = o; }
    LDS_WAIT(); asm volatile("" ::: "memory");
}
__device__ __forceinline__ void p_convert(Frame& F, KArgs A, int L) {
    LAS float* scr = (LAS float*)(F.lds + RING_OFF + F.wave * 16384);
    const int gw = F.bid * NWAVES + F.wave, NGW = F.G * NWAVES, lane = F.lane;
    constexpr int NBI = NIN_ROWS / 32, I_IN = 16 * NBI, I_BR = 3 * 512, I_OUT = 512, I_GU = 64 * 512, I_DN = 64 * 256;
    const int NITEMS = (USE_GUEST_CVT && F.G == 256) ? I_IN + I_BR + I_OUT : I_IN + I_BR + I_OUT + I_GU + I_DN;
    const float* w_in = A->in[I_WIN] + (size_t)L * 1024 * INW;
    for (int it = gw; it < NITEMS; it += NGW) {
        int r = it;
        if (r < I_IN) { const int kb = r / NBI, nb = r % NBI; const int c = incol(nb * 32 + (lane & 31));
            tr_item(c < 0 ? nullptr : w_in + c, INW, 1024, (bf16*)(F.ws + WS_WIN), nb * 32, kb * 64, scr, lane); continue; }
        r -= I_IN;
        if (r < I_BR) { const int b = r / 512, rr = r % 512, kb = rr / 32, nb = rr % 32;
            tr_item(A->in[I_WBR] + (size_t)(L * 3 + b) * 1048576 + nb * 32 + (lane & 31), 1024, 1024, (bf16*)(F.ws + WS_WBR) + (size_t)b * 1048576, nb * 32, kb * 64, scr, lane,
                    (FIX_PURE && b == 1) ? A->in[I_SNW] + (size_t)L * D : (FIX_PURE && b == 2) ? A->in[I_MNW] + (size_t)L * D : nullptr); continue; }
        r -= I_BR;
        if (r < I_OUT) { const int kb = r / 32, nb = r % 32;
            tr_item(A->in[I_WOUT] + (size_t)L * 1048576 + nb * 32 + (lane & 31), 1024, 1024, (bf16*)(F.ws + WS_WOUT), nb * 32, kb * 64, scr, lane); continue; }
        r -= I_OUT;
        if (r < I_GU) { const int e = r / 512, rr = r % 512, kb = rr / 32, nb = rr % 32; const int n = nb * 32 + (lane & 31), q = n >> 3, i = n & 7;
            const float* src = ((i < 4) ? A->in[I_WGATE] : A->in[I_WUP]) + (size_t)(L * 64 + e) * 524288 + 4 * q + (i & 3);
            tr_item(src, 512, 1024, (bf16*)(F.ws + WS_WGU) + (size_t)e * 1048576, nb * 32, kb * 64, scr, lane); continue; }
        r -= I_GU;
        { const int e = r / 256, rr = r % 256, kb = rr / 32, nb = rr % 32;
            tr_item(A->in[I_WDOWN] + (size_t)(L * 64 + e) * 524288 + nb * 32 + (lane & 31), 1024, 512, (bf16*)(F.ws + WS_WDN) + (size_t)e * 524288, nb * 32, kb * 64, scr, lane); }
    }
    bf16* wrh = (bf16*)(F.ws + WS_WRT); bf16* wrl = wrh + 80 * 1024;
    const float* wg = A->in[I_WG] + (size_t)L * 1024 * 8; const float* we = A->in[I_WER] + (size_t)L * 1024 * 64;
    for (int idx = F.bid * 512 + F.tid; idx < 80 * 1024; idx += F.G * 512) { const int c = idx >> 10, k = idx & 1023; const float v = (c < 8) ? wg[k * 8 + c] : (c < 72) ? we[k * 64 + (c - 8)] : 0.f;
        const unsigned hi = f2bf(v); wrh[idx] = (bf16)hi; wrl[idx] = (bf16)f2bf(v - bf2f((unsigned short)hi)); }
}

template <int COMBINE, int FINAL>
__device__ __forceinline__ void p_norm(Frame& F, const float* xin, float* X, const float* w, bf16* H) {
    const int gw = F.bid * NWAVES + F.wave, NGW = F.G * NWAVES, lane = F.lane;
    const int* tok_pos = (const int*)(F.ws + WS_ROUTE + 3 * 262144); const float* tok_w = (const float*)(F.ws + WS_ROUTE + 262144);
    const bf16* Y = (const bf16*)(F.ws + WS_HG);
    f32x4 wv[4];
#pragma unroll
    for (int j = 0; j < 4; ++j) wv[j] = ((const f32x4*)w)[lane + 64 * j];
    for (int m0 = 2 * gw; m0 < NT; m0 += 2 * NGW) {
        f32x4 v[2][4]; v2u ya[2][4], yb[2][4]; float w0[2], w1[2];
#pragma unroll
        for (int r = 0; r < 2; ++r) { const int m = m0 + r;
            const f32x4* xr = (const f32x4*)((COMBINE ? X : xin) + (size_t)m * D) + lane;
#pragma unroll
            for (int j = 0; j < 4; ++j) v[r][j] = NT_LOAD(xr + 64 * j);
            if (COMBINE) { const int p0 = tok_pos[2 * m], p1 = tok_pos[2 * m + 1]; w0[r] = tok_w[2 * m]; w1[r] = tok_w[2 * m + 1];
                const v2u* y0 = (const v2u*)(Y + (size_t)p0 * D) + lane; const v2u* y1 = (const v2u*)(Y + (size_t)p1 * D) + lane;
#pragma unroll
                for (int j = 0; j < 4; ++j) { ya[r][j] = NT_LOAD(y0 + 64 * j); yb[r][j] = NT_LOAD(y1 + 64 * j); } } }
#pragma unroll
        for (int r = 0; r < 2; ++r) { const int m = m0 + r;
            if (COMBINE) {
#pragma unroll
                for (int j = 0; j < 4; ++j) { const v2u a = ya[r][j], b = yb[r][j];
                    v[r][j].x += w0[r] * blo(a.x) + w1[r] * blo(b.x); v[r][j].y += w0[r] * bhi(a.x) + w1[r] * bhi(b.x); v[r][j].z += w0[r] * blo(a.y) + w1[r] * blo(b.y); v[r][j].w += w0[r] * bhi(a.y) + w1[r] * bhi(b.y); }
                if (!FINAL) { f32x4* xo = (f32x4*)(X + (size_t)m * D) + lane;
#pragma unroll
                    for (int j = 0; j < 4; ++j) NT_STORE(v[r][j], xo + 64 * j); }
            }
            float s = 0.f;
#pragma unroll
            for (int j = 0; j < 4; ++j) s += (v[r][j].x * v[r][j].x + v[r][j].y * v[r][j].y) + (v[r][j].z * v[r][j].z + v[r][j].w * v[r][j].w);
            const float rstd = 1.0f / sqrtf(wave_sum(s) * (1.f / D) + RMS_EPS);
            if (FINAL) { f32x4* xo = (f32x4*)(X + (size_t)m * D) + lane;
#pragma unroll
                for (int j = 0; j < 4; ++j) NT_STORE(v[r][j] * rstd * wv[j], xo + 64 * j);
            } else { GAS unsigned long long* o8 = (GAS unsigned long long*)(H + (size_t)m * D) + lane;
#pragma unroll
                for (int j = 0; j < 4; ++j) { const f32x4 y = v[r][j] * rstd * wv[j]; o8[64 * j] = (unsigned long long)pk2(y.x, y.y) | ((unsigned long long)pk2(y.z, y.w) << 32); } }
        }
    }
}

__device__ __forceinline__ void p_small(Frame& F) {
    typedef short bf16x8 __attribute__((ext_vector_type(8)));
    const int gw = F.bid * NWAVES + F.wave, NGW = F.G * NWAVES, lane = F.lane, r = lane & 15, g = lane >> 4;
    const bf16* H = (const bf16*)(F.ws + WS_H); const bf16* W = (const bf16*)(F.ws + WS_WIN) + (size_t)(NPN_IN * 256) * 1024; float* SM = (float*)(F.ws + WS_SMALL);
    for (int task = gw; task < NT / 16; task += NGW) {
        const int m0 = task * 16;
        const bf16x8* ap = (const bf16x8*)(H + (size_t)(m0 + r) * D + 8 * g);
        const bf16x8* bp0 = (const bf16x8*)(W + (size_t)(r) * D + 8 * g); const bf16x8* bp1 = (const bf16x8*)(W + (size_t)(16 + r) * D + 8 * g); const bf16x8* bp2 = (const bf16x8*)(W + (size_t)(32 + r) * D + 8 * g);
        f32x4 c0 = (f32x4){0.f, 0.f, 0.f, 0.f}, c1 = c0, c2 = c0;
#pragma unroll 8
        for (int ks = 0; ks < 32; ++ks) { const bf16x8 a = ap[ks * 4], b0 = bp0[ks * 4], b1 = bp1[ks * 4], b2 = bp2[ks * 4];
            c0 = __builtin_amdgcn_mfma_f32_16x16x32_bf16(a, b0, c0, 0, 0, 0); c1 = __builtin_amdgcn_mfma_f32_16x16x32_bf16(a, b1, c1, 0, 0, 0); c2 = __builtin_amdgcn_mfma_f32_16x16x32_bf16(a, b2, c2, 0, 0, 0); }
#pragma unroll
        for (int i = 0; i < 4; ++i) { float* o = SM + (size_t)(m0 + 4 * g + i) * 64 + r; o[0] = c0[i]; o[16] = c1[i]; o[32] = c2[i]; }
    }
}

__device__ __forceinline__ void p_fcum(Frame& F, KArgs A, int L) {
    LAS float* wt = (LAS float*)(F.lds + RING_OFF);
    const int lane = F.lane, t = F.tid, w = F.wave;
    for (int bh = F.bid; bh < NB * 16; bh += F.G) {
        const int b = bh >> 4, h = bh & 15; const float fb = A->in[I_AFB][L * 16 + h];
        const float* sm = (const float*)(F.ws + WS_SMALL) + (size_t)b * SEQ * 64 + h;
        float* out = (float*)(F.ws + WS_FB) + (size_t)bh * SEQ;
        float v[4]; float tot = 0.f;
#pragma unroll
        for (int i = 0; i < 4; ++i) v[i] = sm[(size_t)(t * 4 + i) * 64];
#pragma unroll
        for (int i = 0; i < 4; ++i) { v[i] = logsigmoid_f(v[i] + fb); tot += v[i]; }
        float inc = tot;
#pragma unroll
        for (int o = 1; o < 64; o <<= 1) { const float u = __shfl_up(inc, o); if (lane >= o) inc += u; }
        if (lane == 63) wt[w] = inc;
        __syncthreads();
        float run = inc - tot;
#pragma unroll
        for (int j = 0; j < NWAVES; ++j) run += (j < w) ? wt[j] : 0.f;
        f32x4 o4; run += v[0]; o4.x = run; run += v[1]; o4.y = run; run += v[2]; o4.z = run; run += v[3]; o4.w = run; *(f32x4*)(out + t * 4) = o4;
        __syncthreads();
    }
}

__device__ __forceinline__ void att_simple_unit(Frame& F, int b, int h, int qb) {
    LAS float* sK = (LAS float*)(F.lds + RING_OFF); LAS float* sV = sK + 4096; LAS float* sF = sV + 4096;
    const bf16* Q = (const bf16*)(F.ws + WS_PROJ); const bf16* K = (const bf16*)(F.ws + WS_PROJ + pg8::SLAB); const bf16* V = (const bf16*)(F.ws + WS_PROJ + 2 * pg8::SLAB);
    const float* FB = (const float*)(F.ws + WS_FB) + (size_t)(b * 16 + h) * SEQ;
    bf16* O = (bf16*)(F.ws + WS_YATT);
    const int tid = F.tid, t = qb * 512 + tid; const size_t row = (size_t)b * SEQ + t;
    float q[64], o[64];
    { const v4u* qp = (const v4u*)(Q + row * D + h * 64);
#pragma unroll
      for (int i = 0; i < 8; ++i) { const v4u w = qp[i]; q[8 * i + 0] = blo(w.x) * 0.125f; q[8 * i + 1] = bhi(w.x) * 0.125f; q[8 * i + 2] = blo(w.y) * 0.125f; q[8 * i + 3] = bhi(w.y) * 0.125f;
          q[8 * i + 4] = blo(w.z) * 0.125f; q[8 * i + 5] = bhi(w.z) * 0.125f; q[8 * i + 6] = blo(w.w) * 0.125f; q[8 * i + 7] = bhi(w.w) * 0.125f; } }
#pragma unroll
    for (int d = 0; d < 64; ++d) o[d] = 0.f;
    const float Fq = FB[t]; float mrun = -INFINITY, l = 0.f;
    const int ntile = (qb * 512 + 512) / 64;
    const int key = tid >> 3, dc = (tid & 7) * 8;
    for (int kt = 0; kt < ntile; ++kt) {
        __syncthreads();
        { const size_t kr = ((size_t)b * SEQ + kt * 64 + key) * D + h * 64 + dc; const v4u kw = *(const v4u*)(K + kr), vw = *(const v4u*)(V + kr);
          LAS float* kd = sK + key * 64 + dc; LAS float* vd = sV + key * 64 + dc;
          kd[0] = blo(kw.x); kd[1] = bhi(kw.x); kd[2] = blo(kw.y); kd[3] = bhi(kw.y); kd[4] = blo(kw.z); kd[5] = bhi(kw.z); kd[6] = blo(kw.w); kd[7] = bhi(kw.w);
          vd[0] = blo(vw.x); vd[1] = bhi(vw.x); vd[2] = blo(vw.y); vd[3] = bhi(vw.y); vd[4] = blo(vw.z); vd[5] = bhi(vw.z); vd[6] = blo(vw.w); vd[7] = bhi(vw.w);
          if (tid < 64) sF[tid] = FB[kt * 64 + tid]; }
        __syncthreads();
        for (int j = 0; j < 64; ++j) {
            const int pos = kt * 64 + j;
            if (pos <= t) {
                float s = Fq - sF[j];
                const LAS f32x4* kp = (const LAS f32x4*)(sK + j * 64);
#pragma unroll
                for (int d4 = 0; d4 < 16; ++d4) { const f32x4 kv = kp[d4]; s += q[4 * d4] * kv.x + q[4 * d4 + 1] * kv.y + q[4 * d4 + 2] * kv.z + q[4 * d4 + 3] * kv.w; }
                const float mn = fmaxf(mrun, s), corr = __expf(mrun - mn), p = __expf(s - mn);
                l = l * corr + p; mrun = mn;
                const LAS f32x4* vp = (const LAS f32x4*)(sV + j * 64);
#pragma unroll
                for (int d4 = 0; d4 < 16; ++d4) { const f32x4 vv = vp[d4]; o[4 * d4] = o[4 * d4] * corr + p * vv.x; o[4 * d4 + 1] = o[4 * d4 + 1] * corr + p * vv.y; o[4 * d4 + 2] = o[4 * d4 + 2] * corr + p * vv.z; o[4 * d4 + 3] = o[4 * d4 + 3] * corr + p * vv.w; }
            }
        }
    }
    const float rl = 1.0f / l;
    v4u* op = (v4u*)(O + row * D + h * 64);
#pragma unroll
    for (int i = 0; i < 8; ++i) { v4u w; w.x = pk2(o[8 * i] * rl, o[8 * i + 1] * rl); w.y = pk2(o[8 * i + 2] * rl, o[8 * i + 3] * rl); w.z = pk2(o[8 * i + 4] * rl, o[8 * i + 5] * rl); w.w = pk2(o[8 * i + 6] * rl, o[8 * i + 7] * rl); op[i] = w; }
}
__device__ __forceinline__ void p_att_simple(Frame& F) {
    for (int u = F.bid; u < 1024; u += F.G) { const int qb = 3 - (u >> 8), bh = u & 255; att_simple_unit(F, bh >> 4, bh & 15, qb); }
    __syncthreads();
}

__device__ __forceinline__ void ssd_simple_unit(Frame& F, KArgs A, int L, int b, int h) {
    constexpr int TB = 32;
    LAS float* cv = (LAS float*)(F.lds + RING_OFF);
    LAS float* sdt = cv + TB * 320; LAS float* sda = sdt + TB; LAS float* yb = sda + TB;
    const int tid = F.tid, g = h >> 2;
    const bf16* SZ = (const bf16*)(F.ws + WS_PROJ); const bf16* XBC = (const bf16*)(F.ws + WS_PROJ + pg8::SLAB) + (size_t)b * SEQ * 2048;
    const float* SM = (const float*)(F.ws + WS_SMALL) + (size_t)b * SEQ * 64;
    bf16* YO = (bf16*)(F.ws + WS_YSSD); float* SSQ = (float*)(F.ws + WS_SSQS);
    int ch = -1;
    if (tid < 64) ch = h * 64 + tid; else if (tid < 192) ch = 1024 + g * 128 + (tid - 64); else if (tid < 320) ch = 1536 + g * 128 + (tid - 192);
    float cw0 = 0.f, cw1 = 0.f, cw2 = 0.f, cw3 = 0.f, cb = 0.f;
    if (ch >= 0) { const float* cw = A->in[I_SCW] + (size_t)L * 4 * 2048 + ch; cw0 = cw[0]; cw1 = cw[2048]; cw2 = cw[4096]; cw3 = cw[6144]; cb = A->in[I_SCB][L * 2048 + ch]; }
    const float Aneg = -expf(A->in[I_SALOG][L * 16 + h]), dtb = A->in[I_SDTB][L * 16 + h], Dh = A->in[I_SD][L * 16 + h];
    float st[16];
#pragma unroll
    for (int j = 0; j < 16; ++j) st[j] = 0.f;
    const int p = tid >> 3, nq = tid & 7;
    float r0 = 0.f, r1 = 0.f, r2 = 0.f;
    for (int t0 = 0; t0 < SEQ; t0 += TB) {
        if (ch >= 0) {
#pragma unroll
            for (int s = 0; s < TB; ++s) { const float r3 = bf2f(XBC[(size_t)(t0 + s) * 2048 + ch]); const float y = cb + cw0 * r0 + cw1 * r1 + cw2 * r2 + cw3 * r3; cv[s * 320 + tid] = silu_f(y); r0 = r1; r1 = r2; r2 = r3; }
        } else if (tid < 320 + TB) { const int s = tid - 320; const float dt = softplus_f(SM[(size_t)(t0 + s) * 64 + 16 + h] + dtb); sdt[s] = dt; sda[s] = expf(dt * Aneg); }
        __syncthreads();
        for (int s = 0; s < TB; ++s) {
            const float xv = cv[s * 320 + p], dt = sdt[s], dA = sda[s], dx = dt * xv; float acc = 0.f;
#pragma unroll
            for (int j = 0; j < 16; ++j) { st[j] = st[j] * dA + dx * cv[s * 320 + 64 + nq * 16 + j]; acc += cv[s * 320 + 192 + nq * 16 + j] * st[j]; }
            acc += __shfl_xor(acc, 1); acc += __shfl_xor(acc, 2); acc += __shfl_xor(acc, 4);
            if (nq == 0) { const float z = bf2f(SZ[((size_t)b * SEQ + t0 + s) * D + h * 64 + p]); yb[s * 64 + p] = (acc + Dh * xv) * silu_f(z); }
        }
        __syncthreads();
        if (tid < TB) { float q = 0.f; for (int i = 0; i < 64; ++i) { const float y = yb[tid * 64 + i]; q += y * y; } SSQ[((size_t)b * SEQ + t0 + tid) * 16 + h] = q; }
        for (int i = tid; i < TB * 64; i += 512) { const int s = i >> 6, pp = i & 63; YO[((size_t)b * SEQ + t0 + s) * D + h * 64 + pp] = (bf16)f2bf(yb[i]); }
        __syncthreads();
    }
}
__device__ __forceinline__ void p_ssd_simple(Frame& F, KArgs A, int L) {
    for (int u = F.bid; u < NB * 16; u += F.G) ssd_simple_unit(F, A, L, u >> 4, u & 15);
}

__device__ __forceinline__ void ml_simple_unit(Frame& F, KArgs A, int L, int b, int h, int vs) {
    constexpr int TB = 16;
    LAS float* sq = (LAS float*)(F.lds + RING_OFF); LAS float* sk = sq + TB * 256; LAS float* sv = sk + TB * 256; LAS float* sg = sv + TB * 64;
    LAS float* red = sg + 2 * TB; LAS float* redd = red + 2 * 8 * 64; LAS float* hb = redd + 16;
    const int tid = F.tid, w = tid >> 6, v = tid & 63;
    const bf16* MQ = (const bf16*)(F.ws + WS_PROJ); const bf16* MK = (const bf16*)(F.ws + WS_PROJ + pg8::SLAB); const bf16* MV = (const bf16*)(F.ws + WS_PROJ + 2 * pg8::SLAB);
    const float* SM = (const float*)(F.ws + WS_SMALL) + (size_t)b * SEQ * 64;
    bf16* YO = (bf16*)(F.ws + WS_YML); float* SSQ = (float*)(F.ws + WS_SSQM);
    const bool isk = tid >= 256; const int cc = h * 256 + (tid & 255), cidx = (isk ? 1024 : 0) + cc;
    const bf16* src = (isk ? MK : MQ) + (size_t)b * SEQ * D + cc;
    const float* cw = A->in[I_MCW] + (size_t)L * 4 * 2048 + cidx; const float cw0 = cw[0], cw1 = cw[2048], cw2 = cw[4096], cw3 = cw[6144], cb = A->in[I_MCB][L * 2048 + cidx];
    const float ib = A->in[I_MIB][L * 4 + h], fbias = A->in[I_MFB][L * 4 + h];
    const float ksc = isk ? 0.0625f : 1.0f;
    float C[32], n[32];
#pragma unroll
    for (int j = 0; j < 32; ++j) { C[j] = 0.f; n[j] = 0.f; }
    float m = 0.f, r0 = 0.f, r1 = 0.f, r2 = 0.f;
    for (int t0 = 0; t0 < SEQ; t0 += TB) {
#pragma unroll
        for (int s = 0; s < TB; ++s) { const float r3 = bf2f(src[(size_t)(t0 + s) * D]); const float y = cb + cw0 * r0 + cw1 * r1 + cw2 * r2 + cw3 * r3; (isk ? sk : sq)[s * 256 + (tid & 255)] = silu_f(y) * ksc; r0 = r1; r1 = r2; r2 = r3; }
        for (int i = tid; i < TB * 64; i += 512) { const int s = i >> 6, j = i & 63; sv[i] = bf2f(MV[((size_t)b * SEQ + t0 + s) * D + h * 256 + vs * 64 + j]); }
        if (tid < TB) { const float* r = SM + (size_t)(t0 + tid) * 64; sg[2 * tid] = r[32 + h] + ib; sg[2 * tid + 1] = logsigmoid_f(r[36 + h] + fbias); }
        __syncthreads();
        for (int s = 0; s < TB; ++s) {
            const float ig = sg[2 * s], lf = sg[2 * s + 1]; const float mn = fmaxf(lf + m, ig); const float fs = expf(lf + m - mn), is = expf(ig - mn); m = mn;
            const float vv = sv[s * 64 + v]; float nump = 0.f, denp = 0.f;
#pragma unroll
            for (int j = 0; j < 32; ++j) { const float kd = sk[s * 256 + w * 32 + j] * is, qd = sq[s * 256 + w * 32 + j]; C[j] = fs * C[j] + kd * vv; nump += qd * C[j]; n[j] = fs * n[j] + kd; denp += qd * n[j]; }
            const int par = s & 1;
            red[(par * 8 + w) * 64 + v] = nump; if (v == 0) redd[par * 8 + w] = denp;
            __syncthreads();
            if (w == 0) { float num = 0.f, den = 0.f;
#pragma unroll
                for (int ww = 0; ww < 8; ++ww) { num += red[(par * 8 + ww) * 64 + v]; den += redd[par * 8 + ww]; }
                hb[s * 64 + v] = num / fmaxf(fabsf(den), expf(-m)); }
        }
        __syncthreads();
        if (tid < TB) { float q = 0.f; for (int i = 0; i < 64; ++i) { const float y = hb[tid * 64 + i]; q += y * y; } SSQ[((size_t)b * SEQ + t0 + tid) * 16 + h * 4 + vs] = q; }
        for (int i = tid; i < TB * 64; i += 512) { const int s = i >> 6, j = i & 63; YO[((size_t)b * SEQ + t0 + s) * D + h * 256 + vs * 64 + j] = (bf16)f2bf(hb[i]); }
        __syncthreads();
    }
}
__device__ __forceinline__ void p_ml_simple(Frame& F, KArgs A, int L) {
    for (int u = F.bid; u < NB * 16; u += F.G) ml_simple_unit(F, A, L, u >> 4, (u >> 2) & 3, u & 3);
}

template <int ML>
__device__ __forceinline__ void p_fix(Frame& F, KArgs A, int L) {
    const int gw = F.bid * NWAVES + F.wave, NGW = F.G * NWAVES, lane = F.lane;
    bf16* Y = (bf16*)(F.ws + (ML ? WS_YML : WS_XSSD)); const float* SSQ = (const float*)(F.ws + (ML ? WS_SSQM : WS_SSQS));
    const bf16* MO = (const bf16*)(F.ws + WS_PROJ + 3 * pg8::SLAB);
    const float* nw = A->in[ML ? I_MNW : I_SNW] + (size_t)L * D;
    f32x4 wv[2][2];
#pragma unroll
    for (int j = 0; j < 2; ++j) { wv[j][0] = *(const f32x4*)(nw + 8 * (lane + 64 * j)); wv[j][1] = *(const f32x4*)(nw + 8 * (lane + 64 * j) + 4); }
    for (int m0 = gw * 4; m0 < NT; m0 += NGW * 4) {
        v4u y[4][2], o[4][2]; float rs[4][2];
#pragma unroll
        for (int r = 0; r < 4; ++r)
#pragma unroll
            for (int j = 0; j < 2; ++j) { y[r][j] = NT_LOAD((const v4u*)(Y + (size_t)(m0 + r) * D + 8 * (lane + 64 * j))); if (ML && !FIX_PURE) o[r][j] = *(const v4u*)(MO + (size_t)(m0 + r) * D + 8 * (lane + 64 * j));
                const f32x4 q = *(const f32x4*)(SSQ + (size_t)(m0 + r) * 16 + 4 * ((lane >> 5) + 2 * j)); rs[r][j] = ((q.x + q.y) + (q.z + q.w)) * (1.f / 256.f) + RMS_EPS; }
#pragma unroll
        for (int r = 0; r < 4; ++r)
#pragma unroll
            for (int j = 0; j < 2; ++j) { const float rstd = 1.0f / sqrtf(rs[r][j]); const unsigned yw[4] = {y[r][j].x, y[r][j].y, y[r][j].z, y[r][j].w}; unsigned ow[4] = {0u, 0u, 0u, 0u}; if (ML && !FIX_PURE) { ow[0] = o[r][j].x; ow[1] = o[r][j].y; ow[2] = o[r][j].z; ow[3] = o[r][j].w; }
                unsigned res[4];
#pragma unroll
                for (int e = 0; e < 4; ++e) { const float w0 = (e < 2) ? wv[j][0][2 * e] : wv[j][1][2 * e - 4], w1 = (e < 2) ? wv[j][0][2 * e + 1] : wv[j][1][2 * e - 3];
                    float a = blo(yw[e]) * rstd * (FIX_PURE ? 1.f : w0), b2 = bhi(yw[e]) * rstd * (FIX_PURE ? 1.f : w1);
                    if (ML && !FIX_PURE) { a *= sigmoid_f(blo(ow[e])); b2 *= sigmoid_f(bhi(ow[e])); }
                    res[e] = pk2(a, b2); }
                v4u w; w.x = res[0]; w.y = res[1]; w.z = res[2]; w.w = res[3]; NT_STORE(w, (v4u*)(Y + (size_t)(m0 + r) * D + 8 * (lane + 64 * j))); }
    }
}

__device__ __forceinline__ void p_probe_copy(Frame& F, int k) {
    const int gw = F.bid * NWAVES + F.wave, NGW = F.G * NWAVES, lane = F.lane;
    const bf16* Y = (const bf16*)(F.ws + WS_WGU + (size_t)k * 64 * MiB); bf16* O = (bf16*)(F.ws + WS_END + (size_t)k * 64 * MiB);
    for (int m0 = gw * 4; m0 < NT; m0 += NGW * 4) {
        v4u y[4][2];
#pragma unroll
        for (int r = 0; r < 4; ++r)
#pragma unroll
            for (int j = 0; j < 2; ++j) y[r][j] = *(const v4u*)(Y + (size_t)(m0 + r) * D + 8 * (lane + 64 * j));
#pragma unroll
        for (int r = 0; r < 4; ++r)
#pragma unroll
            for (int j = 0; j < 2; ++j) *(v4u*)(O + (size_t)(m0 + r) * D + 8 * (lane + 64 * j)) = y[r][j];
    }
}
template <int ML>
__device__ __forceinline__ void p_fix_row(Frame& F, KArgs A, int L, int m) {
    const int lane = F.lane;
    bf16* Y = (bf16*)(F.ws + (ML ? WS_YML : WS_XSSD)); const float* SSQ = (const float*)(F.ws + (ML ? WS_SSQM : WS_SSQS));
    const bf16* MO = (const bf16*)(F.ws + WS_PROJ + 3 * pg8::SLAB);
    const float* nw = A->in[ML ? I_MNW : I_SNW] + (size_t)L * D;
#pragma unroll
    for (int j = 0; j < 2; ++j) { const v4u y = *(const v4u*)(Y + (size_t)m * D + 8 * (lane + 64 * j)); v4u o = (v4u){0u, 0u, 0u, 0u}; if (ML && !FIX_PURE) o = *(const v4u*)(MO + (size_t)m * D + 8 * (lane + 64 * j));
        const f32x4 q = *(const f32x4*)(SSQ + (size_t)m * 16 + 4 * ((lane >> 5) + 2 * j)); const float rstd = 1.0f / sqrtf(((q.x + q.y) + (q.z + q.w)) * (1.f / 256.f) + RMS_EPS);
        const f32x4 w0 = *(const f32x4*)(nw + 8 * (lane + 64 * j)), w1 = *(const f32x4*)(nw + 8 * (lane + 64 * j) + 4);
        const float wv[8] = {w0.x, w0.y, w0.z, w0.w, w1.x, w1.y, w1.z, w1.w}; const unsigned yw[4] = {y.x, y.y, y.z, y.w}, ow[4] = {o.x, o.y, o.z, o.w}; unsigned res[4];
#pragma unroll
        for (int e = 0; e < 4; ++e) { float a = blo(yw[e]) * rstd * (FIX_PURE ? 1.f : wv[2 * e]), b2 = bhi(yw[e]) * rstd * (FIX_PURE ? 1.f : wv[2 * e + 1]);
            if (ML && !FIX_PURE) { a *= sigmoid_f(blo(ow[e])); b2 *= sigmoid_f(bhi(ow[e])); }
            res[e] = pk2(a, b2); }
        v4u w; w.x = res[0]; w.y = res[1]; w.z = res[2]; w.w = res[3]; *(v4u*)(Y + (size_t)m * D + 8 * (lane + 64 * j)) = w; }
}

__device__ __forceinline__ void p_router(Frame& F, KArgs A, int L) {
    typedef short bf16x8 __attribute__((ext_vector_type(8)));
    const int gw = F.bid * NWAVES + F.wave, NGW = F.G * NWAVES, lane = F.lane, r = lane & 15, g = lane >> 4;
    const float* X = F.out; bf16* H = (bf16*)(F.ws + WS_H);
    const float* nw = A->in[I_N2W] + (size_t)L * D; const bf16* wrh = (const bf16*)(F.ws + WS_WRT); const bf16* wrl = wrh + 80 * 1024;
    const float* bg = A->in[I_BG] + L * 8; const float* ber = A->in[I_BER] + L * 64;
    int* tok_e = (int*)(F.ws + WS_ROUTE); float* tok_w = (float*)(F.ws + WS_ROUTE + 262144); int* tok_rank = (int*)(F.ws + WS_ROUTE + 2 * 262144);
    unsigned* cnt = (unsigned*)F.ctl + CW_CNT + 64 * L;
    LAS float* LG = (LAS float*)(F.lds + RING_OFF) + F.wave * (16 * 80);
    LAS int* lc = (LAS int*)(F.lds + RING_OFF + 49152); LAS int* lb = lc + 64;
    const bool two = ROUTER_2LVL && ((NT / 16) % NGW == 0);
    const bool three = ROUTER_NOATOM && two && (NT / 16 == NGW);
    int* cw = (int*)F.ctl + CW_WG + 16384 * L;
    if (two) { if (F.tid < 64) lc[F.tid] = 0; __syncthreads(); }
    for (int task = gw; task < NT / 16; task += NGW) {
        const int m0 = task * 16; const float* xr = X + (size_t)(m0 + r) * D + 8 * g;
        float s = 0.f;
#if RESID_SSQ
        { const f32x4 q = *(const f32x4*)((const float*)(F.ws + WS_SSQS) + (size_t)(m0 + r) * 16 + 4 * g); s = (q.x + q.y) + (q.z + q.w); }
#else
#pragma unroll 8
        for (int ks = 0; ks < 32; ++ks) { const f32x4 a = *(const f32x4*)(xr + 32 * ks), b = *(const f32x4*)(xr + 32 * ks + 4); s += (a.x * a.x + a.y * a.y) + (a.z * a.z + a.w * a.w) + (b.x * b.x + b.y * b.y) + (b.z * b.z + b.w * b.w); }
#endif
        s += __shfl_xor(s, 16); s += __shfl_xor(s, 32);
        const float rstd = 1.0f / sqrtf(s * (1.f / D) + RMS_EPS);
        f32x4 acc[5];
#pragma unroll
        for (int j = 0; j < 5; ++j) acc[j] = (f32x4){0.f, 0.f, 0.f, 0.f};
        bf16* hr = H + (size_t)(m0 + r) * D + 8 * g;
#pragma unroll 4
        for (int ks = 0; ks < 32; ++ks) {
#if ROUTER_NT
            const f32x4 a = NT_LOAD((const f32x4*)(xr + 32 * ks)), b = NT_LOAD((const f32x4*)(xr + 32 * ks + 4));
#else
            const f32x4 a = *(const f32x4*)(xr + 32 * ks), b = *(const f32x4*)(xr + 32 * ks + 4);
#endif
            const f32x4 wa = *(const f32x4*)(nw + 32 * ks + 8 * g), wb = *(const f32x4*)(nw + 32 * ks + 8 * g + 4);
            float hv[8] = {a.x * rstd * wa.x, a.y * rstd * wa.y, a.z * rstd * wa.z, a.w * rstd * wa.w, b.x * rstd * wb.x, b.y * rstd * wb.y, b.z * rstd * wb.z, b.w * rstd * wb.w};
            bf16x8 ah, al;
#pragma unroll
            for (int e = 0; e < 8; ++e) { const unsigned hi = f2bf(hv[e]); ah[e] = (short)hi; al[e] = (short)f2bf(hv[e] - bf2f((unsigned short)hi)); }
            *(bf16x8*)(hr + 32 * ks) = ah;
#pragma unroll
            for (int j = 0; j < 5; ++j) { const size_t wo = (size_t)(16 * j + r) * 1024 + 32 * ks + 8 * g; const bf16x8 bh = *(const bf16x8*)(wrh + wo), bl = *(const bf16x8*)(wrl + wo);
                acc[j] = __builtin_amdgcn_mfma_f32_16x16x32_bf16(ah, bh, acc[j], 0, 0, 0); acc[j] = __builtin_amdgcn_mfma_f32_16x16x32_bf16(ah, bl, acc[j], 0, 0, 0); acc[j] = __builtin_amdgcn_mfma_f32_16x16x32_bf16(al, bh, acc[j], 0, 0, 0); }
        }
#pragma unroll
        for (int j = 0; j < 5; ++j)
#pragma unroll
            for (int i = 0; i < 4; ++i) LG[(4 * g + i) * 80 + 16 * j + r] = acc[j][i];
        LDS_WAIT(); asm volatile("" ::: "memory");
        int se1 = 0, se2 = 0, sk1 = 0, sk2 = 0;
        if (lane < 16) {
            const LAS float* lg = LG + lane * 80; const int m = m0 + lane;
            float gl[8], gmax; int gsel = 0;
#pragma unroll
            for (int j = 0; j < 8; ++j) gl[j] = lg[j] + bg[j];
            gmax = gl[0];
#pragma unroll
            for (int j = 1; j < 8; ++j) if (gl[j] > gmax) { gmax = gl[j]; gsel = j; }
            float den = 0.f;
#pragma unroll
            for (int j = 0; j < 8; ++j) den += expf(gl[j] - gmax);
            const float pg = 1.0f / den;
            float el[8];
#pragma unroll
            for (int j = 0; j < 8; ++j) el[j] = lg[8 + gsel * 8 + j] + ber[gsel * 8 + j];
            int i1 = 0; float v1 = el[0];
#pragma unroll
            for (int j = 1; j < 8; ++j) if (el[j] > v1) { v1 = el[j]; i1 = j; }
            int i2 = -1; float v2 = -INFINITY;
#pragma unroll
            for (int j = 0; j < 8; ++j) if (j != i1 && el[j] > v2) { v2 = el[j]; i2 = j; }
            const float ex = expf(v2 - v1); const float w1 = pg / (1.0f + ex), w2 = pg * ex / (1.0f + ex);
            const int e1 = gsel * 8 + i1, e2 = gsel * 8 + i2;
            tok_e[2 * m] = e1; tok_e[2 * m + 1] = e2; tok_w[2 * m] = w1; tok_w[2 * m + 1] = w2;
            if (two) { se1 = e1; se2 = e2; sk1 = __hip_atomic_fetch_add(lc + e1, 1, __ATOMIC_RELAXED, __HIP_MEMORY_SCOPE_WORKGROUP); sk2 = __hip_atomic_fetch_add(lc + e2, 1, __ATOMIC_RELAXED, __HIP_MEMORY_SCOPE_WORKGROUP); }
            else { const unsigned k1 = __hip_atomic_fetch_add(cnt + e1, 1u, RLX_AGENT), k2 = __hip_atomic_fetch_add(cnt + e2, 1u, RLX_AGENT); tok_rank[2 * m] = (int)k1; tok_rank[2 * m + 1] = (int)k2; }
        }
        LDS_WAIT(); asm volatile("" ::: "memory");
        if (two) {
            __syncthreads();
            if (F.tid < 64) { const int c = lc[F.tid]; if (three) { cw[(size_t)F.bid * 64 + F.tid] = c; lb[F.tid] = 0; } else lb[F.tid] = c ? (int)__hip_atomic_fetch_add(cnt + F.tid, (unsigned)c, RLX_AGENT) : 0; }
            __syncthreads();
            if (lane < 16) { const int m = m0 + lane; tok_rank[2 * m] = lb[se1] + sk1; tok_rank[2 * m + 1] = lb[se2] + sk2; }
            __syncthreads();
            if (F.tid < 64) lc[F.tid] = 0;
            __syncthreads();
        }
    }
}

__device__ __forceinline__ void moe_table(Frame& F, int L, const LAS int* totp = nullptr) {
    LAS int* tab = (LAS int*)(F.lds + TAB_OFF);
    if (F.wave == 0) {
        const unsigned* cnt = (const unsigned*)F.ctl + CW_CNT + 64 * L; const int lane = F.lane;
        const int n = totp ? totp[lane] : (int)__hip_atomic_load(cnt + lane, RLX_AGENT), tiles = (n + 255) >> 8, rem = n & 255;
        const int tail = (MOE_ROWSKIP == 1 && rem != 0 && rem <= 128) ? 1 : 0;
        int inc = tiles, ia = tiles - tail, ib = tail;
#pragma unroll
        for (int o = 1; o < 64; o <<= 1) { const int t = __shfl_up(inc, o), ta = __shfl_up(ia, o), tb = __shfl_up(ib, o); if (lane >= o) { inc += t; ia += ta; ib += tb; } }
        const int t0 = inc - tiles, a0 = ia - (tiles - tail), b0 = __shfl(ia, 63) + ib - tail;
        tab[lane] = t0; if (lane == 63) tab[64] = inc;
        for (int t = 0; t < tiles; ++t) { const bool is_tail = tail && t == tiles - 1; const int valid = (n - 256 * t) < 256 ? (n - 256 * t) : 256;
            tab[pg8::MOE_ORDER_OFF + (is_tail ? b0 : a0 + t)] = (t0 + t) | (lane << 9) | (valid << 15); }
    }
    __syncthreads();
}
__device__ __forceinline__ void p_gather(Frame& F, int L) {
    const int NGW = F.G * NWAVES; const bool three = ROUTER_NOATOM && ROUTER_2LVL && (NT / 16 == NGW);
    LAS int* part = (LAS int*)(F.lds + RING_OFF); LAS int* tot = part + 1024; LAS int* bs = tot + 64;
    unsigned* cnt = (unsigned*)F.ctl + CW_CNT + 64 * L;
    const int w0 = (2 * F.bid < 256) ? 2 * F.bid : 0;
    if (three) {
        const int* cw = (const int*)F.ctl + CW_WG + 16384 * L; const int lane = F.lane, v = F.wave;
        int all = 0, lt = 0;
#pragma unroll 8
        for (int i = 0; i < 32; ++i) { const int w = 32 * v + i; const int c = cw[w * 64 + lane]; all += c; lt += (w < w0) ? c : 0; }
        part[(v * 2 + 0) * 64 + lane] = all; part[(v * 2 + 1) * 64 + lane] = lt;
        __syncthreads();
        if (v == 0) { int t = 0, b = 0;
#pragma unroll
            for (int j = 0; j < 8; ++j) { t += part[(j * 2 + 0) * 64 + lane]; b += part[(j * 2 + 1) * 64 + lane]; }
            tot[lane] = t; bs[lane] = b; bs[64 + lane] = b + cw[w0 * 64 + lane];
            if (F.bid == 0) cnt[lane] = (unsigned)t; }
        __syncthreads();
    }
    moe_table(F, L, three ? (const LAS int*)tot : nullptr);
    const LAS int* tab = (const LAS int*)(F.lds + TAB_OFF);
    const int* tok_e = (const int*)(F.ws + WS_ROUTE); const int* tok_rank = (const int*)(F.ws + WS_ROUTE + 2 * 262144); int* tok_pos = (int*)(F.ws + WS_ROUTE + 3 * 262144);
    int* row_tok = (int*)(F.ws + WS_ROWTOK);
    for (int a = F.bid * 512 + F.tid; a < 2 * NT; a += F.G * 512) { const int e = tok_e[a]; int pos = tab[e] * 256 + tok_rank[a]; if (three) pos += bs[(((a >> 1) >> 7) - w0) * 64 + e]; tok_pos[a] = pos; row_tok[pos] = a >> 1; }
    for (int e = F.bid; e < 64; e += F.G) { const int c0 = tab[e] * 256 + (three ? tot[e] : (int)__hip_atomic_load(cnt + e, RLX_AGENT)), c1 = tab[e + 1] * 256;
        for (int r = c0 + F.tid; r < c1; r += 512) row_tok[r] = 0; }
}

__device__ __forceinline__ void p_conv2(Frame& F, const bf16* src0, int ld0, const bf16* src1, int ld1, bf16* dst0, bf16* dst1, const float* cw, const float* cb, float sc0, float sc1) {
    const int gw = F.bid * NWAVES + F.wave, NGW = F.G * NWAVES, lane = F.lane;
    for (int task = gw; task < 2048; task += NGW) {
        const int which = task >> 10, rem = task & 1023, chalf = rem & 1, rb = rem >> 1;
        const int c = chalf * 512 + lane * 8, cc = which * 1024 + c;
        const bf16* src = (which ? src1 : src0) + c; const int ld = which ? ld1 : ld0; bf16* dst = (which ? dst1 : dst0) + c; const float sc = which ? sc1 : sc0;
        float w[4][8], bb[8];
#pragma unroll
        for (int k = 0; k < 4; ++k) { const f32x4 a = *(const f32x4*)(cw + k * 2048 + cc), b2 = *(const f32x4*)(cw + k * 2048 + cc + 4); w[k][0] = a.x; w[k][1] = a.y; w[k][2] = a.z; w[k][3] = a.w; w[k][4] = b2.x; w[k][5] = b2.y; w[k][6] = b2.z; w[k][7] = b2.w; }
        { const f32x4 a = *(const f32x4*)(cb + cc), b2 = *(const f32x4*)(cb + cc + 4); bb[0] = a.x; bb[1] = a.y; bb[2] = a.z; bb[3] = a.w; bb[4] = b2.x; bb[5] = b2.y; bb[6] = b2.z; bb[7] = b2.w; }
        const int row0 = rb * 64; const bool first = (row0 & (SEQ - 1)) == 0;
        float r0[8], r1[8], r2[8];
#pragma unroll
        for (int e = 0; e < 8; ++e) { r0[e] = 0.f; r1[e] = 0.f; r2[e] = 0.f; }
        if (!first) {
            const v4u a = *(const v4u*)(src + (size_t)(row0 - 3) * ld), b2 = *(const v4u*)(src + (size_t)(row0 - 2) * ld), c2 = *(const v4u*)(src + (size_t)(row0 - 1) * ld);
            r0[0] = blo(a.x); r0[1] = bhi(a.x); r0[2] = blo(a.y); r0[3] = bhi(a.y); r0[4] = blo(a.z); r0[5] = bhi(a.z); r0[6] = blo(a.w); r0[7] = bhi(a.w);
            r1[0] = blo(b2.x); r1[1] = bhi(b2.x); r1[2] = blo(b2.y); r1[3] = bhi(b2.y); r1[4] = blo(b2.z); r1[5] = bhi(b2.z); r1[6] = blo(b2.w); r1[7] = bhi(b2.w);
            r2[0] = blo(c2.x); r2[1] = bhi(c2.x); r2[2] = blo(c2.y); r2[3] = bhi(c2.y); r2[4] = blo(c2.z); r2[5] = bhi(c2.z); r2[6] = blo(c2.w); r2[7] = bhi(c2.w);
        }
        for (int rr = 0; rr < 64; rr += 8) {
            v4u in[8];
#pragma unroll
            for (int i = 0; i < 8; ++i) in[i] = *(const v4u*)(src + (size_t)(row0 + rr + i) * ld);
#pragma unroll
            for (int i = 0; i < 8; ++i) {
                float r3[8]; r3[0] = blo(in[i].x); r3[1] = bhi(in[i].x); r3[2] = blo(in[i].y); r3[3] = bhi(in[i].y); r3[4] = blo(in[i].z); r3[5] = bhi(in[i].z); r3[6] = blo(in[i].w); r3[7] = bhi(in[i].w);
                float y[8];
#pragma unroll
                for (int e = 0; e < 8; ++e) { const float t = bb[e] + w[0][e] * r0[e] + w[1][e] * r1[e] + w[2][e] * r2[e] + w[3][e] * r3[e]; y[e] = t * __builtin_amdgcn_rcpf(1.0f + __expf(-t)) * sc; r0[e] = r1[e]; r1[e] = r2[e]; r2[e] = r3[e]; }
                v4u o; o.x = pk2(y[0], y[1]); o.y = pk2(y[2], y[3]); o.z = pk2(y[4], y[5]); o.w = pk2(y[6], y[7]);
                *(v4u*)(dst + (size_t)(row0 + rr + i) * 1024) = o;
            }
        }
    }
}

__device__ __forceinline__ void p_convfix(Frame& F, bf16* d0, bf16* d1, const float* cw, const float* cb, float sc1, size_t rawh_off) {
    const bf16* rawh = (const bf16*)(F.ws + rawh_off);
    for (int p = F.bid * 512 + F.tid; p < 512 * 256; p += F.G * 512) {
        const int cg = p & 255, B = p >> 8; const int ch = cg * 8; const bool seq0 = (B & 31) == 0;
        v4u sl[6];
#pragma unroll
        for (int k = 0; k < 6; ++k) { sl[k] = (v4u){0u, 0u, 0u, 0u}; if (!(seq0 && k < 3)) sl[k] = *(const v4u*)(rawh + ((size_t)B * 6 + k) * 2048 + ch); }
        float w[4][8], bb[8];
#pragma unroll
        for (int h = 0; h < 2; ++h) { const f32x4 a0 = *(const f32x4*)(cw + ch + 4 * h), a1 = *(const f32x4*)(cw + 2048 + ch + 4 * h), a2 = *(const f32x4*)(cw + 4096 + ch + 4 * h), a3 = *(const f32x4*)(cw + 6144 + ch + 4 * h), b4 = *(const f32x4*)(cb + ch + 4 * h);
#pragma unroll
            for (int e = 0; e < 4; ++e) { w[0][4 * h + e] = a0[e]; w[1][4 * h + e] = a1[e]; w[2][4 * h + e] = a2[e]; w[3][4 * h + e] = a3[e]; bb[4 * h + e] = b4[e]; } }
        float x[6][8];
#pragma unroll
        for (int k = 0; k < 6; ++k) { const v4u v = sl[k]; x[k][0] = blo(v.x); x[k][1] = bhi(v.x); x[k][2] = blo(v.y); x[k][3] = bhi(v.y); x[k][4] = blo(v.z); x[k][5] = bhi(v.z); x[k][6] = blo(v.w); x[k][7] = bhi(v.w); }
        const float sc = ch >= 1024 ? sc1 : 1.0f; bf16* dst = (ch >= 1024 ? d1 : d0) + (size_t)(B * 64) * 1024 + (ch & 1023);
#pragma unroll
        for (int r = 0; r < 3; ++r) { float y[8];
#pragma unroll
            for (int e = 0; e < 8; ++e) { const float t = bb[e] + w[0][e] * x[r][e] + w[1][e] * x[r + 1][e] + w[2][e] * x[r + 2][e] + w[3][e] * x[r + 3][e];
                y[e] = t * __builtin_amdgcn_rcpf(1.0f + __expf(-t)) * sc; }
            v4u o; o.x = pk2(y[0], y[1]); o.y = pk2(y[2], y[3]); o.z = pk2(y[4], y[5]); o.w = pk2(y[6], y[7]);
            *(v4u*)(dst + (size_t)r * 1024) = o; }
    }
}

namespace mixk {
typedef short bf16x8 __attribute__((ext_vector_type(8)));
typedef short s16x4 __attribute__((ext_vector_type(4)));
typedef float f32x16 __attribute__((ext_vector_type(16)));
__device__ __forceinline__ unsigned offb(unsigned row, unsigned ch) { return 2048u * (row >> 3) + 512u * (ch >> 2) + 64u * (row & 7u) + 16u * ((ch & 3u) ^ ((row >> 2) & 3u)); }
__device__ __forceinline__ s16x4 trrd(const LAS unsigned char* p) { return __builtin_bit_cast(s16x4, __builtin_amdgcn_ds_read_tr16_b64_v4i16((LAS s16x4*)p)); }
struct FragBase { unsigned re, t0, t1; };
struct FragBase16 { unsigned r16, u0, u1; };
__device__ __forceinline__ FragBase frag_base(int lane) {
    FragBase f; const unsigned l31 = lane & 31, h = lane >> 5, x = (l31 >> 2) & 3;
    f.re = 2048u * (l31 >> 3) + 64u * (l31 & 7) + 16u * (h ^ x);
    const unsigned blk = (lane >> 4) & 1, q = (lane & 15) >> 2, p = lane & 3, cc = 2 * blk + (p >> 1);
    f.t0 = 2048u * h + 64u * q + 16u * (cc ^ (2 * h)) + 8u * (p & 1); f.t1 = 2048u * h + 64u * (4 + q) + 16u * (cc ^ (2 * h + 1)) + 8u * (p & 1);
    return f;
}
__device__ __forceinline__ FragBase16 frag_base16(int lane, int c16  ) {
    FragBase16 f; const unsigned l15 = lane & 15, g = lane >> 4, q = (lane & 15) >> 2, p = lane & 3;
    f.r16 = 2048u * (l15 >> 3) + 64u * (l15 & 7) + 16u * (g ^ ((l15 >> 2) & 3));
    const unsigned c2 = 2 * (c16 & 1) + (p >> 1);
    f.u0 = 2048u * g + 512u * (c16 >> 1) + 64u * q + 16u * (c2 ^ ((2 * g) & 3)) + 8u * (p & 1); f.u1 = 2048u * g + 512u * (c16 >> 1) + 64u * (4 + q) + 16u * (c2 ^ ((2 * g + 1) & 3)) + 8u * (p & 1);
    return f;
}
__device__ __forceinline__ bf16x8 rowfrag(const LAS unsigned char* tile, const FragBase& f, int rb, int s) { return *(const LAS bf16x8*)(tile + rb * 8192 + (s >> 1) * 512 + (f.re ^ ((unsigned)(s & 1) << 5))); }
__device__ __forceinline__ bf16x8 trfrag(const LAS unsigned char* tile, const FragBase& f, int c, int ks) {
    const s16x4 lo = trrd(tile + 4096 * ks + 512 * c + f.t0), hi = trrd(tile + 4096 * ks + 512 * c + f.t1);
    return (bf16x8){lo[0], lo[1], lo[2], lo[3], hi[0], hi[1], hi[2], hi[3]};
}
__device__ __forceinline__ bf16x8 rowfrag16(const LAS unsigned char* tile, const FragBase16& f, int rb, int s) { return *(const LAS bf16x8*)(tile + rb * 4096 + s * 512 + f.r16); }
__device__ __forceinline__ bf16x8 trfrag16(const LAS unsigned char* tile, const FragBase16& f, int ks) {
    const s16x4 lo = trrd(tile + 8192 * ks + f.u0), hi = trrd(tile + 8192 * ks + f.u1);
    return (bf16x8){lo[0], lo[1], lo[2], lo[3], hi[0], hi[1], hi[2], hi[3]};
}
__device__ __forceinline__ float fast_logsigmoid(float x) { return fminf(x, 0.f) - __logf(1.0f + __expf(-fabsf(x))); }
__device__ __forceinline__ float fast_softplus(float x) { return fmaxf(x, 0.f) + __logf(1.0f + __expf(-fabsf(x))); }
constexpr int SC_A = 0, SC_M = 128, SC_INTER = 256, SC_EMT = 384, SC_WK = 512, SC_DEN1 = 640, SC_DEN2 = 1152, SC_N0 = 1280, SC_N1 = 1536, SC_MISC = 1792;

template <int CTRL, int RM> __device__ __forceinline__ float dpp_keep(float old, float v) { return __builtin_bit_cast(float, __builtin_amdgcn_update_dpp(__builtin_bit_cast(int, old), __builtin_bit_cast(int, v), CTRL, RM, 0xF, false)); }
__device__ __forceinline__ float scan_add(float v) {
    v += dpp_keep<0x111, 0xF>(0.f, v); v += dpp_keep<0x112, 0xF>(0.f, v); v += dpp_keep<0x114, 0xF>(0.f, v); v += dpp_keep<0x118, 0xF>(0.f, v);
    v += dpp_keep<0x142, 0xA>(0.f, v); v += dpp_keep<0x143, 0xC>(0.f, v); return v;
}
__device__ __forceinline__ float scan_max(float v) {
    v = fmaxf(v, dpp_keep<0x111, 0xF>(-INFINITY, v)); v = fmaxf(v, dpp_keep<0x112, 0xF>(-INFINITY, v)); v = fmaxf(v, dpp_keep<0x114, 0xF>(-INFINITY, v)); v = fmaxf(v, dpp_keep<0x118, 0xF>(-INFINITY, v));
    v = fmaxf(v, dpp_keep<0x142, 0xA>(-INFINITY, v)); v = fmaxf(v, dpp_keep<0x143, 0xC>(-INFINITY, v)); return v;
}
__device__ __forceinline__ float lane63(float v) { return __builtin_bit_cast(float, __builtin_amdgcn_readlane(__builtin_bit_cast(int, v), 63)); }
__device__ __forceinline__ void guest_piece(Frame& F, KArgs A, int L, int id, int lane, const float*& src, int& ld, bf16*& dst, int& dk) {
    const int kq = lane & 7, g = lane >> 3; const int e = id / 768, r = id - e * 768;
    if (r < 512) { const int m = r >> 8, rr = r & 255, kb = rr >> 4, nb = rr & 15;
        src = (m ? A->in[I_WUP] : A->in[I_WGATE]) + (size_t)(L * 64 + e) * 524288 + (size_t)(kb * 64 + 8 * kq) * 512 + nb * 32 + 4 * g; ld = 512;
        dst = (bf16*)(F.ws + WS_WGU) + (size_t)e * 1048576 + (size_t)(8 * (nb * 8 + g) + 4 * m) * 1024 + kb * 64 + 8 * kq; dk = 1024; }
    else { const int rr = r - 512, kb = rr >> 5, nb = rr & 31;
        src = A->in[I_WDOWN] + (size_t)(L * 64 + e) * 524288 + (size_t)(kb * 64 + 8 * kq) * 1024 + nb * 32 + 4 * g; ld = 1024;
        dst = (bf16*)(F.ws + WS_WDN) + (size_t)e * 524288 + (size_t)(nb * 32 + 4 * g) * 512 + kb * 64 + 8 * kq; dk = 512; }
}
template <int MODE>
__device__ __forceinline__ void chunk_unit(Frame& F, KArgs A, int L, int b, int h, int vs, const bool guest) {
    constexpr int NH = (MODE == 0) ? 2 : 1;
    LAS unsigned char* QH = F.lds + RING_OFF; LAS unsigned char* KH = QH + 32768; LAS unsigned char* VV = QH + 65536; LAS unsigned char* CS = QH + 98304;
    LAS float* SC = (LAS float*)(F.lds + LDSCTL_OFF + 2048);
    int tid0 = F.tid; asm volatile("" : "+v"(tid0)); const int w = F.wave;
    const size_t rowb = (size_t)b * SEQ;
    const bf16 *Qg, *Kg, *Vg; int vcol;
    if (MODE == 0) { Qg = (const bf16*)(F.ws + WS_YATT) + h * 256; Kg = (const bf16*)(F.ws + WS_YSSD) + h * 256; Vg = (const bf16*)(F.ws + WS_PROJ + 2 * pg8::SLAB) + h * 256 + vs * 64; vcol = h * 256 + vs * 64; }
    else { const int g = h >> 2; Qg = (const bf16*)(F.ws + WS_PROJ + 1 * pg8::SLAB) + 512 + g * 128; Kg = (const bf16*)(F.ws + WS_PROJ + 1 * pg8::SLAB) + g * 128; Vg = (const bf16*)(F.ws + WS_XSSD) + h * 64; vcol = h * 64; }
    bf16* Yg = (bf16*)(F.ws + (MODE == 0 ? WS_YML : WS_XSSD)) + vcol;
    float* SSQ = (float*)(F.ws + (MODE == 0 ? WS_SSQM : WS_SSQS));
    const float* SM = (const float*)(F.ws + WS_SMALL) + rowb * 64;
    v4u qpre[4], kpre[4], vpre[2];
#define MIX_LOADQK(c_, hh_) do { const int r7_ = (tid >> 2) & 7, x_ = (2 * (tid >> 7) + (r7_ >> 2)) & 3; \
        const size_t go = (rowb + (size_t)(c_) * 128 + 8 * (tid >> 7) + r7_) * 1024 + (hh_) * 128 + (4 * ((tid >> 5) & 3) + ((tid & 3) ^ x_)) * 8; \
        _Pragma("unroll") for (int i = 0; i < 4; ++i) { qpre[i] = *(const v4u*)(Qg + go + (size_t)i * 32768); kpre[i] = *(const v4u*)(Kg + go + (size_t)i * 32768); } } while (0)
#define MIX_LOADV(c_) do { const int r7_ = (tid >> 2) & 7, x_ = (2 * (tid >> 6) + (r7_ >> 2)) & 3; \
        const size_t go = (rowb + (size_t)(c_) * 128 + 8 * (tid >> 6) + r7_) * 1024 + (4 * ((tid >> 5) & 1) + ((tid & 3) ^ x_)) * 8; vpre[0] = NT_LOAD((const v4u*)(Vg + go)); vpre[1] = NT_LOAD((const v4u*)(Vg + go + 65536)); } while (0)
#define MIX_STOREQK() do { _Pragma("unroll") for (int i = 0; i < 4; ++i) { *(LAS v4u*)(QH + 16u * tid + 8192u * i) = qpre[i]; *(LAS v4u*)(KH + 16u * tid + 8192u * i) = kpre[i]; } } while (0)
    const int tid = tid0;
    f32x16 Cacc[NH];
#pragma unroll
    for (int hh = 0; hh < NH; ++hh)
#pragma unroll
        for (int r = 0; r < 16; ++r) Cacc[hh][r] = 0.f;
    for (int i = tid; i < 8192; i += 512) ((LAS unsigned*)CS)[i] = 0u;
    if (MODE == 0) { for (int i = tid; i < 512; i += 512) SC[SC_N0 + i] = 0.f; }
    float m_prev = 0.f;
    const float p_ib = (MODE == 0) ? A->in[I_MIB][L * 4 + h] : 0.f, p_fb = (MODE == 0) ? A->in[I_MFB][L * 4 + h] : 0.f;
    const float p_dtb = (MODE == 1) ? A->in[I_SDTB][L * 16 + h] : 0.f, p_A = (MODE == 1) ? -expf(A->in[I_SALOG][L * 16 + h]) : 0.f, p_D = (MODE == 1) ? A->in[I_SD][L * 16 + h] : 0.f;
    float gq0 = 0.f, gq1 = 0.f, gr0 = 0.f, gr1 = 0.f;
#define MIX_LOADG(c_) do { const float* sm_ = SM + (size_t)((c_) * 128 + 2 * (tid & 63)) * 64; if (MODE == 0) { gq0 = sm_[36 + h]; gq1 = sm_[64 + 36 + h]; gr0 = sm_[32 + h]; gr1 = sm_[64 + 32 + h]; } else { gq0 = sm_[16 + h]; gq1 = sm_[64 + 16 + h]; } } while (0)
    if (w == 0) MIX_LOADG(0);
    MIX_LOADQK(0, 0); MIX_LOADV(0);
    __syncthreads();

    for (int c = 0; c < SEQ / 128; ++c) {
        int tid = F.tid; asm volatile("" : "+v"(tid)); int lane = tid & 63;
        const int hl = lane >> 5, l31 = lane & 31; const FragBase fb = frag_base(lane);
        LAS float* nOld = SC + ((c & 1) ? SC_N1 : SC_N0); LAS float* nNew = SC + ((c & 1) ? SC_N0 : SC_N1);
        if (w == 0) {
            float x0, x1, y0, y1;
            if (MODE == 0) { x0 = fast_logsigmoid(gq0 + p_fb); x1 = fast_logsigmoid(gq1 + p_fb); y0 = gr0 + p_ib; y1 = gr1 + p_ib; }
            else { const float d0 = fast_softplus(gq0 + p_dtb), d1 = fast_softplus(gq1 + p_dtb); x0 = d0 * p_A; x1 = d1 * p_A; y0 = __logf(d0); y1 = __logf(d1); }
            if (c + 1 < SEQ / 128) MIX_LOADG(c + 1);
            const float ps = x0 + x1, inc = scan_add(ps);
            const float b0 = inc - ps + x0, b1 = inc;
            const float a0 = y0 - b0, a1 = y1 - b1;
            float M0, M1, Mlast, inter0, inter1, emt0 = 0.f, emt1 = 0.f, wk0, wk1, cs;
            if (MODE == 0) {
                const float im = scan_max(fmaxf(a0, a1));
                const float ex = dpp_keep<0x138, 0xF>(-INFINITY, im);
                const float c0 = fmaxf(ex, a0), c1 = fmaxf(c0, a1);
                M0 = fmaxf(m_prev, c0); M1 = fmaxf(m_prev, c1); Mlast = lane63(M1);
                inter0 = __expf(m_prev - M0); inter1 = __expf(m_prev - M1); emt0 = __expf(-b0 - M0); emt1 = __expf(-b1 - M1);
                wk0 = __expf(a0 - Mlast); wk1 = __expf(a1 - Mlast); cs = __expf(m_prev - Mlast);
                m_prev = lane63(b1) + Mlast;
            } else {
                M0 = -b0; M1 = -b1; const float bl = lane63(b1); inter0 = __expf(b0); inter1 = __expf(b1);
                wk0 = __expf(bl + a0); wk1 = __expf(bl + a1); cs = __expf(bl);
            }
            SC[SC_A + 2 * lane] = a0; SC[SC_A + 2 * lane + 1] = a1; SC[SC_M + 2 * lane] = M0; SC[SC_M + 2 * lane + 1] = M1;
            SC[SC_INTER + 2 * lane] = inter0; SC[SC_INTER + 2 * lane + 1] = inter1; SC[SC_EMT + 2 * lane] = emt0; SC[SC_EMT + 2 * lane + 1] = emt1;
            SC[SC_WK + 2 * lane] = wk0; SC[SC_WK + 2 * lane + 1] = wk1; if (lane == 0) SC[SC_MISC] = cs;
        }
        MIX_STOREQK();
        __syncthreads();
#pragma unroll
        for (int i = 0; i < 2; ++i) { const int rg = (tid >> 6) + 8 * i, row = 8 * rg + ((tid >> 2) & 7); const float wk = SC[SC_WK + row]; const v4u v = vpre[i];
            const unsigned va = 2048u * rg + 512u * ((tid >> 5) & 1) + 64u * ((tid >> 2) & 7) + 16u * (tid & 3);
            *(LAS v4u*)(VV + va) = v; v4u o; o.x = pk2(blo(v.x) * wk, bhi(v.x) * wk); o.y = pk2(blo(v.y) * wk, bhi(v.y) * wk); o.z = pk2(blo(v.z) * wk, bhi(v.z) * wk); o.w = pk2(blo(v.w) * wk, bhi(v.w) * wk);
            *(LAS v4u*)(VV + va + 1024u) = o; }
        if (NH == 2) MIX_LOADQK(c, 1);
        const float cs = SC[SC_MISC];
#pragma unroll
        for (int hh = 0; hh < NH; ++hh)
#pragma unroll
            for (int r = 0; r < 16; ++r) Cacc[hh][r] *= cs;
        __syncthreads();
        const int tau = w >> 1, nu = w & 1;
        f32x16 X0, X1, N2; f32x4 d2 = (f32x4){0.f, 0.f, 0.f, 0.f}; unsigned ppk[2][8];
#pragma unroll
        for (int r = 0; r < 16; ++r) { X0[r] = 0.f; X1[r] = 0.f; N2[r] = 0.f; }
        const bool x0on = (2 * nu) <= tau, x1on = (2 * nu + 1) <= tau;
#pragma unroll
        for (int hh = 0; hh < NH; ++hh) {
            if (hh == 1) { __syncthreads(); MIX_STOREQK(); __syncthreads(); }
#define MIX_SB() __builtin_amdgcn_sched_barrier(0)
            {
                bf16x8 qf = rowfrag(QH, fb, tau, 0), cf = trfrag(CS, fb, 2 * hh + nu, 0), k0 = rowfrag(KH, fb, 2 * nu, 0), k1 = rowfrag(KH, fb, 2 * nu + 1, 0);
#pragma unroll
                for (int ks = 0; ks < 8; ++ks) { const int kn = (ks + 1) & 7;
                    const bf16x8 qn = rowfrag(QH, fb, tau, kn), cn = trfrag(CS, fb, 2 * hh + nu, kn), k0n = rowfrag(KH, fb, 2 * nu, kn), k1n = rowfrag(KH, fb, 2 * nu + 1, kn);
                    N2 = __builtin_amdgcn_mfma_f32_32x32x16_bf16(qf, cf, N2, 0, 0, 0);
                    if (x0on) X0 = __builtin_amdgcn_mfma_f32_32x32x16_bf16(k0, qf, X0, 0, 0, 0);
                    if (x1on) X1 = __builtin_amdgcn_mfma_f32_32x32x16_bf16(k1, qf, X1, 0, 0, 0);
                    MIX_SB(); qf = qn; cf = cn; k0 = k0n; k1 = k1n; }
            }
            MIX_SB();
            if (hh == NH - 1) {
                const int t = 32 * tau + l31; const float Mt = SC[SC_M + t];
#pragma unroll
                for (int xi = 0; xi < 2; ++xi) {
                    const int sig = 2 * nu + xi; const f32x16& X = xi ? X1 : X0; float cs1 = 0.f;
#pragma unroll
                    for (int g = 0; g < 4; ++g) { const int s0 = 32 * sig + 8 * g + 4 * hl; const f32x4 av = *(const LAS f32x4*)(SC + SC_A + s0); float p[4];
#pragma unroll
                        for (int i = 0; i < 4; ++i) { const float e = __expf(av[i] - Mt); p[i] = (s0 + i <= t) ? X[4 * g + i] * e : 0.f; cs1 += p[i]; }
                        ppk[xi][2 * g] = pk2(p[0], p[1]); ppk[xi][2 * g + 1] = pk2(p[2], p[3]); }
                    if (MODE == 0 && sig <= tau) { cs1 += __shfl_xor(cs1, 32); if (hl == 0) SC[SC_DEN1 + sig * 128 + t] = cs1; }
                }
                MIX_SB();
            }
            {
                bf16x8 kf = trfrag(KH, fb, tau, 0), vf = trfrag(VV, fb, 2 + nu, 0);
#pragma unroll
                for (int ks = 0; ks < 8; ++ks) { const int kn = (ks + 1) & 7; const bf16x8 kfn = trfrag(KH, fb, tau, kn), vfn = trfrag(VV, fb, 2 + nu, kn);
                    Cacc[hh] = __builtin_amdgcn_mfma_f32_32x32x16_bf16(kf, vf, Cacc[hh], 0, 0, 0); MIX_SB(); kf = kfn; vf = vfn; }
            }
            MIX_SB();
            if (MODE == 0) {
                f32x4 nacc = (f32x4){0.f, 0.f, 0.f, 0.f}; int lane16 = lane; asm volatile("" : "+v"(lane16)); const FragBase16 fb16 = frag_base16(lane16, w);
#pragma unroll
                for (int ks = 0; ks < 4; ++ks) {
                    bf16x8 nb = (bf16x8){0, 0, 0, 0, 0, 0, 0, 0}, wb = nb;
                    if ((lane & 15) == 0) { const LAS float* np = nOld + hh * 128 + 32 * ks + 8 * (lane >> 4); const LAS float* wp = SC + SC_WK + 32 * ks + 8 * (lane >> 4);
#pragma unroll
                        for (int j = 0; j < 8; ++j) { nb[j] = (short)f2bf(np[j]); wb[j] = (short)f2bf(wp[j]); } }
                    const bf16x8 qa = rowfrag16(QH, fb16, w, ks); d2 = __builtin_amdgcn_mfma_f32_16x16x32_bf16(qa, nb, d2, 0, 0, 0);
                    const bf16x8 ka = trfrag16(KH, fb16, ks); nacc = __builtin_amdgcn_mfma_f32_16x16x32_bf16(ka, wb, nacc, 0, 0, 0); MIX_SB();
                }
                if ((lane & 15) == 0) {
#pragma unroll
                    for (int r = 0; r < 4; ++r) { const int d = hh * 128 + 16 * w + 4 * (lane >> 4) + r; nNew[d] = cs * nOld[d] + nacc[r]; }
                }
            }
        }
        if (MODE == 0) { if ((lane & 15) == 0) {
#pragma unroll
            for (int r = 0; r < 4; ++r) SC[SC_DEN2 + 16 * w + 4 * (lane >> 4) + r] = d2[r]; } }
        __syncthreads();
#if USE_GUEST_CVT
        f32x4 gv[8]; bf16* gdst = nullptr; int gdk = 0;
        const bool gon = guest && (MODE == 0 || (c & 1) == 0);
        if (gon) { const int gid = (MODE == 0) ? (c * 256 + F.bid) * 8 + w : 32768 + ((c >> 1) * 256 + F.bid) * 8 + w; const float* gsrc; int gld; guest_piece(F, A, L, gid, lane, gsrc, gld, gdst, gdk);
#pragma unroll
            for (int j = 0; j < 8; ++j) gv[j] = NT_LOAD((const f32x4*)(gsrc + (size_t)j * gld)); }
        MIX_SB();
#endif
        if (c + 1 < SEQ / 128) { MIX_LOADQK(c + 1, 0); if (MODE == 0) MIX_LOADV(c + 1); }
        v4u og0 = (v4u){0u, 0u, 0u, 0u}, og1 = og0;
        if (MODE == 1 && SSD_ZPRE) { const bf16* zp = (const bf16*)(F.ws + WS_PROJ) + (rowb + (size_t)c * 128 + (tid >> 2)) * 1024 + h * 64 + (tid & 3) * 16; og0 = NT_LOAD((const v4u*)zp); og1 = NT_LOAD((const v4u*)(zp + 8)); }
        if (MODE == 0 && FIX_PURE) { const bf16* op = (const bf16*)(F.ws + WS_PROJ + 3 * pg8::SLAB) + (rowb + (size_t)c * 128 + (tid >> 2)) * 1024 + vcol + (tid & 3) * 16; og0 = NT_LOAD((const v4u*)op); og1 = NT_LOAD((const v4u*)(op + 8)); }
        if (MODE == 0 && tid < 128) {
            float den = SC[SC_INTER + tid] * SC[SC_DEN2 + tid];
#pragma unroll
            for (int sg = 0; sg < 4; ++sg) if (sg <= (tid >> 5)) den += SC[SC_DEN1 + sg * 128 + tid];
            SC[SC_EMT + tid] = 1.0f / fmaxf(fabsf(den), SC[SC_EMT + tid]);
        }
        {
            const unsigned pb = 2048u * (4 * tau + (l31 >> 3)) + 64u * (l31 & 7) + 16u * ((l31 >> 2) & 3) + 8u * hl;
#pragma unroll
            for (int xi = 0; xi < 2; ++xi) {
                const int sig = 2 * nu + xi; if (sig > tau) continue;
#pragma unroll
                for (int g = 0; g < 4; ++g) { v2u o; o.x = ppk[xi][2 * g]; o.y = ppk[xi][2 * g + 1]; *(LAS v2u*)(QH + (pb ^ (16u * g)) + 512u * sig) = o; }
            }
            MIX_SB();
            const unsigned cb = 8192u * tau + 512u * nu + 256u * hl + 2u * (l31 & 7), e0 = 16u * ((l31 >> 3) ^ hl);
#pragma unroll
            for (int hh = 0; hh < NH; ++hh)
#pragma unroll
                for (int r = 0; r < 16; ++r) { const int g = r >> 2, i = r & 3;
                    *(LAS unsigned short*)(CS + cb + 1024u * hh + 2048u * g + 64u * i + (e0 ^ (32u * (g & 1)))) = (unsigned short)f2bf(Cacc[hh][r]); }
            MIX_SB();
        }
        __syncthreads();
        {
            f32x16 N1;
#pragma unroll
            for (int r = 0; r < 16; ++r) N1[r] = 0.f;
            for (int ks = 0; ks < 2 * (tau + 1); ++ks) { const bf16x8 pf = rowfrag(QH, fb, tau, ks); const bf16x8 vf = trfrag(VV, fb, nu, ks); N1 = __builtin_amdgcn_mfma_f32_32x32x16_bf16(pf, vf, N1, 0, 0, 0); MIX_SB(); }
            LAS float* HT = (LAS float*)KH;
            MIX_SB();
#pragma unroll
            for (int g = 0; g < 4; ++g) { const int t0 = 32 * tau + 8 * g + 4 * hl; const f32x4 iv = *(const LAS f32x4*)(SC + SC_INTER + t0); f32x4 rv = (f32x4){1.f, 1.f, 1.f, 1.f}; if (MODE == 0) rv = *(const LAS f32x4*)(SC + SC_EMT + t0);
#pragma unroll
                for (int i = 0; i < 4; ++i) HT[(t0 + i) * 64 + 32 * nu + l31] = (N1[4 * g + i] + iv[i] * N2[4 * g + i]) * rv[i];
                MIX_SB(); }
        }
        __syncthreads();
        if (MODE == 1 && SSD_VEARLY && c + 1 < SEQ / 128) MIX_LOADV(c + 1);
        {
            const int t = tid >> 2, q4 = tid & 3; const LAS float* hp = (const LAS float*)KH + t * 64 + q4 * 16; float y[16];
#pragma unroll
            for (int i = 0; i < 4; ++i) { const f32x4 v = *(const LAS f32x4*)(hp + 4 * i); y[4 * i] = v.x; y[4 * i + 1] = v.y; y[4 * i + 2] = v.z; y[4 * i + 3] = v.w; }
            const size_t grow = rowb + (size_t)c * 128 + t;
            if (MODE == 1) {
                const bf16* zp = (const bf16*)(F.ws + WS_PROJ) + grow * 1024 + h * 64 + q4 * 16; v4u z0, z1; if (SSD_ZPRE) { z0 = og0; z1 = og1; } else { z0 = NT_LOAD((const v4u*)zp); z1 = NT_LOAD((const v4u*)(zp + 8)); }
                const v4u x0 = *(const LAS v4u*)(VV + offb(t, 2 * q4)), x1 = *(const LAS v4u*)(VV + offb(t, 2 * q4 + 1));
                const unsigned zz[8] = {z0.x, z0.y, z0.z, z0.w, z1.x, z1.y, z1.z, z1.w}, xx[8] = {x0.x, x0.y, x0.z, x0.w, x1.x, x1.y, x1.z, x1.w};
#pragma unroll
                for (int i = 0; i < 8; ++i) { const float za = blo(zz[i]), zb = bhi(zz[i]); y[2 * i] = (y[2 * i] + p_D * blo(xx[i])) * (za * __builtin_amdgcn_rcpf(1.0f + __expf(-za))); y[2 * i + 1] = (y[2 * i + 1] + p_D * bhi(xx[i])) * (zb * __builtin_amdgcn_rcpf(1.0f + __expf(-zb))); }
            }
            float q = 0.f;
#pragma unroll
            for (int i = 0; i < 16; ++i) q += y[i] * y[i];
            q += __shfl_xor(q, 1); q += __shfl_xor(q, 2);
            if (q4 == 0) SSQ[grow * 16 + (MODE == 0 ? h * 4 + vs : h)] = q;
            if (MODE == 0 && FIX_PURE) { const unsigned gg[8] = {og0.x, og0.y, og0.z, og0.w, og1.x, og1.y, og1.z, og1.w};
#pragma unroll
                for (int i = 0; i < 8; ++i) { y[2 * i] *= __builtin_amdgcn_rcpf(1.0f + __expf(-blo(gg[i]))); y[2 * i + 1] *= __builtin_amdgcn_rcpf(1.0f + __expf(-bhi(gg[i]))); } }
            v4u o0, o1; o0.x = pk2(y[0], y[1]); o0.y = pk2(y[2], y[3]); o0.z = pk2(y[4], y[5]); o0.w = pk2(y[6], y[7]); o1.x = pk2(y[8], y[9]); o1.y = pk2(y[10], y[11]); o1.z = pk2(y[12], y[13]); o1.w = pk2(y[14], y[15]);
            bf16* yp = Yg + grow * 1024 + q4 * 16; *(v4u*)yp = o0; *(v4u*)(yp + 8) = o1;
        }
        if (MODE == 1 && !SSD_VEARLY && c + 1 < SEQ / 128) MIX_LOADV(c + 1);
#if USE_GUEST_CVT
        MIX_SB();
        if (gon) {
#pragma unroll
            for (int i = 0; i < 4; ++i) { v4u o; o.x = pk2(gv[0][i], gv[1][i]); o.y = pk2(gv[2][i], gv[3][i]); o.z = pk2(gv[4][i], gv[5][i]); o.w = pk2(gv[6][i], gv[7][i]); NT_STORE(o, (v4u*)(gdst + (size_t)i * gdk)); } }
#endif
        __syncthreads();
    }
#undef MIX_LOADQK
#undef MIX_LOADV
#undef MIX_LOADG
#undef MIX_STOREQK
#undef MIX_SB
}
}
__device__ __forceinline__ void p_ml_chunk(Frame& F, KArgs A, int L) { const bool guest = USE_GUEST_CVT && F.G == 256; for (int u = F.bid; u < NB * 16; u += F.G) mixk::chunk_unit<0>(F, A, L, u >> 4, (u >> 2) & 3, u & 3, guest); }
__device__ __forceinline__ void p_ssd_chunk(Frame& F, KArgs A, int L) { const bool guest = USE_GUEST_CVT && F.G == 256; for (int u = F.bid; u < NB * 16; u += F.G) mixk::chunk_unit<1>(F, A, L, u >> 4, u & 15, 0, guest); }


#define MAKE_FRAME(F, A) KArgs A = kargs(); Frame F; \
        { extern __shared__ __attribute__((aligned(16))) unsigned char lds_[]; int t_ = threadIdx.x, b_ = blockIdx.x, g_ = gridDim.x; asm volatile("" : "+v"(t_)); asm volatile("" : "+s"(b_), "+s"(g_)); \
          F.lds = (LAS unsigned char*)lds_; F.MISC = (volatile LAS unsigned*)(F.lds + MISC_OFF); F.tid = t_; F.lane = t_ & 63; F.wave = __builtin_amdgcn_readfirstlane(t_ >> 6); \
          F.G = g_; F.bid = b_; F.ws = A->ws; F.out = A->out; F.ctl = (gu32*)(F.ws + WS_CTL); }
static_assert(FIX_PURE == 1 && USE_EPI_CONV == 1 && !USE_SIMPLE_ML && !USE_SIMPLE_SSD, "the phase order (SSD before attention) needs the mLSTM output gate consumed in the chunk phase and the fused conv epilogue");
template <unsigned MASK>
__global__ void __launch_bounds__(NWAVES * 64, 2) mk_fwd(Args) {
    extern __shared__ __attribute__((aligned(16))) unsigned char lds[];
    { const int t0 = threadIdx.x; for (int u = t0; u < (LDS_BYTES - LDSCTL_OFF) / 4; u += NWAVES * 64) ((LAS unsigned*)((LAS unsigned char*)lds + LDSCTL_OFF))[u] = 0u; }
    __syncthreads();
    XcdBarrier bar = xcd_barrier_post((unsigned*)(kargs()->ws + WS_CTL) + CW_BAR, (volatile LAS unsigned*)((LAS unsigned char*)lds + MISC_OFF) + 8);
    int pid = 0;
#define PH_BEGIN(k) if constexpr ((MASK >> (k)) & 1u) if (kargs()->ph_lo <= pid && pid < kargs()->ph_hi) { \
        for (int rep_ = 0; rep_ < (((((unsigned)(REPEAT_MASK)) >> (k)) & 1u) && L == 0 ? 2 : 1); ++rep_) { MAKE_FRAME(F, A) unsigned char* const ws = F.ws; (void)ws; (void)A;
#define PH_END   } if (pid + 1 < kargs()->ph_hi) { bar.bar = (unsigned*)(kargs()->ws + WS_CTL) + CW_BAR; xcd_barrier(bar); if (PROBE_BAR2) xcd_barrier(bar); } } ++pid;
#define GEMM_IN(EPI, E, pn0, npn) GEMM_IN_GAP(EPI, E, pn0, npn, 1 << 30, 0)
#define GEMM_IN_GAP(EPI, E, pn0, npn, gap_at, gap_len) do { pg8::Gemm g{(const pg8::bf16_t*)(ws + WS_H), (const pg8::bf16_t*)(ws + WS_WIN), NT, NPN_IN * 256, 1024}; \
        pg8::RangeOrder S; S.init(NT, (npn), (pn0), F.G, F.bid, (gap_at), (gap_len)); \
        pg8::gemm_phase<EPI, pg8::RangeOrder, GEMM_ALIGN, GEMM_SP2>(F.lds + RING_OFF, g, S, E); } while (0)

    { constexpr int L = 0;
        PH_BEGIN(0)
            p_convert(F, A, L);
            if (L == 0) p_norm<0, 0>(F, A->in[I_X], F.out, A->in[I_N1W], (bf16*)(ws + WS_H));
            else p_norm<1, 0>(F, nullptr, F.out, A->in[I_N1W] + (size_t)L * D, (bf16*)(ws + WS_H));
        PH_END
        PH_BEGIN(1) { pg8::EpiProjConv E{ws + WS_PROJ, (pg8::bf16_t*)(ws + WS_YATT), (pg8::bf16_t*)(ws + WS_YSSD), A->in[I_MCW] + (size_t)L * 4 * 2048, A->in[I_MCB] + (size_t)L * 2048, (pg8::bf16_t*)(ws + WS_RAWH), 0.0625f,
                                            (pg8::bf16_t*)(ws + WS_XSSD), (pg8::bf16_t*)(ws + WS_PROJ + 1 * pg8::SLAB), A->in[I_SCW] + (size_t)L * 4 * 2048, A->in[I_SCB] + (size_t)L * 2048, (pg8::bf16_t*)(ws + WS_RAWH2)};
                      if (PROBE_EPINULL && rep_ == 1) { pg8::EpiNull EN;
                          if (PROBE_EPINULL == 2) { pg8::Gemm g{(const pg8::bf16_t*)(ws + WS_H), (const pg8::bf16_t*)(ws + WS_WIN), NT, NPN_IN * 256, 1024}; pg8::ConstOrder S{nullptr, nullptr, 14};
                                                    pg8::gemm_phase<pg8::EpiNull, pg8::ConstOrder, GEMM_ALIGN, GEMM_SP2>(F.lds + RING_OFF, g, S, EN); }
                          else GEMM_IN_GAP(pg8::EpiNull, EN, 0, 28, 16, 12); } else { GEMM_IN_GAP(pg8::EpiProjConv, E, 0, 28, 16, 12); } } if (!(PROBE_EPINULL && rep_ == 1)) p_small(F); PH_END
        PH_BEGIN(2) p_convfix(F, (bf16*)(ws + WS_YATT), (bf16*)(ws + WS_YSSD), A->in[I_MCW] + (size_t)L * 4 * 2048, A->in[I_MCB] + (size_t)L * 2048, 0.0625f, WS_RAWH);
                    p_convfix(F, (bf16*)(ws + WS_XSSD), (bf16*)(ws + WS_PROJ + 1 * pg8::SLAB), A->in[I_SCW] + (size_t)L * 4 * 2048, A->in[I_SCB] + (size_t)L * 2048, 1.0f, WS_RAWH2); p_fcum(F, A, L); PH_END
        PH_BEGIN(3) p_ml_chunk(F, A, L); if (PROBE_ML2 && L == 0) p_ml_chunk(F, A, L); p_ssd_chunk(F, A, L); PH_END
#if ATT_GUEST && !USE_SIMPLE_ATT
        PH_BEGIN(4) { pg8::EpiProj E{ws + WS_PROJ}; GEMM_IN(pg8::EpiProj, E, 16, 12); } PH_END
#else
#if PHASE_SPLIT
        PH_BEGIN(4) for (int pass = 0; pass < 2; ++pass) { if ((pass == 0) == ((F.bid & 8) == 0)) { p_fix<1>(F, A, L); p_fix<0>(F, A, L); } else { pg8::EpiProj E{ws + WS_PROJ}; GEMM_IN(pg8::EpiProj, E, 16, 12); } } PH_END
#else
        PH_BEGIN(4) if (PROBE_COPY && L == 0) { for (int pc = 0; pc < PROBE_COPY; ++pc) p_probe_copy(F, pc); } p_fix<1>(F, A, L); p_fix<0>(F, A, L); { pg8::EpiProj E{ws + WS_PROJ}; GEMM_IN(pg8::EpiProj, E, 16, 12); } PH_END
#endif
#endif
        PH_BEGIN(5)
#if USE_SIMPLE_ATT
            p_att_simple(F);
#else
            const attn_body::AttnTensors AT{(const attn_body::bf16*)(ws + WS_PROJ), (const attn_body::bf16*)(ws + WS_PROJ + pg8::SLAB), (const attn_body::bf16*)(ws + WS_PROJ + 2 * pg8::SLAB), (attn_body::bf16*)(ws + WS_YATT), (const float*)(ws + WS_FB)};
            const attn_body::StaticOrder S((int)F.G, (int)F.bid);
            const int g_n = (NT + (int)F.G * NWAVES - 1) / ((int)F.G * NWAVES);
            attn_body::Guest GU{(attn_body::bf16*)(ws + WS_YML), (attn_body::bf16*)(ws + WS_XSSD), (const float*)(ws + WS_SSQM), (const float*)(ws + WS_SSQS), ((int)F.bid * NWAVES + (int)F.wave) * g_n, ATT_GUEST ? 0 : g_n, g_n};
            attn_body::attn_phase<attn_body::StaticOrder, ATT_THRL>((char*)F.lds + RING_OFF, AT, S, GU);
#if ATT_GUEST
            for (; GU.k < GU.n; ++GU.k) { const int row = GU.row0 + GU.k; if (row < NT) { p_fix_row<1>(F, A, L, row); p_fix_row<0>(F, A, L, row); } }
#endif
#endif
        PH_END
#if GATE_FUSE
        PH_BEGIN(9)
            pg8::RangeOrder S0; S0.init(NT, 4, 0, F.G, F.bid); pg8::Unit u0; const bool any0 = S0.next(0, u0);
            const size_t TSTEP = (size_t)256 * 1024 * 2;
            const char* const hA0 = (const char*)(ws + WS_H) + (size_t)u0.pm * TSTEP;
            const pg8::EpiGate EG{ws + WS_PROJ, A->in[I_GB] + (size_t)L * 3072};
#define P9_GATE(b, CIN) do { pg8::Gemm g{(const pg8::bf16_t*)(ws + WS_H), (const pg8::bf16_t*)(ws + WS_WIN), NT, NPN_IN * 256, 1024}; pg8::RangeOrder S; S.init(NT, 4, 40 + 4 * (b), F.G, F.bid); \
                const size_t yoff_ = ((b) == 0) ? WS_YATT : ((b) == 1) ? WS_XSSD : WS_YML; \
                pg8::gemm_phase<pg8::EpiGate, pg8::RangeOrder, true, true, (CIN) && GEMM_CHAIN, GEMM_CHAIN>(F.lds + RING_OFF, g, S, EG, (const char*)(ws + yoff_) + (size_t)u0.pm * TSTEP, (const char*)(ws + WS_WBR) + (size_t)(b) * 2097152 + (size_t)u0.pn * TSTEP); \
                if (!GEMM_CHAIN) { asm volatile("s_waitcnt vmcnt(0)" ::: "memory"); __syncthreads(); } } while (0)
#define P9_MIX(b, COUT) do { const size_t yoff_ = ((b) == 0) ? WS_YATT : ((b) == 1) ? WS_XSSD : WS_YML; \
                pg8::Gemm g{(const pg8::bf16_t*)(ws + yoff_), (const pg8::bf16_t*)(ws + WS_WBR) + (size_t)(b) * 1048576, NT, 1024, 1024}; pg8::RangeOrder S; S.init(NT, 4, 0, F.G, F.bid); \
                pg8::EpiBranch E{(pg8::bf16_t*)(ws + WS_PROJ + 3 * pg8::SLAB), (const pg8::bf16_t*)(ws + WS_PROJ + (size_t)(b) * pg8::SLAB), (b) == 0 ? 1 : 0}; \
                pg8::gemm_phase<pg8::EpiBranch, pg8::RangeOrder, true, true, GEMM_CHAIN, (COUT) && GEMM_CHAIN>(F.lds + RING_OFF, g, S, E, hA0, (const char*)(ws + WS_WIN) + (size_t)(u0.pn + 40 + 4 * ((b) + 1)) * TSTEP); \
                if (!(GEMM_CHAIN && (COUT))) { asm volatile("s_waitcnt vmcnt(0)" ::: "memory"); __syncthreads(); } } while (0)
            if (any0) { P9_GATE(0, false); P9_MIX(0, true); P9_GATE(1, true); P9_MIX(1, true); P9_GATE(2, true); P9_MIX(2, false); }
#undef P9_GATE
#undef P9_MIX
        PH_END
#else
        PH_BEGIN(9) { pg8::EpiGate E{ws + WS_PROJ, A->in[I_GB] + (size_t)L * 3072}; GEMM_IN(pg8::EpiGate, E, 40, 12); } PH_END
        PH_BEGIN(10)
            for (int b = 0; b < 3; ++b) {
                const size_t yoff = (b == 0) ? WS_YATT : (b == 1) ? WS_XSSD : WS_YML;
                pg8::Gemm g{(const pg8::bf16_t*)(ws + yoff), (const pg8::bf16_t*)(ws + WS_WBR) + (size_t)b * 1048576, NT, 1024, 1024};
                pg8::RangeOrder S; S.init(NT, 4, 0, F.G, F.bid);
                pg8::EpiBranch E{(pg8::bf16_t*)(ws + WS_H), (const pg8::bf16_t*)(ws + WS_PROJ + (size_t)b * pg8::SLAB), b == 0 ? 1 : 0};
                pg8::gemm_phase<pg8::EpiBranch, pg8::RangeOrder, true, true>(F.lds + RING_OFF, g, S, E);
                asm volatile("s_waitcnt vmcnt(0)" ::: "memory"); __syncthreads();
            }
        PH_END
#endif
        PH_BEGIN(11)
            pg8::Gemm g{(const pg8::bf16_t*)(ws + (GATE_FUSE ? WS_PROJ + 3 * pg8::SLAB : WS_H)), (const pg8::bf16_t*)(ws + WS_WOUT), NT, 1024, 1024};
            pg8::RangeOrder S; S.init(NT, 4, 0, F.G, F.bid);
            pg8::EpiResid E{L == 0 ? A->in[I_X] : (const float*)F.out, F.out, (float*)(ws + WS_SSQS)};
            pg8::gemm_phase<pg8::EpiResid, pg8::RangeOrder, true, true>(F.lds + RING_OFF, g, S, E);
        PH_END
        PH_BEGIN(12) p_router(F, A, L); PH_END
        PH_BEGIN(13) p_gather(F, L); PH_END
        PH_BEGIN(14)
            if (!MOE_TABLE_ONCE) moe_table(F, L);
            pg8::Gemm g{(const pg8::bf16_t*)(ws + WS_H), (const pg8::bf16_t*)(ws + WS_WGU), NT, 65536, 1024};
            pg8::MoeOrderG S{(const PG8_LAS int*)(F.lds + TAB_OFF), F.G, F.bid, (const int*)(ws + WS_ROWTOK), (const PG8_LAS int*)(F.lds + LDSCTL_OFF + 2048)};
            pg8::EpiGU E{(pg8::bf16_t*)(ws + WS_ACT)};
            pg8::gemm_phase<pg8::EpiGU, pg8::MoeOrderG, true, true>(F.lds + RING_OFF, g, S, E);
        PH_END
        PH_BEGIN(15)
            if (!MOE_TABLE_ONCE) moe_table(F, L);
            pg8::Gemm g{(const pg8::bf16_t*)(ws + WS_ACT), (const pg8::bf16_t*)(ws + WS_WDN), PROWS, 65536, 512};
            pg8::MoeOrder S{(const PG8_LAS int*)(F.lds + TAB_OFF), F.G, F.bid, nullptr, nullptr};
            pg8::EpiRows E{(pg8::bf16_t*)(ws + WS_HG)};
            pg8::gemm_phase<pg8::EpiRows, pg8::MoeOrder, true, true>(F.lds + RING_OFF, g, S, E);
        PH_END
    }
    { constexpr int L = 1;
        PH_BEGIN(0)
            p_convert(F, A, L);
            if (L == 0) p_norm<0, 0>(F, A->in[I_X], F.out, A->in[I_N1W], (bf16*)(ws + WS_H));
            else p_norm<1, 0>(F, nullptr, F.out, A->in[I_N1W] + (size_t)L * D, (bf16*)(ws + WS_H));
        PH_END
        PH_BEGIN(1) { pg8::EpiProjConv E{ws + WS_PROJ, (pg8::bf16_t*)(ws + WS_YATT), (pg8::bf16_t*)(ws + WS_YSSD), A->in[I_MCW] + (size_t)L * 4 * 2048, A->in[I_MCB] + (size_t)L * 2048, (pg8::bf16_t*)(ws + WS_RAWH), 0.0625f,
                                            (pg8::bf16_t*)(ws + WS_XSSD), (pg8::bf16_t*)(ws + WS_PROJ + 1 * pg8::SLAB), A->in[I_SCW] + (size_t)L * 4 * 2048, A->in[I_SCB] + (size_t)L * 2048, (pg8::bf16_t*)(ws + WS_RAWH2)};
                      if (PROBE_EPINULL && rep_ == 1) { pg8::EpiNull EN;
                          if (PROBE_EPINULL == 2) { pg8::Gemm g{(const pg8::bf16_t*)(ws + WS_H), (const pg8::bf16_t*)(ws + WS_WIN), NT, NPN_IN * 256, 1024}; pg8::ConstOrder S{nullptr, nullptr, 14};
                                                    pg8::gemm_phase<pg8::EpiNull, pg8::ConstOrder, GEMM_ALIGN, GEMM_SP2>(F.lds + RING_OFF, g, S, EN); }
                          else GEMM_IN_GAP(pg8::EpiNull, EN, 0, 28, 16, 12); } else { GEMM_IN_GAP(pg8::EpiProjConv, E, 0, 28, 16, 12); } } if (!(PROBE_EPINULL && rep_ == 1)) p_small(F); PH_END
        PH_BEGIN(2) p_convfix(F, (bf16*)(ws + WS_YATT), (bf16*)(ws + WS_YSSD), A->in[I_MCW] + (size_t)L * 4 * 2048, A->in[I_MCB] + (size_t)L * 2048, 0.0625f, WS_RAWH);
                    p_convfix(F, (bf16*)(ws + WS_XSSD), (bf16*)(ws + WS_PROJ + 1 * pg8::SLAB), A->in[I_SCW] + (size_t)L * 4 * 2048, A->in[I_SCB] + (size_t)L * 2048, 1.0f, WS_RAWH2); p_fcum(F, A, L); PH_END
        PH_BEGIN(3) p_ml_chunk(F, A, L); if (PROBE_ML2 && L == 0) p_ml_chunk(F, A, L); p_ssd_chunk(F, A, L); PH_END
#if ATT_GUEST && !USE_SIMPLE_ATT
        PH_BEGIN(4) { pg8::EpiProj E{ws + WS_PROJ}; GEMM_IN(pg8::EpiProj, E, 16, 12); } PH_END
#else
#if PHASE_SPLIT
        PH_BEGIN(4) for (int pass = 0; pass < 2; ++pass) { if ((pass == 0) == ((F.bid & 8) == 0)) { p_fix<1>(F, A, L); p_fix<0>(F, A, L); } else { pg8::EpiProj E{ws + WS_PROJ}; GEMM_IN(pg8::EpiProj, E, 16, 12); } } PH_END
#else
        PH_BEGIN(4) if (PROBE_COPY && L == 0) { for (int pc = 0; pc < PROBE_COPY; ++pc) p_probe_copy(F, pc); } p_fix<1>(F, A, L); p_fix<0>(F, A, L); { pg8::EpiProj E{ws + WS_PROJ}; GEMM_IN(pg8::EpiProj, E, 16, 12); } PH_END
#endif
#endif
        PH_BEGIN(5)
#if USE_SIMPLE_ATT
            p_att_simple(F);
#else
            const attn_body::AttnTensors AT{(const attn_body::bf16*)(ws + WS_PROJ), (const attn_body::bf16*)(ws + WS_PROJ + pg8::SLAB), (const attn_body::bf16*)(ws + WS_PROJ + 2 * pg8::SLAB), (attn_body::bf16*)(ws + WS_YATT), (const float*)(ws + WS_FB)};
            const attn_body::StaticOrder S((int)F.G, (int)F.bid);
            const int g_n = (NT + (int)F.G * NWAVES - 1) / ((int)F.G * NWAVES);
            attn_body::Guest GU{(attn_body::bf16*)(ws + WS_YML), (attn_body::bf16*)(ws + WS_XSSD), (const float*)(ws + WS_SSQM), (const float*)(ws + WS_SSQS), ((int)F.bid * NWAVES + (int)F.wave) * g_n, ATT_GUEST ? 0 : g_n, g_n};
            attn_body::attn_phase<attn_body::StaticOrder, ATT_THRL>((char*)F.lds + RING_OFF, AT, S, GU);
#if ATT_GUEST
            for (; GU.k < GU.n; ++GU.k) { const int row = GU.row0 + GU.k; if (row < NT) { p_fix_row<1>(F, A, L, row); p_fix_row<0>(F, A, L, row); } }
#endif
#endif
        PH_END
#if GATE_FUSE
        PH_BEGIN(9)
            pg8::RangeOrder S0; S0.init(NT, 4, 0, F.G, F.bid); pg8::Unit u0; const bool any0 = S0.next(0, u0);
            const size_t TSTEP = (size_t)256 * 1024 * 2;
            const char* const hA0 = (const char*)(ws + WS_H) + (size_t)u0.pm * TSTEP;
            const pg8::EpiGate EG{ws + WS_PROJ, A->in[I_GB] + (size_t)L * 3072};
#define P9_GATE(b, CIN) do { pg8::Gemm g{(const pg8::bf16_t*)(ws + WS_H), (const pg8::bf16_t*)(ws + WS_WIN), NT, NPN_IN * 256, 1024}; pg8::RangeOrder S; S.init(NT, 4, 40 + 4 * (b), F.G, F.bid); \
                const size_t yoff_ = ((b) == 0) ? WS_YATT : ((b) == 1) ? WS_XSSD : WS_YML; \
                pg8::gemm_phase<pg8::EpiGate, pg8::RangeOrder, true, true, (CIN) && GEMM_CHAIN, GEMM_CHAIN>(F.lds + RING_OFF, g, S, EG, (const char*)(ws + yoff_) + (size_t)u0.pm * TSTEP, (const char*)(ws + WS_WBR) + (size_t)(b) * 2097152 + (size_t)u0.pn * TSTEP); \
                if (!GEMM_CHAIN) { asm volatile("s_waitcnt vmcnt(0)" ::: "memory"); __syncthreads(); } } while (0)
#define P9_MIX(b, COUT) do { const size_t yoff_ = ((b) == 0) ? WS_YATT : ((b) == 1) ? WS_XSSD : WS_YML; \
                pg8::Gemm g{(const pg8::bf16_t*)(ws + yoff_), (const pg8::bf16_t*)(ws + WS_WBR) + (size_t)(b) * 1048576, NT, 1024, 1024}; pg8::RangeOrder S; S.init(NT, 4, 0, F.G, F.bid); \
                pg8::EpiBranch E{(pg8::bf16_t*)(ws + WS_PROJ + 3 * pg8::SLAB), (const pg8::bf16_t*)(ws + WS_PROJ + (size_t)(b) * pg8::SLAB), (b) == 0 ? 1 : 0}; \
                pg8::gemm_phase<pg8::EpiBranch, pg8::RangeOrder, true, true, GEMM_CHAIN, (COUT) && GEMM_CHAIN>(F.lds + RING_OFF, g, S, E, hA0, (const char*)(ws + WS_WIN) + (size_t)(u0.pn + 40 + 4 * ((b) + 1)) * TSTEP); \
                if (!(GEMM_CHAIN && (COUT))) { asm volatile("s_waitcnt vmcnt(0)" ::: "memory"); __syncthreads(); } } while (0)
            if (any0) { P9_GATE(0, false); P9_MIX(0, true); P9_GATE(1, true); P9_MIX(1, true); P9_GATE(2, true); P9_MIX(2, false); }
#undef P9_GATE
#undef P9_MIX
        PH_END
#else
        PH_BEGIN(9) { pg8::EpiGate E{ws + WS_PROJ, A->in[I_GB] + (size_t)L * 3072}; GEMM_IN(pg8::EpiGate, E, 40, 12); } PH_END
        PH_BEGIN(10)
            for (int b = 0; b < 3; ++b) {
                const size_t yoff = (b == 0) ? WS_YATT : (b == 1) ? WS_XSSD : WS_YML;
                pg8::Gemm g{(const pg8::bf16_t*)(ws + yoff), (const pg8::bf16_t*)(ws + WS_WBR) + (size_t)b * 1048576, NT, 1024, 1024};
                pg8::RangeOrder S; S.init(NT, 4, 0, F.G, F.bid);
                pg8::EpiBranch E{(pg8::bf16_t*)(ws + WS_H), (const pg8::bf16_t*)(ws + WS_PROJ + (size_t)b * pg8::SLAB), b == 0 ? 1 : 0};
                pg8::gemm_phase<pg8::EpiBranch, pg8::RangeOrder, true, true>(F.lds + RING_OFF, g, S, E);
                asm volatile("s_waitcnt vmcnt(0)" ::: "memory"); __syncthreads();
            }
        PH_END
#endif
        PH_BEGIN(11)
            pg8::Gemm g{(const pg8::bf16_t*)(ws + (GATE_FUSE ? WS_PROJ + 3 * pg8::SLAB : WS_H)), (const pg8::bf16_t*)(ws + WS_WOUT), NT, 1024, 1024};
            pg8::RangeOrder S; S.init(NT, 4, 0, F.G, F.bid);
            pg8::EpiResid E{L == 0 ? A->in[I_X] : (const float*)F.out, F.out, (float*)(ws + WS_SSQS)};
            pg8::gemm_phase<pg8::EpiResid, pg8::RangeOrder, true, true>(F.lds + RING_OFF, g, S, E);
        PH_END
        PH_BEGIN(12) p_router(F, A, L); PH_END
        PH_BEGIN(13) p_gather(F, L); PH_END
        PH_BEGIN(14)
            if (!MOE_TABLE_ONCE) moe_table(F, L);
            pg8::Gemm g{(const pg8::bf16_t*)(ws + WS_H), (const pg8::bf16_t*)(ws + WS_WGU), NT, 65536, 1024};
            pg8::MoeOrderG S{(const PG8_LAS int*)(F.lds + TAB_OFF), F.G, F.bid, (const int*)(ws + WS_ROWTOK), (const PG8_LAS int*)(F.lds + LDSCTL_OFF + 2048)};
            pg8::EpiGU E{(pg8::bf16_t*)(ws + WS_ACT)};
            pg8::gemm_phase<pg8::EpiGU, pg8::MoeOrderG, true, true>(F.lds + RING_OFF, g, S, E);
        PH_END
        PH_BEGIN(15)
            if (!MOE_TABLE_ONCE) moe_table(F, L);
            pg8::Gemm g{(const pg8::bf16_t*)(ws + WS_ACT), (const pg8::bf16_t*)(ws + WS_WDN), PROWS, 65536, 512};
            pg8::MoeOrder S{(const PG8_LAS int*)(F.lds + TAB_OFF), F.G, F.bid, nullptr, nullptr};
            pg8::EpiRows E{(pg8::bf16_t*)(ws + WS_HG)};
            pg8::gemm_phase<pg8::EpiRows, pg8::MoeOrder, true, true>(F.lds + RING_OFF, g, S, E);
        PH_END
    }
    constexpr int L = -1;
    PH_BEGIN(16) p_norm<1, 1>(F, nullptr, F.out, A->in[I_FNW], nullptr); PH_END
#ifdef DBG_STOP
    if constexpr ((MASK >> 17) & 1u) {
        KArgs A = kargs(); unsigned char* ws = A->ws; float* out = A->out; const size_t offs[4] = {DBG_D0, DBG_D1, DBG_D2, DBG_D3};
        for (size_t i = (size_t)blockIdx.x * 512 + threadIdx.x; i < (size_t)NT * D; i += (size_t)gridDim.x * 512) { float v = 0.f;
            for (int k = 0; k < 4; ++k) if (offs[k]) v += bf2f(((const bf16*)(ws + offs[k]))[i]);
            out[i] = v; }
    }
#endif
#undef PH_BEGIN
#undef PH_END
#undef GEMM_IN
}
constexpr int PIDS_PER_LAYER = 13 - (GATE_FUSE ? 1 : 0);

typedef void (*kern_t)(Args);
extern "C" void kernel_launch(void* const* d_in, const int* in_sizes, int n_in, void* d_out, int out_size, void* d_ws, size_t ws_size, hipStream_t stream) {
    static int grid = 0;
#if defined(ONLY_KIND)
    static const kern_t kerns[1] = { mk_fwd<1u << ONLY_KIND> };
    constexpr int NK = 1;
#elif MK_N_LAUNCHES == 1
    static const kern_t kerns[1] = { mk_fwd<0xffffffffu> };
    constexpr int NK = 1;
#else
    static const kern_t kerns[18] = { mk_fwd<1u << 0>, mk_fwd<1u << 1>, mk_fwd<1u << 2>, mk_fwd<1u << 3>, mk_fwd<1u << 4>, mk_fwd<1u << 5>, mk_fwd<1u << 6>, mk_fwd<1u << 7>, mk_fwd<1u << 8>, mk_fwd<1u << 9>,
                                      mk_fwd<1u << 10>, mk_fwd<1u << 11>, mk_fwd<1u << 12>, mk_fwd<1u << 13>, mk_fwd<1u << 14>, mk_fwd<1u << 15>, mk_fwd<1u << 16>, mk_fwd<1u << 17> };
    constexpr int NK = 18;
#endif
    if (grid == 0) {
        if (n_in != 27 || in_sizes[0] != NT * D || out_size != NT * D || ws_size < WS_END) { fprintf(stderr, "kernel_launch: unexpected shapes (n_in %d, in0 %d, out %d, ws %zu < %zu); nothing launched\n", n_in, n_in > 0 ? in_sizes[0] : -1, out_size, ws_size, (size_t)WS_END); grid = -1; return; }
        int dev = 0, cus = 0, per_cu = 0;
        if (hipGetDevice(&dev) != hipSuccess || hipDeviceGetAttribute(&cus, hipDeviceAttributeMultiprocessorCount, dev) != hipSuccess) { grid = -1; return; }
        for (int k = 0; k < NK; ++k)
            if (hipFuncSetAttribute((const void*)kerns[k], hipFuncAttributeMaxDynamicSharedMemorySize, LDS_BYTES) != hipSuccess) { fprintf(stderr, "kernel_launch: hipFuncSetAttribute failed\n"); grid = -1; return; }
        if (hipOccupancyMaxActiveBlocksPerMultiprocessor(&per_cu, (const void*)kerns[0], NWAVES * 64, LDS_BYTES) != hipSuccess || per_cu < 1) { fprintf(stderr, "kernel_launch: occupancy query says %d\n", per_cu); }
        (void)hipGetLastError();
        grid = cus;
    }
    if (grid < 0) return;
    if (hipMemsetAsync((char*)d_ws + WS_CTL, 0, CTL_ZERO_BYTES, stream) != hipSuccess) return;
    Args a{};
    for (int i = 0; i < 27; ++i) a.in[i] = (const float*)d_in[i];
    a.out = (float*)d_out; a.ws = (unsigned char*)d_ws;
    constexpr int NPH = DEPTH * PIDS_PER_LAYER + 1;
#if MK_N_LAUNCHES == 1
    a.ph_lo = 0; a.ph_hi = NPH;
    hipLaunchKernelGGL(kerns[0], dim3(grid), dim3(NWAVES * 64), LDS_BYTES, stream, a);
#else
    int kind_of[PIDS_PER_LAYER]; { int n = 0; for (int k = 0; k < 16; ++k) { if (k >= 6 && k <= 8) continue; kind_of[n++] = k; } }
#ifdef DBG_STOP
    constexpr int NPH_RUN = DBG_STOP;
#else
    constexpr int NPH_RUN = NPH;
#endif
    for (int p = 0; p < NPH_RUN; ++p) { a.ph_lo = p; a.ph_hi = p + 1; const int k = (p == NPH - 1) ? 16 : kind_of[p % PIDS_PER_LAYER];
        hipLaunchKernelGGL(kerns[k], dim3(grid), dim3(NWAVES * 64), LDS_BYTES, stream, a); }
#ifdef DBG_STOP
    if (DBG_D0) { a.ph_lo = 1000; a.ph_hi = 1000; hipLaunchKernelGGL(kerns[17], dim3(grid), dim3(NWAVES * 64), LDS_BYTES, stream, a); }
#endif
#endif
    const hipError_t le = hipPeekAtLastError();
    if (le != hipSuccess) fprintf(stderr, "kernel_launch: launch failed: %s\n", hipGetErrorName(le));
}
```
